# Optimizing an MI355X kernel written in HIP

```python
import math
import jax, jax.numpy as jnp
from jax import lax
import numpy as np

D_MODEL = 1024
BATCH = 8
SEQ = 4096
DEPTH = 4

BRANCH_WIDTH = 512
N_BRANCHES = 3
SWA_Q_HEADS = 8
SWA_KV_HEADS = 2
SWA_GROUP = SWA_Q_HEADS // SWA_KV_HEADS
SWA_HEAD_DIM = BRANCH_WIDTH // SWA_Q_HEADS
WINDOW = 128
N_BUCKETS = 32
MAX_DISTANCE = 128
CONV_CHANNELS = BRANCH_WIDTH
CONV_WIDTH = 31
MLA_HEADS = 8
MLA_Q_RANK = 256
MLA_KV_RANK = 128
MLA_NOPE_DIM = 64
MLA_ROPE_DIM = 32
MLA_V_DIM = BRANCH_WIDTH // MLA_HEADS
ROPE_THETA = 10000.0
Q_BLOCK = 128
D_FF = 4 * D_MODEL
EPS = 1e-6
NEG_INF = -1e30

IN_SPLIT_SIZES = (
    SWA_Q_HEADS * SWA_HEAD_DIM,
    SWA_KV_HEADS * SWA_HEAD_DIM,
    SWA_KV_HEADS * SWA_HEAD_DIM,
    2 * CONV_CHANNELS,
    MLA_Q_RANK,
    MLA_KV_RANK,
    MLA_ROPE_DIM,
    N_BRANCHES * D_MODEL,
)
IN_COLS = sum(IN_SPLIT_SIZES)
IN_SPLIT_POINTS = tuple(sum(IN_SPLIT_SIZES[: i + 1]) for i in range(len(IN_SPLIT_SIZES) - 1))

kernel_name = "hybrid_swa_conformer_mla_gated_block"


def rms_norm(x, g):
    xf = x.astype(jnp.float32)
    y = xf * lax.rsqrt(jnp.mean(xf * xf, axis=-1, keepdims=True) + EPS)
    return (y * g.astype(jnp.float32)).astype(x.dtype)


def layer_norm(x, g, b):
    xf = x.astype(jnp.float32)
    mu = jnp.mean(xf, axis=-1, keepdims=True)
    var = jnp.mean(jnp.square(xf - mu), axis=-1, keepdims=True)
    y = (xf - mu) * lax.rsqrt(var + EPS) * g.astype(jnp.float32) + b.astype(jnp.float32)
    return y.astype(x.dtype)


def t5_bucket(rel):
    n = jnp.maximum(rel, 0)
    max_exact = N_BUCKETS // 2
    nf = jnp.maximum(n, max_exact).astype(jnp.float32)
    large = max_exact + (jnp.log(nf / max_exact) / math.log(MAX_DISTANCE / max_exact)
                         * (N_BUCKETS - max_exact)).astype(jnp.int32)
    return jnp.where(n < max_exact, n, jnp.minimum(large, N_BUCKETS - 1))


def band_frames(t):
    b, s = t.shape[:2]
    blocks = t.reshape((b, s // WINDOW, WINDOW) + t.shape[2:])
    prev = jnp.concatenate([jnp.zeros_like(blocks[:, :1]), blocks[:, :-1]], axis=1)
    return jnp.concatenate([prev, blocks], axis=2)


def swa_bias_and_mask(positions, rel_bias):
    b, s = positions.shape
    nb = s // WINDOW
    pq = positions.reshape(b, nb, WINDOW)
    pk = band_frames(positions)
    bucket = t5_bucket(pq[..., :, None] - pk[..., None, :])
    bias = rel_bias[bucket].astype(jnp.float32).reshape(b, nb, WINDOW, 2 * WINDOW, SWA_KV_HEADS, SWA_GROUP)
    qi = WINDOW + jnp.arange(WINDOW)[:, None]
    ki = jnp.arange(2 * WINDOW)[None, :]
    in_band = (ki <= qi) & (qi - ki < WINDOW)
    has_prev = (jnp.arange(nb) > 0)[:, None, None] | (ki >= WINDOW)[None]
    mask = in_band[None] & has_prev
    return bias, mask[None, :, :, :, None, None]


def swa_attention(q, k, v, sinks, bias, mask):
    b, s = q.shape[:2]
    nb = s // WINDOW
    qb = q.reshape(b, nb, WINDOW, SWA_KV_HEADS, SWA_GROUP, SWA_HEAD_DIM)
    kk = band_frames(k.reshape(b, s, SWA_KV_HEADS, SWA_HEAD_DIM))
    vv = band_frames(v.reshape(b, s, SWA_KV_HEADS, SWA_HEAD_DIM))
    scores = jnp.einsum('bnqhgd,bnkhd->bnqkhg', qb, kk).astype(jnp.float32) * (SWA_HEAD_DIM ** -0.5) + bias
    scores = jnp.where(mask, scores, NEG_INF)
    sink = sinks.astype(jnp.float32).reshape(SWA_KV_HEADS, SWA_GROUP)
    m = jnp.maximum(scores.max(axis=3, keepdims=True), sink)
    p = jnp.exp(scores - m)
    p = p / (p.sum(axis=3, keepdims=True) + jnp.exp(sink - m))
    out = jnp.einsum('bnqkhg,bnkhd->bnqhgd', p.astype(vv.dtype), vv)
    return out.reshape(b, s, SWA_Q_HEADS * SWA_HEAD_DIM)


def conformer_conv(u_glu, w_dw, b_dw, g_ln, b_ln):
    a, gate = jnp.split(u_glu, 2, axis=-1)
    u = a * jax.nn.sigmoid(gate)
    u = lax.conv_general_dilated(u, w_dw, window_strides=(1,), padding=[(CONV_WIDTH - 1, 0)],
                                 dimension_numbers=('NWC', 'WIO', 'NWC'),
                                 feature_group_count=CONV_CHANNELS) + b_dw
    return jax.nn.silu(layer_norm(u, g_ln, b_ln))


def rope(x, positions):
    d = x.shape[-1]
    half = d // 2
    freqs = jnp.exp(-math.log(ROPE_THETA) * jnp.arange(half, dtype=jnp.float32) / half)
    ang = positions.astype(jnp.float32)[..., None] * freqs
    cos = jnp.cos(ang)[:, :, None, :]
    sin = jnp.sin(ang)[:, :, None, :]
    x1 = x[..., :half].astype(jnp.float32)
    x2 = x[..., half:].astype(jnp.float32)
    return jnp.concatenate([x1 * cos - x2 * sin, x2 * cos + x1 * sin], axis=-1).astype(x.dtype)


def mla_attention(cq, ckv, kpe_raw, positions, g_qn, w_uq, g_kvn, w_ukv):
    b, s = cq.shape[:2]
    q = (rms_norm(cq, g_qn) @ w_uq).reshape(b, s, MLA_HEADS, MLA_NOPE_DIM + MLA_ROPE_DIM)
    q_nope = q[..., :MLA_NOPE_DIM]
    q_pe = rope(q[..., MLA_NOPE_DIM:], positions)
    kv = (rms_norm(ckv, g_kvn) @ w_ukv).reshape(b, s, MLA_HEADS, MLA_NOPE_DIM + MLA_V_DIM)
    k_nope = kv[..., :MLA_NOPE_DIM]
    v = kv[..., MLA_NOPE_DIM:]
    k_pe = rope(kpe_raw[:, :, None, :], positions)[:, :, 0]
    scale = (MLA_NOPE_DIM + MLA_ROPE_DIM) ** -0.5
    nb = s // Q_BLOCK
    key_idx = jnp.arange(s)

    def to_blocks(t):
        return jnp.moveaxis(t.reshape((b, nb, Q_BLOCK) + t.shape[2:]), 1, 0)

    def attend_block(args):
        qn, qp, blk = args
        sc = (jnp.einsum('bqhd,bkhd->bhqk', qn, k_nope)
              + jnp.einsum('bqhd,bkd->bhqk', qp, k_pe)).astype(jnp.float32) * scale
        q_idx = blk * Q_BLOCK + jnp.arange(Q_BLOCK)
        sc = jnp.where(key_idx[None, :] <= q_idx[:, None], sc, NEG_INF)
        p = jax.nn.softmax(sc, axis=-1)
        return jnp.einsum('bhqk,bkhd->bqhd', p.astype(v.dtype), v)

    out = lax.map(attend_block, (to_blocks(q_nope), to_blocks(q_pe), jnp.arange(nb)))
    return jnp.moveaxis(out, 0, 1).reshape(b, s, MLA_HEADS * MLA_V_DIM)


def setup_inputs(seed: int = 0) -> dict:
    key = jax.random.key(seed)
    ks = jax.random.split(key, 20)
    f32 = jnp.float32

    def nrm(k, shape, scale):
        return jax.random.normal(k, shape, f32) * scale

    def gain(k, shape):
        return 1.0 + 0.05 * jax.random.normal(k, shape, f32)

    return {
        "x": nrm(ks[0], (BATCH, SEQ, D_MODEL), 1.0),
        "positions": jnp.broadcast_to(jnp.arange(SEQ, dtype=jnp.int32), (BATCH, SEQ)),
        "rel_bias": nrm(ks[1], (N_BUCKETS, SWA_Q_HEADS), 0.5),
        "g_final": gain(ks[2], (D_MODEL,)),
        "g_mix": gain(ks[3], (DEPTH, D_MODEL)),
        "w_in": nrm(ks[4], (DEPTH, D_MODEL, IN_COLS), D_MODEL ** -0.5),
        "swa_sinks": nrm(ks[5], (DEPTH, SWA_Q_HEADS), 0.5),
        "g_q_norm": gain(ks[6], (DEPTH, MLA_Q_RANK)),
        "w_q_up": nrm(ks[7], (DEPTH, MLA_Q_RANK, MLA_HEADS * (MLA_NOPE_DIM + MLA_ROPE_DIM)), MLA_Q_RANK ** -0.5),
        "g_kv_norm": gain(ks[8], (DEPTH, MLA_KV_RANK)),
        "w_kv_up": nrm(ks[9], (DEPTH, MLA_KV_RANK, MLA_HEADS * (MLA_NOPE_DIM + MLA_V_DIM)), MLA_KV_RANK ** -0.5),
        "w_dw": nrm(ks[10], (DEPTH, CONV_WIDTH, 1, CONV_CHANNELS), CONV_WIDTH ** -0.5),
        "b_dw": nrm(ks[11], (DEPTH, CONV_CHANNELS), 0.02),
        "g_conv_ln": gain(ks[12], (DEPTH, CONV_CHANNELS)),
        "b_conv_ln": nrm(ks[13], (DEPTH, CONV_CHANNELS), 0.02),
        "w_branch": nrm(ks[14], (DEPTH, N_BRANCHES, BRANCH_WIDTH, D_MODEL), BRANCH_WIDTH ** -0.5),
        "w_out": nrm(ks[15], (DEPTH, D_MODEL, D_MODEL), D_MODEL ** -0.5),
        "g_mlp": gain(ks[16], (DEPTH, D_MODEL)),
        "w_up": nrm(ks[17], (DEPTH, D_MODEL, D_FF), D_MODEL ** -0.5),
        "w_down": nrm(ks[18], (DEPTH, D_FF, D_MODEL), D_FF ** -0.5),
    }


def reference(x, positions, rel_bias, g_final, g_mix, w_in, swa_sinks, g_q_norm, w_q_up,
              g_kv_norm, w_kv_up, w_dw, b_dw, g_conv_ln, b_conv_ln, w_branch, w_out,
              g_mlp, w_up, w_down):
    b, s, _ = x.shape
    swa_bias, swa_mask = swa_bias_and_mask(positions, rel_bias)
    for l in range(DEPTH):
        h = rms_norm(x, g_mix[l])
        q_a, k_a, v_a, u_b, cq_c, ckv_c, kpe_c, gate_logits = jnp.split(h @ w_in[l], IN_SPLIT_POINTS, axis=-1)
        y_a = swa_attention(q_a, k_a, v_a, swa_sinks[l], swa_bias, swa_mask)
        y_b = conformer_conv(u_b, w_dw[l], b_dw[l], g_conv_ln[l], b_conv_ln[l])
        y_c = mla_attention(cq_c, ckv_c, kpe_c, positions, g_q_norm[l], w_q_up[l],
                            g_kv_norm[l], w_kv_up[l])
        branches = jnp.einsum('bsnc,ncd->bsnd', jnp.stack([y_a, y_b, y_c], axis=2), w_branch[l])
        gates = jax.nn.sigmoid(gate_logits.reshape(b, s, N_BRANCHES, D_MODEL))
        x = x + jnp.einsum('bsnd,bsnd->bsd', gates, branches) @ w_out[l]
        h = rms_norm(x, g_mlp[l])
        x = x + jnp.square(jax.nn.relu(h @ w_up[l])) @ w_down[l]
    return rms_norm(x, g_final)
```

```cpp
#include <hip/hip_runtime.h>
#include <hip/hip_cooperative_groups.h>
#include <cstdio>
#include <cstdint>
namespace cg = cooperative_groups;

#ifndef DBG_REP_E
#define DBG_REP_E 1
#endif
#ifndef DBG_REP_G
#define DBG_REP_G 1
#endif
#ifndef DBG_REP_C
#define DBG_REP_C 1
#endif
#ifndef DBG_REP_A
#define DBG_REP_A 1
#endif
#ifndef DBG_XSYNC
#define DBG_XSYNC 0
#endif
#ifndef DBG_REP_S
#define DBG_REP_S 1
#endif
namespace pg8 {
#define PG8_LAS __attribute__((address_space(3)))
typedef unsigned short bf16_t;
typedef short bf16x8 __attribute__((ext_vector_type(8)));
typedef float f32x4 __attribute__((ext_vector_type(4)));
typedef unsigned u32x4 __attribute__((ext_vector_type(4)));
constexpr int BM = 256, BK = 64, HALF = 128, HTB = HALF * BK * 2  , STAGE_BYTES = 8 * HTB, NXCD = 8, WGM = 8;

__host__ __device__ __forceinline__ int lds_byte(int r, int c) { const int st = (r >> 4) * 2 + (c >> 5), rr = r & 15, cc = c & 31, ob = rr * 64 + cc * 2; return st * 1024 + (ob ^ (((ob >> 9) & 1) << 5)); }
__host__ __device__ __forceinline__ void stage_rc(int b, int& R, int& C) { const int st = b / 1024, sb = b % 1024, swz = sb ^ (((sb >> 9) & 1) << 5); R = (st >> 1) * 16 + swz / 64; C = (st & 1) * 32 + (swz % 64) / 2; }
__host__ __device__ __forceinline__ int perm32(int rho) { const int n = rho >> 4, i = rho & 15; return 8 * (i >> 2) + 4 * n + (i & 3); }

struct Unit { int pm, pn; };
struct Gemm { const bf16_t* A; const bf16_t* Bt; int lda, ldb, M, N, K; };

struct StaticOrder {
    int nM, nN, nwg, G, c;
    __host__ __device__ void init(int M, int N, int G_, int c_) { nM = M / BM; nN = N / BM; nwg = nM * nN; G = G_; c = c_; }
    __host__ __device__ bool next(int i, Unit& u) const {
        const long L = (long)i * G + c; if (L >= nwg) return false;
        int wgid = (int)L; { const int q = nwg / NXCD, r = nwg % NXCD, xcd = wgid % NXCD, off = wgid / NXCD; wgid = (xcd < r ? xcd * (q + 1) : r * (q + 1) + (xcd - r) * q) + off; }
        const int nig = WGM * nN, gid = wgid / nig, fm = gid * WGM, gsz = (nM - fm) < WGM ? (nM - fm) : WGM;
        u.pm = fm + ((wgid % nig) % gsz); u.pn = (wgid % nig) / gsz; return true;
    }
    __device__ __forceinline__ void a_ready(const Unit&) const {}
    __device__ __forceinline__ void done(const Unit&) const {}
};

__device__ __forceinline__ unsigned cvt_pk_bf16(float lo, float hi) { unsigned r; asm volatile("v_cvt_pk_bf16_f32 %0, %1, %2" : "=v"(r) : "v"(lo), "v"(hi)); return r; }

template <class Epi, class Sched, bool ALIGN_EPI = false, bool SP2 = false>
__device__ __forceinline__ void gemm_phase(PG8_LAS unsigned char* lds, const Gemm g, const Sched& S, const Epi& E) {
    int tid_ = threadIdx.x; asm volatile("" : "+v"(tid_));
    const int tid = tid_, wid = __builtin_amdgcn_readfirstlane(tid >> 6), lane = tid & 63, wr = wid >> 2, wc = wid & 3, fr = lane & 15, fq = lane >> 4;
    const int K = g.K, nt = K / BK;
    unsigned voffA[2], voffB[2];
#pragma unroll
    for (int i = 0; i < 2; ++i) { int R, C; stage_rc(tid * 16 + i * 8192, R, C); const int Rb = Epi::PERM ? ((R & ~31) + perm32(R & 31)) : R;
        voffA[i] = (unsigned)(R * g.lda + C) * 2u; voffB[i] = (unsigned)(Rb * g.ldb + C) * 2u; }
    const size_t kstep = (size_t)(BK * 2);
    const size_t hstepA = (size_t)HALF * g.lda * 2, hstepB = (size_t)HALF * g.ldb * 2;
    const size_t tstepA = 2 * hstepA, tstepB = 2 * hstepB;
    const unsigned ldsw = (unsigned)wid * 1024u;
    const int aoff = lds_byte(wr * 64 + fr, fq * 8), boff = lds_byte(wc * 32 + fr, fq * 8);
#define PG8_SA(b, h) (((b) * 2 + (h)) * HTB)
#define PG8_SB(b, h) ((4 + (b) * 2 + (h)) * HTB)
#define PG8_STAGE(bufoff, gbase, voff) do { _Pragma("unroll") for (int _i = 0; _i < 2; ++_i) \
        __builtin_amdgcn_global_load_lds((const unsigned*)((const char*)(gbase) + (voff)[_i]), (PG8_LAS unsigned*)(lds + (bufoff) + ldsw + _i * 8192), 16, 0, 0); } while (0)
#define PG8_LDA(dst, b, h) do { _Pragma("unroll") for (int m = 0; m < 4; ++m) _Pragma("unroll") for (int k = 0; k < 2; ++k) dst[m][k] = *(const PG8_LAS bf16x8*)(lds + PG8_SA(b, h) + aoff + m * 2048 + k * 1024); } while (0)
#define PG8_LDB(dst, b, h) do { _Pragma("unroll") for (int n = 0; n < 2; ++n) _Pragma("unroll") for (int k = 0; k < 2; ++k) dst[n][k] = *(const PG8_LAS bf16x8*)(lds + PG8_SB(b, h) + boff + n * 2048 + k * 1024); } while (0)
#define PG8_MMA(ai, bj, At, Bt) do { __builtin_amdgcn_s_setprio(1); _Pragma("unroll") for (int m = 0; m < 4; ++m) _Pragma("unroll") for (int n = 0; n < 2; ++n) _Pragma("unroll") for (int k = 0; k < 2; ++k) \
        acc[ai][bj][m][n] = __builtin_amdgcn_mfma_f32_16x16x32_bf16(Bt[n][k], At[m][k], acc[ai][bj][m][n], 0, 0, 0); __builtin_amdgcn_s_setprio(0); } while (0)
#define PG8_WAIT_V(n) asm volatile("s_waitcnt vmcnt(" #n ")" ::: "memory")
#define PG8_WAIT_L(n) asm volatile("s_waitcnt lgkmcnt(" #n ")" ::: "memory")
#define PG8_BAR __builtin_amdgcn_s_barrier()
#define PG8_SCHED __builtin_amdgcn_sched_barrier(0)
    Unit cur, nxt; int ui = 0;
    if (!S.next(0, cur)) return;
    f32x4 acc[2][2][4][2];
#pragma unroll
    for (int a = 0; a < 2; ++a)
#pragma unroll
        for (int b = 0; b < 2; ++b)
#pragma unroll
            for (int m = 0; m < 4; ++m)
#pragma unroll
                for (int n = 0; n < 2; ++n) acc[a][b][m][n] = (f32x4){0.f, 0.f, 0.f, 0.f};
    bf16x8 At[4][2], B0[2][2], B1[2][2];
    const char* cA = (const char*)g.A + (size_t)cur.pm * tstepA; const char* cB = (const char*)g.Bt + (size_t)cur.pn * tstepB;
    S.a_ready(cur);
    if constexpr (SP2) {
        PG8_STAGE(PG8_SB(0, 0), cB, voffB); PG8_STAGE(PG8_SB(0, 1), cB + hstepB, voffB); PG8_STAGE(PG8_SA(0, 0), cA, voffA); PG8_STAGE(PG8_SA(0, 1), cA + hstepA, voffA);
        if (wr == 1) PG8_BAR;
        PG8_WAIT_V(2); PG8_BAR;
        PG8_STAGE(PG8_SB(1, 0), cB + kstep, voffB); PG8_STAGE(PG8_SA(1, 0), cA + kstep, voffA); PG8_STAGE(PG8_SB(1, 1), cB + hstepB + kstep, voffB);
        PG8_WAIT_V(6); PG8_BAR;
    } else {
        PG8_STAGE(PG8_SB(0, 0), cB, voffB); PG8_STAGE(PG8_SA(0, 0), cA, voffA); PG8_STAGE(PG8_SB(0, 1), cB + hstepB, voffB); PG8_STAGE(PG8_SA(0, 1), cA + hstepA, voffA);
        if (wr == 1) PG8_BAR;
        PG8_WAIT_V(4); PG8_BAR;
        PG8_STAGE(PG8_SB(1, 0), cB + kstep, voffB); PG8_STAGE(PG8_SA(1, 0), cA + kstep, voffA); PG8_STAGE(PG8_SB(1, 1), cB + hstepB + kstep, voffB);
        PG8_WAIT_V(6); PG8_BAR;
    }
    for (;;) {
        const bool has_next = S.next(ui + 1, nxt);
        const char* nA = has_next ? (const char*)g.A + (size_t)nxt.pm * tstepA : cA; const char* nB = has_next ? (const char*)g.Bt + (size_t)nxt.pn * tstepB : cB;
        for (int t = 0; t < nt; t += 2) {
            const bool last = (t == nt - 2);
            const char* a1 = cA + (size_t)(t + 1) * kstep;
            const char* a2 = last ? nA : cA + (size_t)(t + 2) * kstep; const char* b2 = last ? nB : cB + (size_t)(t + 2) * kstep;
            const char* a3 = a2 + kstep; const char* b3 = b2 + kstep;
            if (last && has_next) S.a_ready(nxt);
            if constexpr (SP2) {
            PG8_LDB(B0, 0, 0); PG8_LDB(B1, 0, 1); PG8_SCHED; PG8_LDA(At, 0, 0); PG8_STAGE(PG8_SA(1, 1), a1 + hstepA, voffA);
            PG8_WAIT_V(8); PG8_WAIT_L(0); PG8_BAR; PG8_MMA(0, 0, At, B0); PG8_MMA(0, 1, At, B1); PG8_BAR; PG8_SCHED;
            PG8_LDA(At, 0, 1); PG8_STAGE(PG8_SB(0, 0), b2, voffB); PG8_STAGE(PG8_SB(0, 1), b2 + hstepB, voffB); PG8_STAGE(PG8_SA(0, 0), a2, voffA);
            PG8_WAIT_V(8); PG8_WAIT_L(0); PG8_BAR; PG8_MMA(1, 0, At, B0); PG8_MMA(1, 1, At, B1); PG8_BAR; PG8_SCHED;
            PG8_LDB(B0, 1, 0); PG8_LDB(B1, 1, 1); PG8_SCHED; PG8_LDA(At, 1, 0); PG8_STAGE(PG8_SA(0, 1), a2 + hstepA, voffA);
            PG8_WAIT_V(8); PG8_WAIT_L(0); PG8_BAR; PG8_MMA(0, 0, At, B0); PG8_MMA(0, 1, At, B1); PG8_BAR; PG8_SCHED;
            PG8_LDA(At, 1, 1); PG8_STAGE(PG8_SB(1, 0), b3, voffB); PG8_STAGE(PG8_SB(1, 1), b3 + hstepB, voffB); PG8_STAGE(PG8_SA(1, 0), a3, voffA);
            PG8_WAIT_V(8); PG8_WAIT_L(0); PG8_BAR; PG8_MMA(1, 0, At, B0); PG8_MMA(1, 1, At, B1); PG8_BAR; PG8_SCHED;
            } else {
            PG8_LDB(B0, 0, 0); PG8_SCHED; PG8_LDA(At, 0, 0); PG8_STAGE(PG8_SA(1, 1), a1 + hstepA, voffA);
            PG8_WAIT_L(8); PG8_BAR; PG8_WAIT_L(0); PG8_MMA(0, 0, At, B0); PG8_BAR; PG8_SCHED;
            PG8_LDB(B1, 0, 1); PG8_STAGE(PG8_SB(0, 0), b2, voffB);
            PG8_BAR; PG8_WAIT_L(0); PG8_MMA(0, 1, At, B1); PG8_BAR;
            PG8_LDA(At, 0, 1); PG8_STAGE(PG8_SA(0, 0), a2, voffA);
            PG8_BAR; PG8_WAIT_L(0); PG8_MMA(1, 0, At, B0); PG8_BAR; PG8_SCHED;
            PG8_STAGE(PG8_SB(0, 1), b2 + hstepB, voffB);
            PG8_WAIT_V(6); PG8_BAR; PG8_MMA(1, 1, At, B1); PG8_BAR;
            PG8_LDB(B0, 1, 0); PG8_SCHED; PG8_LDA(At, 1, 0); PG8_STAGE(PG8_SA(0, 1), a2 + hstepA, voffA);
            PG8_WAIT_L(8); PG8_BAR; PG8_WAIT_L(0); PG8_MMA(0, 0, At, B0); PG8_BAR; PG8_SCHED;
            PG8_LDB(B1, 1, 1); PG8_STAGE(PG8_SB(1, 0), b3, voffB);
            PG8_BAR; PG8_WAIT_L(0); PG8_MMA(0, 1, At, B1); PG8_BAR;
            PG8_LDA(At, 1, 1); PG8_STAGE(PG8_SA(1, 0), a3, voffA);
            PG8_BAR; PG8_WAIT_L(0); PG8_MMA(1, 0, At, B0); PG8_BAR; PG8_SCHED;
            PG8_STAGE(PG8_SB(1, 1), b3 + hstepB, voffB);
            PG8_WAIT_V(6); PG8_BAR; PG8_MMA(1, 1, At, B1); PG8_BAR;
            }
        }
        if constexpr (ALIGN_EPI) { if (wr == 0) PG8_BAR; }
        if constexpr (!Epi::AFTER_DRAIN) { E(acc, cur, wr, wc, fr, fq); S.done(cur); }
        if (!has_next) break;
#pragma unroll
        for (int a = 0; a < 2; ++a)
#pragma unroll
            for (int b = 0; b < 2; ++b)
#pragma unroll
                for (int m = 0; m < 4; ++m)
#pragma unroll
                    for (int n = 0; n < 2; ++n) acc[a][b][m][n] = (f32x4){0.f, 0.f, 0.f, 0.f};
        cur = nxt; cA = nA; cB = nB; ++ui;
        if constexpr (ALIGN_EPI) { if (wr == 1) PG8_BAR; }
    }
    PG8_WAIT_V(0);
    if constexpr (!ALIGN_EPI) { if (wr == 0) PG8_BAR; }
    PG8_BAR;
    if constexpr (Epi::AFTER_DRAIN) { E.fused(acc, cur, wr, wc, fr, fq, lds, wid, lane); S.done(cur); }
#undef PG8_SA
#undef PG8_SB
#undef PG8_STAGE
#undef PG8_LDA
#undef PG8_LDB
#undef PG8_MMA
#undef PG8_WAIT_V
#undef PG8_WAIT_L
#undef PG8_BAR
#undef PG8_SCHED
}
}

constexpr int BATCH = 8, SEQ = 4096, DM = 1024, DEPTH = 4, T = BATCH * SEQ;
constexpr int INC = 5280, PN = 2304, DFF = 4096;
constexpr int C_QA = 0, C_KA = 512, C_VA = 640, C_UB = 768, C_CQ = 1792, C_CKV = 2048, C_KPE = 2176, C_GATE = 2208;
constexpr float EPS = 1e-6f, LOG2E = 1.4426950408889634f;
constexpr size_t MiB = 1u << 20;
constexpr size_t WS_ROPE = 1 * MiB;
constexpr size_t WS_BT = 5 * MiB;
constexpr size_t WS_W = 8 * MiB;
constexpr size_t WS_H = 41 * MiB;
constexpr size_t WS_P = 105 * MiB;
constexpr size_t WS_Y = 249 * MiB;
constexpr size_t WS_QM = 345 * MiB;
constexpr size_t WS_KM = 393 * MiB;
constexpr size_t WS_VTM = 425 * MiB;
constexpr size_t WS_VTA = 457 * MiB;
constexpr size_t WS_END = 473 * MiB;
constexpr size_t WS_MG = WS_QM;
constexpr size_t WS_GS = WS_P;
constexpr size_t WS_HID = WS_P;
constexpr size_t WO_IN = 0;
constexpr size_t WO_G = WO_IN + (size_t)2304 * 1024;
constexpr size_t WO_Q = WO_G + (size_t)3072 * 1024;
constexpr size_t WO_K = WO_Q + (size_t)768 * 256;
constexpr size_t WO_V = WO_K + (size_t)512 * 256;
constexpr size_t WO_B = WO_V + (size_t)512 * 256;
constexpr size_t WO_O = WO_B + (size_t)3 * 1024 * 512;
constexpr size_t WO_U = WO_O + (size_t)1024 * 1024;
constexpr size_t WO_D = WO_U + (size_t)4096 * 1024;
constexpr size_t WO_END = WO_D + (size_t)1024 * 4096;
static_assert(WO_END * 2 <= 33 * MiB, "weights fit");

constexpr int RING_BYTES = 131072, LDS_BYTES = 135168;
#define LAS __attribute__((address_space(3)))
typedef unsigned short bf16;
typedef unsigned v4u __attribute__((ext_vector_type(4)));
typedef unsigned v2u __attribute__((ext_vector_type(2)));
typedef float f32x4 __attribute__((ext_vector_type(4)));
typedef float f32x2 __attribute__((ext_vector_type(2)));
typedef short bf16x8 __attribute__((ext_vector_type(8)));

__device__ __forceinline__ unsigned f2bf(float f) { unsigned u = __builtin_bit_cast(unsigned, f); return (u + 0x7fffu + ((u >> 16) & 1u)) >> 16; }
__device__ __forceinline__ unsigned pk2(float lo, float hi) { return f2bf(lo) | (f2bf(hi) << 16); }
typedef float f32x2q __attribute__((ext_vector_type(2))); typedef __bf16 bf16x2q __attribute__((ext_vector_type(2)));
__device__ __forceinline__ unsigned pkhw(float lo, float hi) { f32x2q v = {lo, hi}; bf16x2q b = __builtin_convertvector(v, bf16x2q); return __builtin_bit_cast(unsigned, b); }
__device__ __forceinline__ float bf2f(unsigned short h) { return __builtin_bit_cast(float, (unsigned)h << 16); }
__device__ __forceinline__ float bflo(unsigned w) { return __builtin_bit_cast(float, w << 16); }
__device__ __forceinline__ float bfhi(unsigned w) { return __builtin_bit_cast(float, w & 0xffff0000u); }
__device__ __forceinline__ float wave_sum(float v) {
#pragma unroll
    for (int o = 1; o < 64; o <<= 1) v += __shfl_xor(v, o);
    return v;
}
__device__ __forceinline__ float sigmoidf_(float x) { return __builtin_amdgcn_rcpf(1.0f + __builtin_amdgcn_exp2f(-x * LOG2E)); }

struct Params {
    const float* x; const int* pos; const float* rel_bias; const float* g_final; const float* g_mix; const float* w_in; const float* sinks;
    const float* g_qn; const float* w_qup; const float* g_kvn; const float* w_kvup; const float* w_dw; const float* b_dw; const float* g_cln; const float* b_cln;
    const float* w_branch; const float* w_out; const float* g_mlp; const float* w_up; const float* w_down;
    float* out; unsigned char* ws;
};

namespace pg8 {
enum { EPI_BF16 = 0, EPI_SIG = 1, EPI_GATEMUL = 2, EPI_RES = 3, EPI_RELU2 = 4 };
typedef float f32x2p __attribute__((ext_vector_type(2))); typedef __bf16 bf16x2p __attribute__((ext_vector_type(2)));
__device__ __forceinline__ unsigned pkbf(float lo, float hi) { f32x2p v = {lo, hi}; bf16x2p b = __builtin_convertvector(v, bf16x2p); return __builtin_bit_cast(unsigned, b); }
template <int MODE> struct Epi {
    static constexpr bool PERM = true, AFTER_DRAIN = false;
    bf16_t* O; int ldc; const bf16_t* G; int first; const float* base; float* outf; float bscale;
    __device__ __forceinline__ void operator()(const f32x4 (&acc)[2][2][4][2], const Unit& u, int wr, int wc, int fr, int fq) const {
        const int row0 = u.pm * BM + wr * 64 + fr; const int col0 = u.pn * BM + wc * 32 + 8 * fq;
#pragma unroll
        for (int ai = 0; ai < 2; ++ai)
#pragma unroll
            for (int m = 0; m < 4; ++m) {
                const size_t roff = (size_t)(row0 + ai * HALF + m * 16) * (size_t)ldc + col0;
#pragma unroll
                for (int bj = 0; bj < 2; ++bj) {
                    f32x4 v0 = acc[ai][bj][m][0], v1 = acc[ai][bj][m][1];
                    const size_t off = roff + bj * HALF;
                    if constexpr (MODE == EPI_RES) {
                        const f32x4 b0 = *(const f32x4*)(base + off), b1 = *(const f32x4*)(base + off + 4);
                        *(f32x4*)(outf + off) = b0 + v0; *(f32x4*)(outf + off + 4) = b1 + v1;
                    } else {
                        if constexpr (MODE == EPI_SIG) {
#pragma unroll
                            for (int e = 0; e < 4; ++e) { v0[e] = sigmoidf_(v0[e]); v1[e] = sigmoidf_(v1[e]); }
                        }
                        if constexpr (MODE == EPI_RELU2) {
#pragma unroll
                            for (int e = 0; e < 4; ++e) { float a = fmaxf(v0[e], 0.f), b = fmaxf(v1[e], 0.f); v0[e] = a * a; v1[e] = b * b; }
                        }
                        if constexpr (MODE == EPI_GATEMUL) {
                            const u32x4 gw = *(const u32x4*)(G + off); v0 = v0 * bscale; v1 = v1 * bscale;
                            v0[0] *= bflo(gw.x); v0[1] *= bfhi(gw.x); v0[2] *= bflo(gw.y); v0[3] *= bfhi(gw.y);
                            v1[0] *= bflo(gw.z); v1[1] *= bfhi(gw.z); v1[2] *= bflo(gw.w); v1[3] *= bfhi(gw.w);
                            if (!first) {
                                const u32x4 ow = *(const u32x4*)(O + off);
                                v0[0] += bflo(ow.x); v0[1] += bfhi(ow.x); v0[2] += bflo(ow.y); v0[3] += bfhi(ow.y);
                                v1[0] += bflo(ow.z); v1[1] += bfhi(ow.z); v1[2] += bflo(ow.w); v1[3] += bfhi(ow.w);
                            }
                        }
                        u32x4 w; w.x = pkbf(v0[0], v0[1]); w.y = pkbf(v0[2], v0[3]); w.z = pkbf(v1[0], v1[1]); w.w = pkbf(v1[2], v1[3]);
                        *(u32x4*)(O + off) = w;
                    }
                }
            }
    }
};
}

struct Ctx { LAS unsigned char* lds; int tid, lane, wave, G, bid; };

__device__ __forceinline__ Ctx relaunder(const Ctx& C0) {
    Ctx C = C0; int t_ = C0.tid; asm volatile("" : "+v"(t_)); C.tid = t_; C.lane = t_ & 63; C.wave = __builtin_amdgcn_readfirstlane(t_ >> 6); return C;
}

__device__ __forceinline__ void tr_item(const float* W, int ldw, int c0, bf16* WT, int ldk, int r0, int nblk, int item, LAS float* scr, int lane) {
    const int kb = item / nblk, nb = item % nblk, k0 = 64 * kb, n0 = 32 * nb;
#pragma unroll 8
    for (int i = 0; i < 32; ++i) { const int kk = 2 * i + (lane >> 5); scr[kk * 33 + (lane & 31)] = W[(size_t)(k0 + kk) * ldw + c0 + n0 + (lane & 31)]; }
    asm volatile("s_waitcnt lgkmcnt(0)" ::: "memory");
    const int c = lane & 7;
#pragma unroll
    for (int j = 0; j < 4; ++j) { const int n = (lane >> 3) + 8 * j; const LAS float* s = scr + (8 * c) * 33 + n;
        v4u o; o.x = pk2(s[0 * 33], s[1 * 33]); o.y = pk2(s[2 * 33], s[3 * 33]); o.z = pk2(s[4 * 33], s[5 * 33]); o.w = pk2(s[6 * 33], s[7 * 33]);
        *(v4u*)(WT + (size_t)(r0 + n0 + n) * ldk + k0 + 8 * c) = o; }
    asm volatile("s_waitcnt lgkmcnt(0)" ::: "memory");
}

__device__ __forceinline__ void phase_convert_weights(const Ctx& C0, const Params& p, int l) {
    const Ctx C = relaunder(C0);
    LAS float* scr = (LAS float*)(C.lds + C.wave * 16384);
    bf16* W = (bf16*)(p.ws + WS_W);
    const int gw = C.bid * 8 + C.wave, NGW = C.G * 8;
    const float* w_in = p.w_in + (size_t)l * 1024 * INC;
    const float* w_qup = p.w_qup + (size_t)l * 256 * 768;
    const float* w_kvup = p.w_kvup + (size_t)l * 128 * 1024;
    const float* w_br = p.w_branch + (size_t)l * 3 * 512 * 1024;
    const float* w_out = p.w_out + (size_t)l * 1024 * 1024;
    const float* w_up = p.w_up + (size_t)l * 1024 * 4096;
    const float* w_down = p.w_down + (size_t)l * 4096 * 1024;
    constexpr int I_IN = 16 * 69, I_G = 16 * 96, I_Q = 4 * 24, I_KV = 16 * 4, I_B = 3 * 8 * 32, I_O = 16 * 32, I_U = 16 * 128, I_D = 64 * 32;
    constexpr int NITEMS = I_IN + I_G + I_Q + I_KV + I_B + I_O + I_U + I_D;
    for (int it = gw; it < NITEMS; it += NGW) {
        int r = it;
        if (r < I_IN) { tr_item(w_in, INC, 0, W + WO_IN, 1024, 0, 69, r, scr, C.lane); continue; } r -= I_IN;
        if (r < I_G) { tr_item(w_in, INC, C_GATE, W + WO_G, 1024, 0, 96, r, scr, C.lane); continue; } r -= I_G;
        if (r < I_Q) { tr_item(w_qup, 768, 0, W + WO_Q, 256, 0, 24, r, scr, C.lane); continue; } r -= I_Q;
        if (r < I_KV) { const int job = r >> 2, sub = r & 3, h = job >> 1, part = job & 1;
            tr_item(w_kvup, 1024, h * 128 + part * 64, W + (part ? WO_V : WO_K), 256, h * 64, 2, sub, scr, C.lane); continue; } r -= I_KV;
        if (r < I_B) { const int n = r / 256, s = r % 256; tr_item(w_br + (size_t)n * 512 * 1024, 1024, 0, W + WO_B + (size_t)n * 1024 * 512, 512, 0, 32, s, scr, C.lane); continue; } r -= I_B;
        if (r < I_O) { tr_item(w_out, 1024, 0, W + WO_O, 1024, 0, 32, r, scr, C.lane); continue; } r -= I_O;
        if (r < I_U) { tr_item(w_up, 4096, 0, W + WO_U, 1024, 0, 128, r, scr, C.lane); continue; } r -= I_U;
        tr_item(w_down, 1024, 0, W + WO_D, 4096, 0, 32, r, scr, C.lane);
    }
    const int gt = C.bid * 512 + C.tid, NGT = C.G * 512;
    for (int i = gt; i < 96 * 1024 / 8; i += NGT) *(v4u*)(W + WO_IN + (size_t)2208 * 1024 + (size_t)i * 8) = (v4u){0u, 0u, 0u, 0u};
    for (int i = gt; i < 1024 * 16; i += NGT) { const int row = i >> 4, c = i & 15; *(v4u*)(W + WO_K + (size_t)row * 256 + 128 + c * 8) = (v4u){0u, 0u, 0u, 0u}; }
}

__device__ __forceinline__ void phase_tables(const Ctx& C, const Params& p) {
    const int gt = C.bid * 512 + C.tid, NGT = C.G * 512;
    f32x2* cs = (f32x2*)(p.ws + WS_ROPE);
    for (int idx = gt; idx < T * 16; idx += NGT) {
        const int t = idx >> 4, i = idx & 15;
        const float freq = (float)exp(-9.210340371976184 * (double)i / 16.0);
        const float ang = (float)p.pos[t] * freq;
        double r = (double)ang * 0.15915494309189535; r -= rint(r);
        const double xx = r * 6.283185307179586, x2 = xx * xx;
        double s = 1.0 / 51090942171709440000.0, c = 1.0 / 1124000727777607680000.0;
        s = s * x2 - 1.0 / 121645100408832000.0;  c = c * -x2 + 1.0 / 2432902008176640000.0;
        s = s * x2 + 1.0 / 355687428096000.0;
        s = s * x2 - 1.0 / 1307674368000.0;
        s = s * x2 + 1.0 / 6227020800.0;
        s = s * x2 - 1.0 / 39916800.0;
        s = s * x2 + 1.0 / 362880.0;
        s = s * x2 - 1.0 / 5040.0;
        s = s * x2 + 1.0 / 120.0;
        s = s * x2 - 1.0 / 6.0;
        s = s * x2 + 1.0;
        s = s * xx;
        c = c * x2 - 1.0 / 6402373705728000.0;
        c = c * x2 + 1.0 / 20922789888000.0;
        c = c * x2 - 1.0 / 87178291200.0;
        c = c * x2 + 1.0 / 479001600.0;
        c = c * x2 - 1.0 / 3628800.0;
        c = c * x2 + 1.0 / 40320.0;
        c = c * x2 - 1.0 / 720.0;
        c = c * x2 + 1.0 / 24.0;
        c = c * x2 - 0.5;
        c = c * x2 + 1.0;
        cs[idx] = (f32x2){(float)c, (float)s};
    }
    float* bt = (float*)(p.ws + WS_BT);
    for (int idx = gt; idx < 129 * 8; idx += NGT) {
        const int n = idx >> 3, h = idx & 7; int bucket;
        if (n < 16) bucket = n;
        else { const float nf = (float)n; int large = 16 + (int)(logf(nf / 16.0f) / 2.0794415416798357f * 16.0f); bucket = large < 31 ? large : 31; }
        bt[idx] = p.rel_bias[bucket * 8 + h];
    }
}

__device__ __forceinline__ void phase_norm(const Ctx& C0, const float* xin, const float* g, bf16* hout) {
    const Ctx C = relaunder(C0);
    const int gw = C.bid * 8 + C.wave, NGW = C.G * 8;
    f32x4 gv[4];
#pragma unroll
    for (int j = 0; j < 4; ++j) gv[j] = *((const f32x4*)g + C.lane + 64 * j);
    for (int m = gw; m < T; m += 2 * NGW) {
        const int m2 = m + NGW; const bool has2 = m2 < T;
        const f32x4* xr = (const f32x4*)(xin + (size_t)m * DM) + C.lane; const f32x4* xr2 = (const f32x4*)(xin + (size_t)(has2 ? m2 : m) * DM) + C.lane;
        f32x4 v[4], u[4]; float s = 0.f, s2 = 0.f;
#pragma unroll
        for (int j = 0; j < 4; ++j) { v[j] = xr[64 * j]; u[j] = xr2[64 * j]; }
#pragma unroll
        for (int j = 0; j < 4; ++j) { s += (v[j].x * v[j].x + v[j].y * v[j].y) + (v[j].z * v[j].z + v[j].w * v[j].w); s2 += (u[j].x * u[j].x + u[j].y * u[j].y) + (u[j].z * u[j].z + u[j].w * u[j].w); }
        const float rstd = 1.0f / sqrtf(wave_sum(s) * (1.f / DM) + EPS), rstd2 = 1.0f / sqrtf(wave_sum(s2) * (1.f / DM) + EPS);
        v2u* o8 = (v2u*)(hout + (size_t)m * DM) + C.lane;
#pragma unroll
        for (int j = 0; j < 4; ++j) { v2u w; w.x = pk2(v[j].x * rstd * gv[j].x, v[j].y * rstd * gv[j].y); w.y = pk2(v[j].z * rstd * gv[j].z, v[j].w * rstd * gv[j].w); o8[64 * j] = w; }
        if (has2) { v2u* p8 = (v2u*)(hout + (size_t)m2 * DM) + C.lane;
#pragma unroll
            for (int j = 0; j < 4; ++j) { v2u w; w.x = pk2(u[j].x * rstd2 * gv[j].x, u[j].y * rstd2 * gv[j].y); w.y = pk2(u[j].z * rstd2 * gv[j].z, u[j].w * rstd2 * gv[j].w); p8[64 * j] = w; } }
    }
}
__device__ __forceinline__ void phase_final_norm(const Ctx& C, const float* g, float* x, float dbg_add = 0.f) {
    const int gw = C.bid * 8 + C.wave, NGW = C.G * 8;
    f32x4 gv[4];
#pragma unroll
    for (int j = 0; j < 4; ++j) gv[j] = *((const f32x4*)g + C.lane + 64 * j);
    for (int m = gw; m < T; m += NGW) {
        f32x4* xr = (f32x4*)(x + (size_t)m * DM) + C.lane;
        f32x4 v[4]; float s = 0.f;
#pragma unroll
        for (int j = 0; j < 4; ++j) { v[j] = xr[64 * j]; s += (v[j].x * v[j].x + v[j].y * v[j].y) + (v[j].z * v[j].z + v[j].w * v[j].w); }
        const float rstd = 1.0f / sqrtf(wave_sum(s) * (1.f / DM) + EPS);
#pragma unroll
        for (int j = 0; j < 4; ++j) xr[64 * j] = v[j] * rstd * gv[j] + dbg_add;
#ifdef DBG_ZERO
        { const int s_ = m & (SEQ - 1); if (DBG_ZERO) {
#pragma unroll
            for (int j = 0; j < 4; ++j) xr[64 * j] = (f32x4){0.f, 0.f, 0.f, 0.f}; } }
#endif
    }
}

__device__ __forceinline__ void rownorm_rows(const Ctx& C0, const Params& p, int l, int gw, int NGW) {
    const Ctx C = relaunder(C0);
    bf16* P = (bf16*)(p.ws + WS_P);
    const f32x2* cs = (const f32x2*)(p.ws + WS_ROPE);
    const float* gq = p.g_qn + l * 256; const float* gkv = p.g_kvn + l * 128;
    const f32x4 gqv = *((const f32x4*)gq + C.lane); const f32x2 gkvv = *((const f32x2*)gkv + C.lane);
    for (int m = gw; m < T; m += 2 * NGW) {
        const int mm[2] = {m, (m + NGW < T) ? m + NGW : m}; const int nrow = (m + NGW < T) ? 2 : 1;
        v2u cw[2]; unsigned kw[2]; float x1[2], x2[2]; f32x2 cc[2];
#pragma unroll
        for (int r = 0; r < 2; ++r) { const bf16* row = P + (size_t)mm[r] * PN; cw[r] = *((const v2u*)(row + C_CQ) + C.lane); kw[r] = *((const unsigned*)(row + C_CKV) + C.lane);
            x1[r] = bf2f(row[C_KPE + (C.lane & 15)]); x2[r] = bf2f(row[C_KPE + 16 + (C.lane & 15)]); cc[r] = cs[(size_t)mm[r] * 16 + (C.lane & 15)]; }
#pragma unroll
        for (int r = 0; r < 2; ++r) {
            if (r < nrow) {
            bf16* row = P + (size_t)mm[r] * PN;
            const float a0 = bflo(cw[r].x), a1 = bfhi(cw[r].x), a2 = bflo(cw[r].y), a3 = bfhi(cw[r].y);
            const float rq = 1.0f / sqrtf(wave_sum((a0 * a0 + a1 * a1) + (a2 * a2 + a3 * a3)) * (1.f / 256.f) + EPS);
            const float b0 = bflo(kw[r]), b1 = bfhi(kw[r]);
            const float rk = 1.0f / sqrtf(wave_sum(b0 * b0 + b1 * b1) * (1.f / 128.f) + EPS);
            v2u ow; ow.x = pk2(a0 * rq * gqv.x, a1 * rq * gqv.y); ow.y = pk2(a2 * rq * gqv.z, a3 * rq * gqv.w); *((v2u*)(row + C_CQ) + C.lane) = ow;
            *((unsigned*)(row + C_CKV) + C.lane) = pk2(b0 * rk * gkvv.x, b1 * rk * gkvv.y);
            if (C.lane < 16) {
                f32x2 c = cc[r];
#ifdef DBG_NOROPE
                c = (f32x2){1.f, 0.f};
#endif
                row[C_KPE + C.lane] = (bf16)f2bf(x1[r] * c.x - x2[r] * c.y);
                row[C_KPE + 16 + C.lane] = (bf16)f2bf(x2[r] * c.x + x1[r] * c.y);
            }
            }
        }
    }
}

template <bool SWA>
__device__ __forceinline__ void attn_unit(const Ctx& C, const Params& p, int l, int unit) {
    constexpr int NKK = SWA ? 2 : 3;
    const int lane = C.lane, fr = lane & 15, fq = lane >> 4;
    int b, h, qb;
    if constexpr (SWA) { b = unit >> 8; h = (unit >> 5) & 7; qb = unit & 31; }
    else {
        const int k = unit >> 8, i = unit & 255, g = i >> 6, bh = i & 63;
        qb = 31 - 4 * k - ((k & 1) ? (3 - g) : g); b = bh >> 3; h = bh & 7;
    }
    const int q0 = qb * 128 + C.wave * 16;
    const size_t tok0 = (size_t)b * SEQ;
    const size_t qrow = tok0 + q0 + fr;
    const bf16* P = (const bf16*)(p.ws + WS_P);
    bf16x8 qf[NKK];
    if constexpr (SWA) {
        const bf16* qp = P + qrow * PN + C_QA + h * 64 + fq * 8;
        qf[0] = *(const bf16x8*)qp; qf[1] = *(const bf16x8*)(qp + 32);
    } else {
        const bf16* qp = (const bf16*)(p.ws + WS_QM) + qrow * 768 + h * 96 + fq * 8;
        qf[0] = *(const bf16x8*)qp; qf[1] = *(const bf16x8*)(qp + 32);
        const v4u raw = *(const v4u*)(qp + 64);
        const f32x2* cs = (const f32x2*)(p.ws + WS_ROPE) + qrow * 16 + (fq & 1) * 8;
        float own[8] = {bflo(raw.x), bfhi(raw.x), bflo(raw.y), bfhi(raw.y), bflo(raw.z), bfhi(raw.z), bflo(raw.w), bfhi(raw.w)};
        float res[8];
#pragma unroll
        for (int e = 0; e < 8; ++e) { const float oth = __shfl_xor(own[e], 32); f32x2 c = cs[e];
#ifdef DBG_NOROPE
            c = (f32x2){1.f, 0.f};
#endif

            res[e] = (fq < 2) ? (own[e] * c.x - oth * c.y) : (own[e] * c.x + oth * c.y); }
        v4u rw; rw.x = pk2(res[0], res[1]); rw.y = pk2(res[2], res[3]); rw.z = pk2(res[4], res[5]); rw.w = pk2(res[6], res[7]);
        qf[2] = __builtin_bit_cast(bf16x8, rw);
    }
    const float scale = SWA ? 0.125f : 0.10206207261596577f;
    float sink2 = 0.f, m = -1e30f, lsum = 0.f;
    if constexpr (SWA) { sink2 = p.sinks[l * 8 + h] * LOG2E; m = sink2; }
    f32x4 o[4];
#pragma unroll
    for (int d = 0; d < 4; ++d) o[d] = (f32x4){0.f, 0.f, 0.f, 0.f};
    const int kt_lo = SWA ? ((q0 - 127 > 0 ? q0 - 127 : 0) >> 5) : 0, kt_hi = (q0 + 15) >> 5;
    const int qi = q0 + fr;
    int pq = 0; if constexpr (SWA) pq = p.pos[qrow];
    const float* bt = (const float*)(p.ws + WS_BT) + h;
    const bf16* Kb; int ldk; const bf16* Vt;
    if constexpr (SWA) { Kb = P + C_KA + (h >> 2) * 64; ldk = PN; Vt = (const bf16*)(p.ws + WS_VTA) + (size_t)((h >> 2) * 64) * T; }
    else { Kb = (const bf16*)(p.ws + WS_KM) + h * 64; ldk = 512; Vt = (const bf16*)(p.ws + WS_VTM) + (size_t)(h * 64) * T; }
    for (int kt = kt_lo; kt <= kt_hi; ++kt) {
        const int k0 = kt * 32;
        f32x4 s0 = (f32x4){0.f, 0.f, 0.f, 0.f}, s1 = (f32x4){0.f, 0.f, 0.f, 0.f};
        const size_t kra = tok0 + k0 + fr, krb = kra + 16;
#pragma unroll
        for (int kk = 0; kk < NKK; ++kk) {
            bf16x8 ka, kb;
            if (SWA || kk < 2) { ka = *(const bf16x8*)(Kb + kra * ldk + kk * 32 + fq * 8); kb = *(const bf16x8*)(Kb + krb * ldk + kk * 32 + fq * 8); }
            else { ka = *(const bf16x8*)(P + kra * PN + C_KPE + fq * 8); kb = *(const bf16x8*)(P + krb * PN + C_KPE + fq * 8); }
            s0 = __builtin_amdgcn_mfma_f32_16x16x32_bf16(ka, qf[kk], s0, 0, 0, 0);
            s1 = __builtin_amdgcn_mfma_f32_16x16x32_bf16(kb, qf[kk], s1, 0, 0, 0);
        }
        float v[8];
        int pka[4] = {0, 0, 0, 0}, pkb[4] = {0, 0, 0, 0};
        if constexpr (SWA) { const int4 t0 = *(const int4*)(p.pos + tok0 + k0 + fq * 4), t1 = *(const int4*)(p.pos + tok0 + k0 + 16 + fq * 4);
            pka[0] = t0.x; pka[1] = t0.y; pka[2] = t0.z; pka[3] = t0.w; pkb[0] = t1.x; pkb[1] = t1.y; pkb[2] = t1.z; pkb[3] = t1.w; }
#pragma unroll
        for (int j = 0; j < 4; ++j) {
            const int keya = k0 + fq * 4 + j, keyb = keya + 16;
            float sa = s0[j] * scale, sb = s1[j] * scale;
            bool oka = keya <= qi, okb = keyb <= qi;
            if constexpr (SWA) {
                int da = pq - pka[j]; da = da < 0 ? 0 : (da > 128 ? 128 : da);
                int db = pq - pkb[j]; db = db < 0 ? 0 : (db > 128 ? 128 : db);
#ifndef DBG_NOBIAS
                sa += bt[da * 8]; sb += bt[db * 8];
#endif
                oka = oka && (qi - keya < 128); okb = okb && (qi - keyb < 128);
            }
            v[j] = oka ? sa * LOG2E : -1e30f; v[4 + j] = okb ? sb * LOG2E : -1e30f;
        }
        float mx = fmaxf(fmaxf(fmaxf(v[0], v[1]), fmaxf(v[2], v[3])), fmaxf(fmaxf(v[4], v[5]), fmaxf(v[6], v[7])));
        mx = fmaxf(mx, __shfl_xor(mx, 16)); mx = fmaxf(mx, __shfl_xor(mx, 32));
        const float mn = fmaxf(m, mx), alpha = __builtin_amdgcn_exp2f(m - mn); m = mn;
        float ps = 0.f;
#pragma unroll
        for (int e = 0; e < 8; ++e) { v[e] = __builtin_amdgcn_exp2f(v[e] - mn); ps += v[e]; }
        lsum = lsum * alpha + ps;
#pragma unroll
        for (int d = 0; d < 4; ++d) o[d] = o[d] * alpha;
        v4u pw; pw.x = pk2(v[0], v[1]); pw.y = pk2(v[2], v[3]); pw.z = pk2(v[4], v[5]); pw.w = pk2(v[6], v[7]);
        const bf16x8 pf = __builtin_bit_cast(bf16x8, pw);
#pragma unroll
        for (int d = 0; d < 4; ++d) {
            const bf16* vp = Vt + (size_t)(d * 16 + fr) * T + tok0 + k0 + fq * 4;
            const v2u lo = *(const v2u*)vp, hi = *(const v2u*)(vp + 16);
            const v4u vw = (v4u){lo.x, lo.y, hi.x, hi.y};
            o[d] = __builtin_amdgcn_mfma_f32_16x16x32_bf16(__builtin_bit_cast(bf16x8, vw), pf, o[d], 0, 0, 0);
        }
    }
    lsum += __shfl_xor(lsum, 16); lsum += __shfl_xor(lsum, 32);
    if constexpr (SWA) lsum += __builtin_amdgcn_exp2f(sink2 - m);
    const float inv = 1.0f / lsum;
    bf16* Y = (bf16*)(p.ws + WS_Y) + (SWA ? (size_t)0 : (size_t)2 * T * 512) + qrow * 512 + h * 64 + fq * 4;
#pragma unroll
    for (int d = 0; d < 4; ++d) { v2u w; w.x = pk2(o[d][0] * inv, o[d][1] * inv); w.y = pk2(o[d][2] * inv, o[d][3] * inv); *(v2u*)(Y + d * 16) = w; }
}

__device__ __forceinline__ void conv_unit(const Ctx& C0, const Params& p, int l, int unit) {
    const Ctx C = relaunder(C0);
    LAS float* U = (LAS float*)C.lds;
    const int c = C.tid, t0 = unit * 32, s0 = t0 & (SEQ - 1);
    const bf16* P = (const bf16*)(p.ws + WS_P);
    { const int cg8 = (c & 63) * 8, rsub = c >> 6;
#pragma unroll
      for (int pass = 0; pass < 8; ++pass) {
        const int r = pass * 8 + rsub;
        if (r < 62) {
            const int s = s0 - 30 + r; f32x4 u0 = (f32x4){0.f, 0.f, 0.f, 0.f}, u1 = u0;
            if (s >= 0) { const bf16* row = P + (size_t)(t0 - 30 + r) * PN + C_UB + cg8; const v4u a = *(const v4u*)row, g = *(const v4u*)(row + 512);
                u0[0] = bflo(a.x) * sigmoidf_(bflo(g.x)); u0[1] = bfhi(a.x) * sigmoidf_(bfhi(g.x)); u0[2] = bflo(a.y) * sigmoidf_(bflo(g.y)); u0[3] = bfhi(a.y) * sigmoidf_(bfhi(g.y));
                u1[0] = bflo(a.z) * sigmoidf_(bflo(g.z)); u1[1] = bfhi(a.z) * sigmoidf_(bfhi(g.z)); u1[2] = bflo(a.w) * sigmoidf_(bflo(g.w)); u1[3] = bfhi(a.w) * sigmoidf_(bfhi(g.w)); }
            *(LAS f32x4*)(U + r * 512 + cg8) = u0; *(LAS f32x4*)(U + r * 512 + cg8 + 4) = u1;
        }
      }
    }
    __syncthreads();
    float w[31];
#pragma unroll
    for (int j = 0; j < 31; ++j) w[j] = p.w_dw[(size_t)l * 31 * 512 + j * 512 + c];
    const float bias = p.b_dw[l * 512 + c];
    for (int tb = 0; tb < 32; tb += 8) {
        float acc[8];
#pragma unroll
        for (int k = 0; k < 8; ++k) acc[k] = bias;
#pragma unroll
        for (int jj = 0; jj < 38; ++jj) {
            const float u = U[(tb + jj) * 512 + c];
#pragma unroll
            for (int k = 0; k < 8; ++k) { const int j = jj - k; if (j >= 0 && j < 31) acc[k] += w[j] * u; }
        }
#pragma unroll
        for (int k = 0; k < 8; ++k) U[(tb + k) * 512 + c] = acc[k];
    }
    __syncthreads();
    const float* gl = p.g_cln + l * 512; const float* bl = p.b_cln + l * 512;
    bf16* Y = (bf16*)(p.ws + WS_Y) + (size_t)1 * T * 512;
    for (int q = 0; q < 4; ++q) {
        const int tl = C.wave * 4 + q; float xv[8]; float s = 0.f;
#pragma unroll
        for (int i = 0; i < 8; ++i) { xv[i] = U[tl * 512 + C.lane + 64 * i]; s += xv[i]; }
        const float mean = wave_sum(s) * (1.f / 512.f); float s2 = 0.f;
#pragma unroll
        for (int i = 0; i < 8; ++i) { xv[i] -= mean; s2 += xv[i] * xv[i]; }
        const float rstd = 1.0f / sqrtf(wave_sum(s2) * (1.f / 512.f) + EPS);
#pragma unroll
        for (int i = 0; i < 8; ++i) { const int ch = C.lane + 64 * i; const float y = xv[i] * rstd * gl[ch] + bl[ch]; Y[(size_t)(t0 + tl) * 512 + ch] = (bf16)f2bf(y * sigmoidf_(y)); }
    }
    __syncthreads();
}

constexpr int AK_ROW = 208, AV_ROW = 144, AK_BYTES = 64 * AK_ROW, AV_BYTES = 64 * AV_ROW, ABUF = AK_BYTES + AV_BYTES;
__device__ __forceinline__ void mla_unit(const Ctx& C, const Params& p, int unit) {
    int tid_ = C.tid; asm volatile("" : "+v"(tid_));
    const int tid = tid_, lane = tid & 63, fr = lane & 15, fq = lane >> 4;
    int b, h, qb;
    { const int k = unit >> 8, i = unit & 255, g = i >> 6, bh = i & 63; qb = 15 - 4 * k - ((k & 1) ? (3 - g) : g); b = bh >> 3; h = bh & 7; }
    const int q0w = qb * 256 + C.wave * 32;
    const size_t tok0 = (size_t)b * SEQ;
    const bf16* P = (const bf16*)(p.ws + WS_P); const bf16* QM = (const bf16*)(p.ws + WS_QM); const bf16* KM = (const bf16*)(p.ws + WS_KM); const bf16* VTM = (const bf16*)(p.ws + WS_VTM);
    bf16x8 qf[2][3];
#pragma unroll
    for (int g = 0; g < 2; ++g) {
        const size_t qrow = tok0 + q0w + 16 * g + fr;
        const bf16* qp = QM + qrow * 768 + h * 96 + fq * 8;
        qf[g][0] = *(const bf16x8*)qp; qf[g][1] = *(const bf16x8*)(qp + 32);
        const v4u raw = *(const v4u*)(qp + 64);
        const f32x2* cs = (const f32x2*)(p.ws + WS_ROPE) + qrow * 16 + (fq & 1) * 8;
        const float own[8] = {bflo(raw.x), bfhi(raw.x), bflo(raw.y), bfhi(raw.y), bflo(raw.z), bfhi(raw.z), bflo(raw.w), bfhi(raw.w)};
        float res[8];
#pragma unroll
        for (int e = 0; e < 8; ++e) { const float oth = __shfl_xor(own[e], 32); const f32x2 c = cs[e]; res[e] = (fq < 2) ? (own[e] * c.x - oth * c.y) : (own[e] * c.x + oth * c.y); }
        v4u rw; rw.x = pkhw(res[0], res[1]); rw.y = pkhw(res[2], res[3]); rw.z = pkhw(res[4], res[5]); rw.w = pkhw(res[6], res[7]);
        qf[g][2] = __builtin_bit_cast(bf16x8, rw);
    }
    float m[2] = {-1e30f, -1e30f}, lsum[2] = {0.f, 0.f};
    f32x4 o[2][4];
#pragma unroll
    for (int g = 0; g < 2; ++g)
#pragma unroll
        for (int d = 0; d < 4; ++d) o[g][d] = (f32x4){0.f, 0.f, 0.f, 0.f};
    const int nt = 4 * (qb + 1), my_last = (q0w + 31) >> 6;
    const int kc0 = tid, kc1 = tid + 512;
    const int key0 = kc0 / 12, part0 = kc0 % 12, key1 = kc1 / 12, part1 = kc1 % 12; const bool has1 = kc1 < 768;
    const bf16* ksrc0 = (part0 < 8) ? (KM + (tok0 + key0) * 512 + h * 64 + part0 * 8) : (P + (tok0 + key0) * PN + C_KPE + (part0 - 8) * 8);
    const bf16* ksrc1 = (part1 < 8) ? (KM + (tok0 + key1) * 512 + h * 64 + part1 * 8) : (P + (tok0 + key1) * PN + C_KPE + (part1 - 8) * 8);
    const size_t kstep0 = (part0 < 8) ? (size_t)64 * 512 : (size_t)64 * PN, kstep1 = (part1 < 8) ? (size_t)64 * 512 : (size_t)64 * PN;
    const int kdst0 = key0 * AK_ROW + part0 * 16, kdst1 = key1 * AK_ROW + part1 * 16;
    const bf16* vsrc = VTM + (size_t)(h * 64 + (tid >> 3)) * T + tok0 + (tid & 7) * 8;
    const int vdst = AK_BYTES + (tid >> 3) * AV_ROW + (tid & 7) * 16;
    LAS unsigned char* lds = C.lds;
    v4u r0[2], r1[2], r2[2];
#pragma unroll
    for (int sb = 0; sb < 2; ++sb) { r1[sb] = (v4u){0u, 0u, 0u, 0u}; r0[sb] = *(const v4u*)(ksrc0 + (size_t)sb * kstep0); if (has1) r1[sb] = *(const v4u*)(ksrc1 + (size_t)sb * kstep1); r2[sb] = *(const v4u*)(vsrc + (size_t)sb * 64); }
#pragma unroll
    for (int sb = 0; sb < 2; ++sb) { LAS unsigned char* nb = lds + sb * ABUF; *(LAS v4u*)(nb + kdst0) = r0[sb]; if (has1) *(LAS v4u*)(nb + kdst1) = r1[sb]; *(LAS v4u*)(nb + vdst) = r2[sb]; }
    __syncthreads();
    const float c2 = 0.10206207261596577f * LOG2E;
    for (int kp = 0; kp < nt / 2; ++kp) {
        const bool more = 2 * kp + 2 < nt;
        if (more) {
#pragma unroll
            for (int sb = 0; sb < 2; ++sb) { const int tn = 2 * kp + 2 + sb; r0[sb] = *(const v4u*)(ksrc0 + (size_t)tn * kstep0); if (has1) r1[sb] = *(const v4u*)(ksrc1 + (size_t)tn * kstep1); r2[sb] = *(const v4u*)(vsrc + (size_t)tn * 64); } }
#pragma unroll 1
        for (int sub = 0; sub < 2; ++sub) {
        const int kt = 2 * kp + sub;
        if (kt <= my_last) {
            const LAS unsigned char* Kb = lds + ((kp & 1) * 2 + sub) * ABUF; const LAS unsigned char* Vb = Kb + AK_BYTES;
            const int k0 = kt * 64;
            f32x4 s[2][4];
#pragma unroll
            for (int g = 0; g < 2; ++g)
#pragma unroll
                for (int blk = 0; blk < 4; ++blk) s[g][blk] = (f32x4){0.f, 0.f, 0.f, 0.f};
#pragma unroll
            for (int kk = 0; kk < 3; ++kk)
#pragma unroll
                for (int blk = 0; blk < 4; ++blk) {
                    const bf16x8 kf = *(const LAS bf16x8*)(Kb + (blk * 16 + fr) * AK_ROW + (kk * 32 + fq * 8) * 2);
#pragma unroll
                    for (int g = 0; g < 2; ++g) s[g][blk] = __builtin_amdgcn_mfma_f32_16x16x32_bf16(kf, qf[g][kk], s[g][blk], 0, 0, 0);
                }
            const bool need_mask = (k0 + 63 > q0w);
            bf16x8 pf[2][2];
#pragma unroll
            for (int g = 0; g < 2; ++g) {
                const int qi = q0w + 16 * g + fr;
                if (need_mask) {
                    asm volatile("" ::: "memory");
#pragma unroll
                    for (int blk = 0; blk < 4; ++blk)
#pragma unroll
                        for (int j = 0; j < 4; ++j) { const int key = k0 + blk * 16 + fq * 4 + j; if (key > qi) s[g][blk][j] = -1e30f; }
                    asm volatile("" ::: "memory");
                }
                float mx = fmaxf(s[g][0][0], s[g][0][1]);
                mx = fmaxf(fmaxf(mx, s[g][0][2]), s[g][0][3]);
#pragma unroll
                for (int blk = 1; blk < 4; ++blk) { mx = fmaxf(fmaxf(mx, s[g][blk][0]), s[g][blk][1]); mx = fmaxf(fmaxf(mx, s[g][blk][2]), s[g][blk][3]); }
                mx = fmaxf(mx, __shfl_xor(mx, 16)); mx = fmaxf(mx, __shfl_xor(mx, 32));
                const float mn = fmaxf(m[g], mx * c2), alpha = __builtin_amdgcn_exp2f(m[g] - mn); m[g] = mn;
                float ps = 0.f;
#pragma unroll
                for (int blk = 0; blk < 4; ++blk)
#pragma unroll
                    for (int j = 0; j < 4; ++j) { const float pv = __builtin_amdgcn_exp2f(s[g][blk][j] * c2 - mn); s[g][blk][j] = pv; ps += pv; }
                lsum[g] = lsum[g] * alpha + ps;
                if (__builtin_amdgcn_ballot_w64(alpha != 1.0f) != 0ull) {
#pragma unroll
                    for (int d = 0; d < 4; ++d) o[g][d] = o[g][d] * alpha;
                }
#pragma unroll
                for (int hf = 0; hf < 2; ++hf) { v4u pw; pw.x = pkhw(s[g][2 * hf][0], s[g][2 * hf][1]); pw.y = pkhw(s[g][2 * hf][2], s[g][2 * hf][3]); pw.z = pkhw(s[g][2 * hf + 1][0], s[g][2 * hf + 1][1]); pw.w = pkhw(s[g][2 * hf + 1][2], s[g][2 * hf + 1][3]);
                    pf[g][hf] = __builtin_bit_cast(bf16x8, pw); }
            }
#pragma unroll
            for (int hf = 0; hf < 2; ++hf)
#pragma unroll
                for (int d = 0; d < 4; ++d) {
                    const LAS unsigned char* vp = Vb + (d * 16 + fr) * AV_ROW + (hf * 32 + fq * 4) * 2;
                    const v2u lo = *(const LAS v2u*)vp, hi = *(const LAS v2u*)(vp + 32);
                    const v4u vw = (v4u){lo.x, lo.y, hi.x, hi.y}; const bf16x8 vf = __builtin_bit_cast(bf16x8, vw);
#pragma unroll
                    for (int g = 0; g < 2; ++g) o[g][d] = __builtin_amdgcn_mfma_f32_16x16x32_bf16(vf, pf[g][hf], o[g][d], 0, 0, 0);
                }
        }
        }
        if (more) {
#pragma unroll
            for (int sb = 0; sb < 2; ++sb) { LAS unsigned char* nb = lds + (((kp + 1) & 1) * 2 + sb) * ABUF; *(LAS v4u*)(nb + kdst0) = r0[sb]; if (has1) *(LAS v4u*)(nb + kdst1) = r1[sb]; *(LAS v4u*)(nb + vdst) = r2[sb]; } }
        __syncthreads();
    }
    bf16* Y = (bf16*)(p.ws + WS_Y) + (size_t)2 * T * 512;
#pragma unroll
    for (int g = 0; g < 2; ++g) {
        float lt = lsum[g]; lt += __shfl_xor(lt, 16); lt += __shfl_xor(lt, 32);
        const float inv = 1.0f / lt;
        bf16* yp = Y + (tok0 + q0w + 16 * g + fr) * 512 + h * 64 + fq * 4;
#pragma unroll
        for (int d = 0; d < 4; ++d) { v2u w; w.x = pkhw(o[g][d][0] * inv, o[g][d][1] * inv); w.y = pkhw(o[g][d][2] * inv, o[g][d][3] * inv); *(v2u*)(yp + d * 16) = w; }
    }
}

__device__ __forceinline__ void swa_unit(const Ctx& C, const Params& p, int l, int unit) {
    int tid_ = threadIdx.x; asm volatile("" : "+v"(tid_));
    const int tid = tid_, lane = tid & 63, fr = lane & 15, fq = lane >> 4, wave_ = __builtin_amdgcn_readfirstlane(tid >> 6);
    const int b = unit >> 5, kvh = (unit >> 4) & 1, qb = unit & 15;
    const int q0w = qb * 256 + wave_ * 32;
    const size_t tok0 = (size_t)b * SEQ;
    const bf16* P = (const bf16*)(p.ws + WS_P); const bf16* VTA = (const bf16*)(p.ws + WS_VTA);
    LAS unsigned char* lds = C.lds;
    constexpr int SROW = 144, STILE = 2 * 64 * SROW;
    LAS float* btl = (LAS float*)(lds + 6 * STILE);
    const int kt_lo = (4 * qb - 2 > 0) ? 4 * qb - 2 : 0, kt_hi = 4 * qb + 3, ntile = kt_hi - kt_lo + 1;
    const int my_lo = (q0w - 127 > 0 ? q0w - 127 : 0) >> 6, my_hi = (q0w + 31) >> 6;
    {
        const bf16* ksrc = P + (tok0 + (size_t)kt_lo * 64 + (tid >> 3)) * PN + C_KA + kvh * 64 + (tid & 7) * 8;
        const bf16* vsrc = VTA + (size_t)(kvh * 64 + (tid >> 3)) * T + tok0 + (size_t)kt_lo * 64 + (tid & 7) * 8;
        const int dst = (tid >> 3) * SROW + (tid & 7) * 16;
        v4u rk[6], rv[6];
#pragma unroll
        for (int t = 0; t < 6; ++t) if (t < ntile) { rk[t] = *(const v4u*)(ksrc + (size_t)t * 64 * PN); rv[t] = *(const v4u*)(vsrc + (size_t)t * 64); }
        for (int i = tid; i < 4 * 129; i += 512) { const int hh = i / 129, n = i - hh * 129; btl[i] = ((const float*)(p.ws + WS_BT))[n * 8 + kvh * 4 + hh] * LOG2E; }
#pragma unroll
        for (int t = 0; t < 6; ++t) if (t < ntile) { *(LAS v4u*)(lds + t * STILE + dst) = rk[t]; *(LAS v4u*)(lds + t * STILE + 64 * SROW + dst) = rv[t]; }
    }
    __syncthreads();
    const float c2 = 0.125f * LOG2E;
    int pq[2];
#pragma unroll
    for (int g = 0; g < 2; ++g) pq[g] = p.pos[tok0 + q0w + 16 * g + fr];
#pragma unroll 1
    for (int hh = 0; hh < 4; ++hh) {
        const int h = kvh * 4 + hh;
        const LAS float* bth = btl + hh * 129;
        bf16x8 qf[2][2];
#pragma unroll
        for (int g = 0; g < 2; ++g) { const bf16* qp = P + (tok0 + q0w + 16 * g + fr) * PN + C_QA + h * 64 + fq * 8; qf[g][0] = *(const bf16x8*)qp; qf[g][1] = *(const bf16x8*)(qp + 32); }
        const float sink2 = p.sinks[l * 8 + h] * LOG2E;
        float m[2] = {sink2, sink2}, lsum[2] = {0.f, 0.f};
        f32x4 o[2][4];
#pragma unroll
        for (int g = 0; g < 2; ++g)
#pragma unroll
            for (int d = 0; d < 4; ++d) o[g][d] = (f32x4){0.f, 0.f, 0.f, 0.f};
#pragma unroll 1
        for (int kt = my_lo; kt <= my_hi; ++kt) {
            const LAS unsigned char* Kb = lds + (kt - kt_lo) * STILE; const LAS unsigned char* Vb = Kb + 64 * SROW;
            const int k0 = kt * 64;
            f32x4 s[2][4];
#pragma unroll
            for (int g = 0; g < 2; ++g)
#pragma unroll
                for (int blk = 0; blk < 4; ++blk) s[g][blk] = (f32x4){0.f, 0.f, 0.f, 0.f};
#pragma unroll
            for (int kk = 0; kk < 2; ++kk)
#pragma unroll
                for (int blk = 0; blk < 4; ++blk) {
                    const bf16x8 kf = *(const LAS bf16x8*)(Kb + (blk * 16 + fr) * SROW + (kk * 32 + fq * 8) * 2);
#pragma unroll
                    for (int g = 0; g < 2; ++g) s[g][blk] = __builtin_amdgcn_mfma_f32_16x16x32_bf16(kf, qf[g][kk], s[g][blk], 0, 0, 0);
                }
            bf16x8 pf[2][2];
#pragma unroll
            for (int g = 0; g < 2; ++g) {
                const int qi = q0w + 16 * g + fr;
#pragma unroll
                for (int blk = 0; blk < 4; ++blk) { const int4 t4 = *(const int4*)(p.pos + tok0 + k0 + blk * 16 + fq * 4); const int pkv[4] = {t4.x, t4.y, t4.z, t4.w};
#pragma unroll
                    for (int j = 0; j < 4; ++j) { const int key = k0 + blk * 16 + fq * 4 + j; int dd = pq[g] - pkv[j]; dd = dd < 0 ? 0 : (dd > 128 ? 128 : dd);
                        const float v = s[g][blk][j] * c2 + bth[dd]; const bool ok = (key <= qi) && (qi - key < 128); s[g][blk][j] = ok ? v : -1e30f; } }
                float mx = fmaxf(s[g][0][0], s[g][0][1]);
                mx = fmaxf(fmaxf(mx, s[g][0][2]), s[g][0][3]);
#pragma unroll
                for (int blk = 1; blk < 4; ++blk) { mx = fmaxf(fmaxf(mx, s[g][blk][0]), s[g][blk][1]); mx = fmaxf(fmaxf(mx, s[g][blk][2]), s[g][blk][3]); }
                mx = fmaxf(mx, __shfl_xor(mx, 16)); mx = fmaxf(mx, __shfl_xor(mx, 32));
                const float mn = fmaxf(m[g], mx), alpha = __builtin_amdgcn_exp2f(m[g] - mn); m[g] = mn;
                float ps = 0.f;
#pragma unroll
                for (int blk = 0; blk < 4; ++blk)
#pragma unroll
                    for (int j = 0; j < 4; ++j) { const float pv = __builtin_amdgcn_exp2f(s[g][blk][j] - mn); s[g][blk][j] = pv; ps += pv; }
                lsum[g] = lsum[g] * alpha + ps;
#pragma unroll
                for (int d = 0; d < 4; ++d) o[g][d] = o[g][d] * alpha;
#pragma unroll
                for (int hf = 0; hf < 2; ++hf) { v4u pw; pw.x = pkhw(s[g][2 * hf][0], s[g][2 * hf][1]); pw.y = pkhw(s[g][2 * hf][2], s[g][2 * hf][3]); pw.z = pkhw(s[g][2 * hf + 1][0], s[g][2 * hf + 1][1]); pw.w = pkhw(s[g][2 * hf + 1][2], s[g][2 * hf + 1][3]);
                    pf[g][hf] = __builtin_bit_cast(bf16x8, pw); }
            }
#pragma unroll
            for (int hf = 0; hf < 2; ++hf)
#pragma unroll
                for (int d = 0; d < 4; ++d) {
                    const LAS unsigned char* vp = Vb + (d * 16 + fr) * SROW + (hf * 32 + fq * 4) * 2;
                    const v2u lo = *(const LAS v2u*)vp, hi = *(const LAS v2u*)(vp + 32);
                    const v4u vw = (v4u){lo.x, lo.y, hi.x, hi.y}; const bf16x8 vf = __builtin_bit_cast(bf16x8, vw);
#pragma unroll
                    for (int g = 0; g < 2; ++g) o[g][d] = __builtin_amdgcn_mfma_f32_16x16x32_bf16(vf, pf[g][hf], o[g][d], 0, 0, 0);
                }
        }
        bf16* Y = (bf16*)(p.ws + WS_Y);
#pragma unroll
        for (int g = 0; g < 2; ++g) {
            float lt = lsum[g]; lt += __shfl_xor(lt, 16); lt += __shfl_xor(lt, 32);
            lt += __builtin_amdgcn_exp2f(sink2 - m[g]);
            const float inv = 1.0f / lt;
            bf16* yp = Y + (tok0 + q0w + 16 * g + fr) * 512 + h * 64 + fq * 4;
#pragma unroll
            for (int d = 0; d < 4; ++d) { v2u w; w.x = pkhw(o[g][d][0] * inv, o[g][d][1] * inv); w.y = pkhw(o[g][d][2] * inv, o[g][d][3] * inv); *(v2u*)(yp + d * 16) = w; }
        }
    }
    __syncthreads();
}

#ifndef DBG_NAIVE
#define DBG_NAIVE 0
#endif
#if DBG_NAIVE
__device__ __forceinline__ int t5b_n(int rel) { int n = rel < 0 ? 0 : rel; if (n < 16) return n; float nf = (float)n; int lg = 16 + (int)(logf(nf / 16.0f) / 2.0794415416798357f * 16.0f); return lg < 31 ? lg : 31; }
__device__ __forceinline__ void naive_conv(const Ctx& C, const Params& p, int l) {
    LAS float* red = (LAS float*)C.lds; const bf16* P = (const bf16*)(p.ws + WS_P); bf16* Y = (bf16*)(p.ws + WS_Y) + (size_t)T * 512; const int c = C.tid;
    for (int t = C.bid; t < T; t += C.G) {
        const int s = t & (SEQ - 1); float acc = p.b_dw[l * 512 + c];
        for (int j = 0; j < 31; ++j) { const int ss = s - 30 + j; if (ss >= 0) { const bf16* row = P + (size_t)(t - 30 + j) * PN + C_UB; const float a = bf2f(row[c]), g = bf2f(row[512 + c]); acc += p.w_dw[(size_t)l * 31 * 512 + j * 512 + c] * (a / (1.f + expf(-g))); } }
        float sw = wave_sum(acc); if (C.lane == 0) red[C.wave] = sw; __syncthreads();
        float tot = 0.f; for (int w = 0; w < 8; ++w) tot += red[w]; const float mean = tot / 512.f; __syncthreads();
        const float dv = acc - mean; sw = wave_sum(dv * dv); if (C.lane == 0) red[C.wave] = sw; __syncthreads();
        tot = 0.f; for (int w = 0; w < 8; ++w) tot += red[w]; __syncthreads();
        float y = dv / sqrtf(tot / 512.f + EPS) * p.g_cln[l * 512 + c] + p.b_cln[l * 512 + c]; y = y / (1.f + expf(-y));
        Y[(size_t)t * 512 + c] = (bf16)f2bf(y);
    }
}
__device__ __forceinline__ void naive_swa(const Ctx& C, const Params& p, int l) {
    const bf16* P = (const bf16*)(p.ws + WS_P); bf16* Y = (bf16*)(p.ws + WS_Y);
    for (int it = C.bid * 512 + C.tid; it < T * 8; it += C.G * 512) {
        const int t = it >> 3, h = it & 7, s = t & (SEQ - 1), b0 = t - s; const bf16* q = P + (size_t)t * PN + h * 64;
        float qv[64];
#pragma unroll
        for (int d = 0; d < 64; ++d) qv[d] = bf2f(q[d]);
        float acc[64];
#pragma unroll
        for (int d = 0; d < 64; ++d) acc[d] = 0.f;
        const float sink = p.sinks[l * 8 + h]; float m = sink, lsum = 0.f;
        for (int ks = (s - 127 > 0 ? s - 127 : 0); ks <= s; ++ks) { const bf16* kr = P + (size_t)(b0 + ks) * PN + C_KA + (h >> 2) * 64; float sc = 0.f;
#pragma unroll
            for (int d = 0; d < 64; ++d) sc += qv[d] * bf2f(kr[d]);
            sc = sc * 0.125f + p.rel_bias[t5b_n(p.pos[t] - p.pos[b0 + ks]) * 8 + h];
            const float mn = fmaxf(m, sc), al = expf(m - mn), pp = expf(sc - mn); lsum = lsum * al + pp; m = mn; const bf16* vr = P + (size_t)(b0 + ks) * PN + C_VA + (h >> 2) * 64;
#pragma unroll
            for (int d = 0; d < 64; ++d) acc[d] = acc[d] * al + pp * bf2f(vr[d]); }
        lsum += expf(sink - m);
#pragma unroll
        for (int d = 0; d < 64; ++d) Y[(size_t)t * 512 + h * 64 + d] = (bf16)f2bf(acc[d] / lsum);
    }
}
__device__ __forceinline__ void naive_mla(const Ctx& C, const Params& p, int l) {
    const bf16* P = (const bf16*)(p.ws + WS_P); const bf16* QM = (const bf16*)(p.ws + WS_QM); const bf16* KM = (const bf16*)(p.ws + WS_KM); const bf16* VTM = (const bf16*)(p.ws + WS_VTM);
    bf16* Y = (bf16*)(p.ws + WS_Y) + (size_t)2 * T * 512; LAS float* qs = (LAS float*)C.lds + C.wave * 128;
    for (int it = C.bid * 8 + C.wave; it < T * 8; it += C.G * 8) {
        const int t = it >> 3, h = it & 7, s = t & (SEQ - 1), b0 = t - s; const bf16* q = QM + (size_t)t * 768 + h * 96;
        asm volatile("s_waitcnt lgkmcnt(0)" ::: "memory");
        qs[C.lane] = bf2f(q[C.lane]);
        if (C.lane < 16) { const float ang = (float)p.pos[t] * expf(-9.210340371976184f * (float)C.lane / 16.f); const float cc = __cosf(ang), sn = __sinf(ang);
            const float x1 = bf2f(q[64 + C.lane]), x2 = bf2f(q[80 + C.lane]); qs[64 + C.lane] = x1 * cc - x2 * sn; qs[80 + C.lane] = x2 * cc + x1 * sn; }
        asm volatile("s_waitcnt lgkmcnt(0)" ::: "memory");
        float acc[64];
#pragma unroll
        for (int d = 0; d < 64; ++d) acc[d] = 0.f;
        float m = -1e30f, lsum = 0.f;
        for (int ks = C.lane; ks <= s; ks += 64) { const size_t kt = (size_t)(b0 + ks); float sc = 0.f;
            for (int d = 0; d < 64; ++d) sc += qs[d] * bf2f(KM[kt * 512 + h * 64 + d]);
            for (int d = 0; d < 32; ++d) sc += qs[64 + d] * bf2f(P[kt * PN + C_KPE + d]);
            sc *= 0.10206207261596577f;
            const float mn = fmaxf(m, sc), al = expf(m - mn), pp = expf(sc - mn); lsum = lsum * al + pp; m = mn;
#pragma unroll
            for (int d = 0; d < 64; ++d) acc[d] = acc[d] * al + pp * bf2f(VTM[(size_t)(h * 64 + d) * T + kt]); }
        float mg = m;
#pragma unroll
        for (int o = 1; o < 64; o <<= 1) mg = fmaxf(mg, __shfl_xor(mg, o));
        const float f = expf(m - mg); const float lt = wave_sum(lsum * f);
#pragma unroll
        for (int d = 0; d < 64; ++d) { const float v = wave_sum(acc[d] * f); if (C.lane == (d & 63)) Y[(size_t)t * 512 + h * 64 + d] = (bf16)f2bf(v / lt); }
    }
}
#endif

#define XB_TMO      128
#define XB_XCNT(j)  (256  + 64 * (j))
#define XB_XSUB(j)  (1280 + 64 * (j))
#define XB_XGEN(j)  (2304 + 64 * (j))
#define XB_TOP      3328
#define XB_TOPGEN   3392
#define XCD_BAR_WORDS 3456
#define XB_SPIN_CAP (1u << 18)

__device__ __forceinline__ unsigned xb_ld(unsigned* p)              { return __hip_atomic_load(p, __ATOMIC_RELAXED, __HIP_MEMORY_SCOPE_AGENT); }
__device__ __forceinline__ unsigned xb_add(unsigned* p, unsigned v) { return __hip_atomic_fetch_add(p, v, __ATOMIC_RELAXED, __HIP_MEMORY_SCOPE_AGENT); }
__device__ __forceinline__ unsigned xb_xcc_id() { return (unsigned)__builtin_amdgcn_s_getreg((3 << 11) | 20) & 0xFu; }
#define XB_SPIN(cond, bar) do { unsigned _sp = 0; while (cond) { __builtin_amdgcn_s_sleep(1); \
    if ((++_sp & 255u) == 0u) { if (xb_ld(&(bar)[XB_TMO])) break; if (_sp > XB_SPIN_CAP) { atomicAdd(&(bar)[XB_TMO], 1u); break; } } } } while (0)

struct XcdBarrier {
    unsigned* bar; unsigned x;
    volatile LAS unsigned* st;
};

__device__ __forceinline__ XcdBarrier xcd_barrier_post(unsigned* bar, volatile LAS unsigned* st) {
    XcdBarrier b; b.bar = bar; b.x = xb_xcc_id(); b.st = st;
    if (threadIdx.x == 0) (void)xb_add(&bar[XB_XCNT(b.x)], 1u);
    return b;
}
__device__ __forceinline__ void xcd_barrier_complete(unsigned* bar, unsigned x, unsigned& nloc, unsigned& nx) {
    const unsigned G = gridDim.x * gridDim.y * gridDim.z;
    unsigned sum, cnt, mine, sp = 0u;
    for (;;) {
        sum = 0u; cnt = 0u; mine = 0u;
#pragma unroll
        for (unsigned j = 0; j < 16; ++j) { const unsigned c = xb_ld(&bar[XB_XCNT(j)]); sum += c; cnt += (c > 0u) ? 1u : 0u; mine = (j == x) ? c : mine; }
        if (sum == G) break;
        __builtin_amdgcn_s_sleep(1);
        if ((++sp & 255u) == 0u) { if (xb_ld(&bar[XB_TMO])) break; if (sp > XB_SPIN_CAP) { atomicAdd(&bar[XB_TMO], 1u); break; } }
    }
    nloc = mine > 0u ? mine : 1u; nx = cnt > 0u ? cnt : 1u;
}

__device__ __forceinline__ void xcd_barrier(const XcdBarrier& b) {
    asm volatile("s_waitcnt vmcnt(0)" ::: "memory");
    __syncthreads();
    if (threadIdx.x == 0) {
        unsigned* bar = b.bar;
        __builtin_amdgcn_s_waitcnt(0);
        unsigned nloc = b.st[0], nx = b.st[1];
        if (nloc == 0u) { xcd_barrier_complete(bar, b.x, nloc, nx); b.st[0] = nloc; b.st[1] = nx; }
        const unsigned old = xb_add(&bar[XB_XSUB(b.x)], 1u);
        const unsigned gen = old / nloc;
        if (old + 1u == (gen + 1u) * nloc) {
            __builtin_amdgcn_fence(__ATOMIC_RELEASE, "agent");
            asm volatile("s_waitcnt vmcnt(0)" ::: "memory");
            const unsigned og = xb_add(&bar[XB_TOP], 1u);
            const unsigned tg = og / nx;
            if (og + 1u == (tg + 1u) * nx) xb_add(&bar[XB_TOPGEN], 1u);
            else XB_SPIN(xb_ld(&bar[XB_TOPGEN]) == tg, bar);
            __builtin_amdgcn_fence(__ATOMIC_ACQUIRE, "agent");
            xb_add(&bar[XB_XGEN(b.x)], 1u);
            asm volatile("s_waitcnt vmcnt(0)" ::: "memory");
        } else {
            XB_SPIN(xb_ld(&bar[XB_XGEN(b.x)]) == gen, bar);
            __builtin_amdgcn_fence(__ATOMIC_ACQUIRE, "agent");
            asm volatile("s_waitcnt vmcnt(0)" ::: "memory");
        }
    }
    __syncthreads();
}

template <int MODE>
__device__ __forceinline__ void run_gemm(const Ctx& C, const bf16* A, int lda, const bf16* Bt, int ldb, int M, int N, int K, const pg8::Epi<MODE>& E, int crot = 0) {
    pg8::Gemm g{A, Bt, lda, ldb, M, N, K}; pg8::StaticOrder S; S.init(M, N, C.G, (C.bid + crot) % C.G);
    pg8::gemm_phase<pg8::Epi<MODE>, pg8::StaticOrder, true, true>(C.lds, g, S, E);
    __syncthreads();
}

#define GSYNC() do { xcd_barrier(xbar); } while (0)
__global__ void __launch_bounds__(512) mega_fwd(Params p) {
    extern __shared__ __attribute__((aligned(16))) unsigned char lds_raw[];
    cg::grid_group grid = cg::this_grid();
    Ctx C; C.lds = (LAS unsigned char*)lds_raw; C.tid = threadIdx.x; C.lane = C.tid & 63; C.wave = __builtin_amdgcn_readfirstlane(C.tid >> 6); C.G = gridDim.x; C.bid = blockIdx.x;
    unsigned char* ws = p.ws;
    bf16* W = (bf16*)(ws + WS_W); bf16* H = (bf16*)(ws + WS_H); bf16* P = (bf16*)(ws + WS_P); bf16* Y = (bf16*)(ws + WS_Y);
    bf16* QM = (bf16*)(ws + WS_QM); bf16* KM = (bf16*)(ws + WS_KM); bf16* VTM = (bf16*)(ws + WS_VTM); bf16* VTA = (bf16*)(ws + WS_VTA);
    bf16* MG = (bf16*)(ws + WS_MG); bf16* GS = (bf16*)(ws + WS_GS); bf16* HID = (bf16*)(ws + WS_HID);

    volatile LAS unsigned* xst = (volatile LAS unsigned*)(C.lds + RING_BYTES + 64);
    if (threadIdx.x < 2) xst[threadIdx.x] = 0u;
    __syncthreads();
    XcdBarrier xbar = xcd_barrier_post((unsigned*)(p.ws), xst);
    phase_tables(C, p);
    asm volatile("s_waitcnt vmcnt(0) lgkmcnt(0)" ::: "memory"); grid.sync();
    for (int l = 0; l < DEPTH; ++l) {
        { int t_ = threadIdx.x; asm volatile("" : "+v"(t_)); C.tid = t_; C.lane = t_ & 63; C.wave = __builtin_amdgcn_readfirstlane(t_ >> 6); }
        const float* xcur = (l == 0) ? p.x : p.out;
        for (int rep_ = 0; rep_ < DBG_REP_A; ++rep_) {
        phase_convert_weights(C, p, l);
        phase_norm(C, xcur, p.g_mix + l * DM, H);
        }
        GSYNC();
        for (int rep_ = 0; rep_ < DBG_XSYNC; ++rep_) GSYNC();
        for (int rep_ = 0; rep_ < DBG_REP_G; ++rep_) {
        { pg8::Epi<pg8::EPI_BF16> E{P, PN, nullptr, 0, nullptr, nullptr, 1.f}; run_gemm(C, H, DM, W + WO_IN, DM, T, PN, DM, E); }
        { pg8::Epi<pg8::EPI_BF16> E{VTA, T, nullptr, 0, nullptr, nullptr, 1.f}; run_gemm(C, W + WO_IN + (size_t)C_VA * DM, DM, H, DM, 256, T, DM, E, C.G / 2); }
        }
        GSYNC();
        {
            rownorm_rows(C, p, l, C.bid * 8 + C.wave, C.G * 8);
            for (int rep_ = 0; rep_ < DBG_REP_C; ++rep_) {
#if DBG_NAIVE & 1
            naive_swa(C, p, l);
#else
#ifdef SWA_V1
            for (int u = C.bid; u < 2048; u += C.G) attn_unit<true>(C, p, l, u);
#else
            for (int rs_ = 0; rs_ < DBG_REP_S; ++rs_) for (int u = C.bid; u < 256; u += C.G) swa_unit(C, p, l, u);
#endif
#endif
#if DBG_NAIVE & 2
            naive_conv(C, p, l);
#else
            for (int u = C.bid; u < T / 32; u += C.G) conv_unit(C, p, l, u);
#endif
            }
        }
        GSYNC();
        for (int rep_ = 0; rep_ < DBG_REP_G; ++rep_) {
        { pg8::Epi<pg8::EPI_BF16> E{QM, 768, nullptr, 0, nullptr, nullptr, 1.f}; run_gemm(C, P + C_CQ, PN, W + WO_Q, 256, T, 768, 256, E); }
        { pg8::Epi<pg8::EPI_BF16> E{KM, 512, nullptr, 0, nullptr, nullptr, 1.f}; run_gemm(C, P + C_CKV, PN, W + WO_K, 256, T, 512, 256, E); }
        { pg8::Epi<pg8::EPI_BF16> E{VTM, T, nullptr, 0, nullptr, nullptr, 1.f}; run_gemm(C, W + WO_V, 256, P + C_CKV, PN, 512, T, 256, E); }
        }
        GSYNC();
#if DBG_NAIVE & 4
        naive_mla(C, p, l);
#else
#ifdef MLA_V1
        for (int rep = 0; rep < DBG_REP_E; ++rep) for (int u = C.bid; u < 2048; u += C.G) attn_unit<false>(C, p, l, u);
#else
        for (int rep_ = 0; rep_ < DBG_REP_E; ++rep_) for (int u = C.bid; u < 1024; u += C.G) mla_unit(C, p, u);
#endif
#endif
        GSYNC();
#ifndef DBG_REP_E
#define DBG_REP_E 1
#endif
#ifndef DBG_REP_G
#define DBG_REP_G 1
#endif
#ifndef DBG_REP_C
#define DBG_REP_C 1
#endif
#ifndef DBG_SKIP
#define DBG_SKIP 0
#endif
#ifndef DBG_DBL
#define DBG_DBL 0
#endif
        for (int rep_ = 0; rep_ < DBG_REP_G; ++rep_) { int firstn = 1;
        for (int n = 0; n < 3; ++n) {
            if ((DBG_SKIP >> n) & 1) continue;
            { pg8::Epi<pg8::EPI_SIG> E{GS, DM, nullptr, 0, nullptr, nullptr, 1.f}; run_gemm(C, H, DM, W + WO_G + (size_t)n * DM * DM, DM, T, DM, DM, E); }
#ifdef DBG_FSYNC
            GSYNC();
#endif
            { pg8::Epi<pg8::EPI_GATEMUL> E{MG, DM, GS, firstn, nullptr, nullptr, ((DBG_DBL >> n) & 1) ? 2.f : 1.f}; run_gemm(C, Y + (size_t)n * T * 512, 512, W + WO_B + (size_t)n * DM * 512, 512, T, DM, 512, E); }
            firstn = 0;
        } }
        GSYNC();
        { pg8::Epi<pg8::EPI_RES> E{nullptr, DM, nullptr, 0, xcur, p.out, 1.f}; run_gemm(C, MG, DM, W + WO_O, DM, T, DM, DM, E); }
        GSYNC();
        for (int rep_ = 0; rep_ < DBG_REP_A; ++rep_) phase_norm(C, p.out, p.g_mlp + l * DM, H);
        GSYNC();
        for (int rep_ = 0; rep_ < DBG_REP_G; ++rep_)
        { pg8::Epi<pg8::EPI_RELU2> E{HID, DFF, nullptr, 0, nullptr, nullptr, 1.f}; run_gemm(C, H, DM, W + WO_U, DM, T, DFF, DM, E); }
        GSYNC();
        { pg8::Epi<pg8::EPI_RES> E{nullptr, DM, nullptr, 0, p.out, p.out, 1.f}; run_gemm(C, HID, DFF, W + WO_D, DFF, T, DM, DFF, E); }
        GSYNC();
    }
    phase_final_norm(C, p.g_final, p.out);
}

extern "C" void kernel_launch(void* const* d_in, const int* in_sizes, int n_in, void* d_out, int out_size, void* d_ws, size_t ws_size, hipStream_t stream) {
    static int grid = 0;
    if (grid == 0) {
        int dev = 0, cus = 0, per_cu = 0;
        hipGetDevice(&dev);
        hipDeviceGetAttribute(&cus, hipDeviceAttributeMultiprocessorCount, dev);
        hipFuncSetAttribute((const void*)mega_fwd, hipFuncAttributeMaxDynamicSharedMemorySize, LDS_BYTES);
        hipOccupancyMaxActiveBlocksPerMultiprocessor(&per_cu, (const void*)mega_fwd, 512, LDS_BYTES);
        if (per_cu < 1) per_cu = 1;
        grid = cus * per_cu;
        if (ws_size < WS_END) fprintf(stderr, "kernel_launch: workspace too small: %zu < %zu\n", ws_size, (size_t)WS_END);
    }
    Params p{};
    p.x = (const float*)d_in[0]; p.pos = (const int*)d_in[1]; p.rel_bias = (const float*)d_in[2]; p.g_final = (const float*)d_in[3]; p.g_mix = (const float*)d_in[4];
    p.w_in = (const float*)d_in[5]; p.sinks = (const float*)d_in[6]; p.g_qn = (const float*)d_in[7]; p.w_qup = (const float*)d_in[8]; p.g_kvn = (const float*)d_in[9];
    p.w_kvup = (const float*)d_in[10]; p.w_dw = (const float*)d_in[11]; p.b_dw = (const float*)d_in[12]; p.g_cln = (const float*)d_in[13]; p.b_cln = (const float*)d_in[14];
    p.w_branch = (const float*)d_in[15]; p.w_out = (const float*)d_in[16]; p.g_mlp = (const float*)d_in[17]; p.w_up = (const float*)d_in[18]; p.w_down = (const float*)d_in[19];
    p.out = (float*)d_out; p.ws = (unsigned char*)d_ws;
    hipMemsetAsync(d_ws, 0, XCD_BAR_WORDS * 4, stream);
    void* args[] = {&p};
    hipError_t e = hipLaunchCooperativeKernel((const void*)mega_fwd, dim3(grid), dim3(512), args, LDS_BYTES, stream);
    if (e != hipSuccess) fprintf(stderr, "cooperative launch failed: %s (grid %d)\n", hipGetErrorString(e), grid);
}
```

```cpp
#include <hip/hip_runtime.h>
#include <hip/hip_cooperative_groups.h>
#include <cstdio>
#include <cstdint>
namespace cg = cooperative_groups;

#ifndef DBG_REP_E
#define DBG_REP_E 1
#endif
#ifndef DBG_REP_G
#define DBG_REP_G 1
#endif
#ifndef DBG_REP_C
#define DBG_REP_C 1
#endif
#ifndef DBG_REP_A
#define DBG_REP_A 1
#endif
#ifndef DBG_XSYNC
#define DBG_XSYNC 0
#endif
#ifndef DBG_REP_S
#define DBG_REP_S 1
#endif
namespace pg8 {
#define PG8_LAS __attribute__((address_space(3)))
typedef unsigned short bf16_t;
typedef short bf16x8 __attribute__((ext_vector_type(8)));
typedef float f32x4 __attribute__((ext_vector_type(4)));
typedef unsigned u32x4 __attribute__((ext_vector_type(4)));
constexpr int BM = 256, BK = 64, HALF = 128, HTB = HALF * BK * 2  , STAGE_BYTES = 8 * HTB, NXCD = 8, WGM = 8;

__host__ __device__ __forceinline__ int lds_byte(int r, int c) { const int st = (r >> 4) * 2 + (c >> 5), rr = r & 15, cc = c & 31, ob = rr * 64 + cc * 2; return st * 1024 + (ob ^ (((ob >> 9) & 1) << 5)); }
__host__ __device__ __forceinline__ void stage_rc(int b, int& R, int& C) { const int st = b / 1024, sb = b % 1024, swz = sb ^ (((sb >> 9) & 1) << 5); R = (st >> 1) * 16 + swz / 64; C = (st & 1) * 32 + (swz % 64) / 2; }
__host__ __device__ __forceinline__ int perm32(int rho) { const int n = rho >> 4, i = rho & 15; return 8 * (i >> 2) + 4 * n + (i & 3); }

struct Unit { int pm, pn; };
struct Gemm { const bf16_t* A; const bf16_t* Bt; int lda, ldb, M, N, K; };

struct StaticOrder {
    int nM, nN, nwg, G, c;
    __host__ __device__ void init(int M, int N, int G_, int c_) { nM = M / BM; nN = N / BM; nwg = nM * nN; G = G_; c = c_; }
    __host__ __device__ bool next(int i, Unit& u) const {
        const long L = (long)i * G + c; if (L >= nwg) return false;
        int wgid = (int)L; { const int q = nwg / NXCD, r = nwg % NXCD, xcd = wgid % NXCD, off = wgid / NXCD; wgid = (xcd < r ? xcd * (q + 1) : r * (q + 1) + (xcd - r) * q) + off; }
        const int nig = WGM * nN, gid = wgid / nig, fm = gid * WGM, gsz = (nM - fm) < WGM ? (nM - fm) : WGM;
        u.pm = fm + ((wgid % nig) % gsz); u.pn = (wgid % nig) / gsz; return true;
    }
    __device__ __forceinline__ void a_ready(const Unit&) const {}
    __device__ __forceinline__ void done(const Unit&) const {}
};

__device__ __forceinline__ unsigned cvt_pk_bf16(float lo, float hi) { unsigned r; asm volatile("v_cvt_pk_bf16_f32 %0, %1, %2" : "=v"(r) : "v"(lo), "v"(hi)); return r; }

template <class Epi, class Sched, bool ALIGN_EPI = false, bool SP2 = false>
__device__ __forceinline__ void gemm_phase(PG8_LAS unsigned char* lds, const Gemm g, const Sched& S, const Epi& E) {
    int tid_ = threadIdx.x; asm volatile("" : "+v"(tid_));
    const int tid = tid_, wid = __builtin_amdgcn_readfirstlane(tid >> 6), lane = tid & 63, wr = wid >> 2, wc = wid & 3, fr = lane & 15, fq = lane >> 4;
    const int K = g.K, nt = K / BK;
    unsigned voffA[2], voffB[2];
#pragma unroll
    for (int i = 0; i < 2; ++i) { int R, C; stage_rc(tid * 16 + i * 8192, R, C); const int Rb = Epi::PERM ? ((R & ~31) + perm32(R & 31)) : R;
        voffA[i] = (unsigned)(R * g.lda + C) * 2u; voffB[i] = (unsigned)(Rb * g.ldb + C) * 2u; }
    const size_t kstep = (size_t)(BK * 2);
    const size_t hstepA = (size_t)HALF * g.lda * 2, hstepB = (size_t)HALF * g.ldb * 2;
    const size_t tstepA = 2 * hstepA, tstepB = 2 * hstepB;
    const unsigned ldsw = (unsigned)wid * 1024u;
    const int aoff = lds_byte(wr * 64 + fr, fq * 8), boff = lds_byte(wc * 32 + fr, fq * 8);
#define PG8_SA(b, h) (((b) * 2 + (h)) * HTB)
#define PG8_SB(b, h) ((4 + (b) * 2 + (h)) * HTB)
#define PG8_STAGE(bufoff, gbase, voff) do { _Pragma("unroll") for (int _i = 0; _i < 2; ++_i) \
        __builtin_amdgcn_global_load_lds((const unsigned*)((const char*)(gbase) + (voff)[_i]), (PG8_LAS unsigned*)(lds + (bufoff) + ldsw + _i * 8192), 16, 0, 0); } while (0)
#define PG8_LDA(dst, b, h) do { _Pragma("unroll") for (int m = 0; m < 4; ++m) _Pragma("unroll") for (int k = 0; k < 2; ++k) dst[m][k] = *(const PG8_LAS bf16x8*)(lds + PG8_SA(b, h) + aoff + m * 2048 + k * 1024); } while (0)
#define PG8_LDB(dst, b, h) do { _Pragma("unroll") for (int n = 0; n < 2; ++n) _Pragma("unroll") for (int k = 0; k < 2; ++k) dst[n][k] = *(const PG8_LAS bf16x8*)(lds + PG8_SB(b, h) + boff + n * 2048 + k * 1024); } while (0)
#define PG8_MMA(ai, bj, At, Bt) do { __builtin_amdgcn_s_setprio(1); _Pragma("unroll") for (int m = 0; m < 4; ++m) _Pragma("unroll") for (int n = 0; n < 2; ++n) _Pragma("unroll") for (int k = 0; k < 2; ++k) \
        acc[ai][bj][m][n] = __builtin_amdgcn_mfma_f32_16x16x32_bf16(Bt[n][k], At[m][k], acc[ai][bj][m][n], 0, 0, 0); __builtin_amdgcn_s_setprio(0); } while (0)
#define PG8_WAIT_V(n) asm volatile("s_waitcnt vmcnt(" #n ")" ::: "memory")
#define PG8_WAIT_L(n) asm volatile("s_waitcnt lgkmcnt(" #n ")" ::: "memory")
#define PG8_BAR __builtin_amdgcn_s_barrier()
#define PG8_SCHED __builtin_amdgcn_sched_barrier(0)
    Unit cur, nxt; int ui = 0;
    if (!S.next(0, cur)) return;
    f32x4 acc[2][2][4][2];
#pragma unroll
    for (int a = 0; a < 2; ++a)
#pragma unroll
        for (int b = 0; b < 2; ++b)
#pragma unroll
            for (int m = 0; m < 4; ++m)
#pragma unroll
                for (int n = 0; n < 2; ++n) acc[a][b][m][n] = (f32x4){0.f, 0.f, 0.f, 0.f};
    bf16x8 At[4][2], B0[2][2], B1[2][2];
    const char* cA = (const char*)g.A + (size_t)cur.pm * tstepA; const char* cB = (const char*)g.Bt + (size_t)cur.pn * tstepB;
    S.a_ready(cur);
    if constexpr (SP2) {
        PG8_STAGE(PG8_SB(0, 0), cB, voffB); PG8_STAGE(PG8_SB(0, 1), cB + hstepB, voffB); PG8_STAGE(PG8_SA(0, 0), cA, voffA); PG8_STAGE(PG8_SA(0, 1), cA + hstepA, voffA);
        if (wr == 1) PG8_BAR;
        PG8_WAIT_V(2); PG8_BAR;
        PG8_STAGE(PG8_SB(1, 0), cB + kstep, voffB); PG8_STAGE(PG8_SA(1, 0), cA + kstep, voffA); PG8_STAGE(PG8_SB(1, 1), cB + hstepB + kstep, voffB);
        PG8_WAIT_V(6); PG8_BAR;
    } else {
        PG8_STAGE(PG8_SB(0, 0), cB, voffB); PG8_STAGE(PG8_SA(0, 0), cA, voffA); PG8_STAGE(PG8_SB(0, 1), cB + hstepB, voffB); PG8_STAGE(PG8_SA(0, 1), cA + hstepA, voffA);
        if (wr == 1) PG8_BAR;
        PG8_WAIT_V(4); PG8_BAR;
        PG8_STAGE(PG8_SB(1, 0), cB + kstep, voffB); PG8_STAGE(PG8_SA(1, 0), cA + kstep, voffA); PG8_STAGE(PG8_SB(1, 1), cB + hstepB + kstep, voffB);
        PG8_WAIT_V(6); PG8_BAR;
    }
    for (;;) {
        const bool has_next = S.next(ui + 1, nxt);
        const char* nA = has_next ? (const char*)g.A + (size_t)nxt.pm * tstepA : cA; const char* nB = has_next ? (const char*)g.Bt + (size_t)nxt.pn * tstepB : cB;
        for (int t = 0; t < nt; t += 2) {
            const bool last = (t == nt - 2);
            const char* a1 = cA + (size_t)(t + 1) * kstep;
            const char* a2 = last ? nA : cA + (size_t)(t + 2) * kstep; const char* b2 = last ? nB : cB + (size_t)(t + 2) * kstep;
            const char* a3 = a2 + kstep; const char* b3 = b2 + kstep;
            if (last && has_next) S.a_ready(nxt);
            if constexpr (SP2) {
            PG8_LDB(B0, 0, 0); PG8_LDB(B1, 0, 1); PG8_SCHED; PG8_LDA(At, 0, 0); PG8_STAGE(PG8_SA(1, 1), a1 + hstepA, voffA);
            PG8_WAIT_V(8); PG8_WAIT_L(0); PG8_BAR; PG8_MMA(0, 0, At, B0); PG8_MMA(0, 1, At, B1); PG8_BAR; PG8_SCHED;
            PG8_LDA(At, 0, 1); PG8_STAGE(PG8_SB(0, 0), b2, voffB); PG8_STAGE(PG8_SB(0, 1), b2 + hstepB, voffB); PG8_STAGE(PG8_SA(0, 0), a2, voffA);
            PG8_WAIT_V(8); PG8_WAIT_L(0); PG8_BAR; PG8_MMA(1, 0, At, B0); PG8_MMA(1, 1, At, B1); PG8_BAR; PG8_SCHED;
            PG8_LDB(B0, 1, 0); PG8_LDB(B1, 1, 1); PG8_SCHED; PG8_LDA(At, 1, 0); PG8_STAGE(PG8_SA(0, 1), a2 + hstepA, voffA);
            PG8_WAIT_V(8); PG8_WAIT_L(0); PG8_BAR; PG8_MMA(0, 0, At, B0); PG8_MMA(0, 1, At, B1); PG8_BAR; PG8_SCHED;
            PG8_LDA(At, 1, 1); PG8_STAGE(PG8_SB(1, 0), b3, voffB); PG8_STAGE(PG8_SB(1, 1), b3 + hstepB, voffB); PG8_STAGE(PG8_SA(1, 0), a3, voffA);
            PG8_WAIT_V(8); PG8_WAIT_L(0); PG8_BAR; PG8_MMA(1, 0, At, B0); PG8_MMA(1, 1, At, B1); PG8_BAR; PG8_SCHED;
            } else {
            PG8_LDB(B0, 0, 0); PG8_SCHED; PG8_LDA(At, 0, 0); PG8_STAGE(PG8_SA(1, 1), a1 + hstepA, voffA);
            PG8_WAIT_L(8); PG8_BAR; PG8_WAIT_L(0); PG8_MMA(0, 0, At, B0); PG8_BAR; PG8_SCHED;
            PG8_LDB(B1, 0, 1); PG8_STAGE(PG8_SB(0, 0), b2, voffB);
            PG8_BAR; PG8_WAIT_L(0); PG8_MMA(0, 1, At, B1); PG8_BAR;
            PG8_LDA(At, 0, 1); PG8_STAGE(PG8_SA(0, 0), a2, voffA);
            PG8_BAR; PG8_WAIT_L(0); PG8_MMA(1, 0, At, B0); PG8_BAR; PG8_SCHED;
            PG8_STAGE(PG8_SB(0, 1), b2 + hstepB, voffB);
            PG8_WAIT_V(6); PG8_BAR; PG8_MMA(1, 1, At, B1); PG8_BAR;
            PG8_LDB(B0, 1, 0); PG8_SCHED; PG8_LDA(At, 1, 0); PG8_STAGE(PG8_SA(0, 1), a2 + hstepA, voffA);
            PG8_WAIT_L(8); PG8_BAR; PG8_WAIT_L(0); PG8_MMA(0, 0, At, B0); PG8_BAR; PG8_SCHED;
            PG8_LDB(B1, 1, 1); PG8_STAGE(PG8_SB(1, 0), b3, voffB);
            PG8_BAR; PG8_WAIT_L(0); PG8_MMA(0, 1, At, B1); PG8_BAR;
            PG8_LDA(At, 1, 1); PG8_STAGE(PG8_SA(1, 0), a3, voffA);
            PG8_BAR; PG8_WAIT_L(0); PG8_MMA(1, 0, At, B0); PG8_BAR; PG8_SCHED;
            PG8_STAGE(PG8_SB(1, 1), b3 + hstepB, voffB);
            PG8_WAIT_V(6); PG8_BAR; PG8_MMA(1, 1, At, B1); PG8_BAR;
            }
        }
        if constexpr (ALIGN_EPI) { if (wr == 0) PG8_BAR; }
        if constexpr (!Epi::AFTER_DRAIN) { E(acc, cur, wr, wc, fr, fq); S.done(cur); }
        if (!has_next) break;
#pragma unroll
        for (int a = 0; a < 2; ++a)
#pragma unroll
            for (int b = 0; b < 2; ++b)
#pragma unroll
                for (int m = 0; m < 4; ++m)
#pragma unroll
                    for (int n = 0; n < 2; ++n) acc[a][b][m][n] = (f32x4){0.f, 0.f, 0.f, 0.f};
        cur = nxt; cA = nA; cB = nB; ++ui;
        if constexpr (ALIGN_EPI) { if (wr == 1) PG8_BAR; }
    }
    PG8_WAIT_V(0);
    if constexpr (!ALIGN_EPI) { if (wr == 0) PG8_BAR; }
    PG8_BAR;
    if constexpr (Epi::AFTER_DRAIN) { E.fused(acc, cur, wr, wc, fr, fq, lds, wid, lane); S.done(cur); }
#undef PG8_SA
#undef PG8_SB
#undef PG8_STAGE
#undef PG8_LDA
#undef PG8_LDB
#undef PG8_MMA
#undef PG8_WAIT_V
#undef PG8_WAIT_L
#undef PG8_BAR
#undef PG8_SCHED
}
}

constexpr int BATCH = 8, SEQ = 4096, DM = 1024, DEPTH = 4, T = BATCH * SEQ;
constexpr int INC = 5280, PN = 2304, DFF = 4096;
constexpr int C_QA = 0, C_KA = 512, C_VA = 640, C_UB = 768, C_CQ = 1792, C_CKV = 2048, C_KPE = 2176, C_GATE = 2208;
constexpr float EPS = 1e-6f, LOG2E = 1.4426950408889634f;
constexpr size_t MiB = 1u << 20;
constexpr size_t WS_ROPE = 1 * MiB;
constexpr size_t WS_BT = 5 * MiB;
constexpr size_t WS_W = 8 * MiB;
constexpr size_t WS_H = 41 * MiB;
constexpr size_t WS_P = 105 * MiB;
constexpr size_t WS_Y = 249 * MiB;
constexpr size_t WS_QM = 345 * MiB;
constexpr size_t WS_KM = 393 * MiB;
constexpr size_t WS_VTM = 425 * MiB;
constexpr size_t WS_VTA = 457 * MiB;
constexpr size_t WS_END = 473 * MiB;
constexpr size_t WS_MG = WS_QM;
constexpr size_t WS_GS = WS_P;
constexpr size_t WS_HID = WS_P;
constexpr size_t WO_IN = 0;
constexpr size_t WO_G = WO_IN + (size_t)2304 * 1024;
constexpr size_t WO_Q = WO_G + (size_t)3072 * 1024;
constexpr size_t WO_K = WO_Q + (size_t)768 * 256;
constexpr size_t WO_V = WO_K + (size_t)512 * 256;
constexpr size_t WO_B = WO_V + (size_t)512 * 256;
constexpr size_t WO_O = WO_B + (size_t)3 * 1024 * 512;
constexpr size_t WO_U = WO_O + (size_t)1024 * 1024;
constexpr size_t WO_D = WO_U + (size_t)4096 * 1024;
constexpr size_t WO_END = WO_D + (size_t)1024 * 4096;
static_assert(WO_END * 2 <= 33 * MiB, "weights fit");

constexpr int RING_BYTES = 131072, LDS_BYTES = 135168;
#define LAS __attribute__((address_space(3)))
typedef unsigned short bf16;
typedef unsigned v4u __attribute__((ext_vector_type(4)));
typedef unsigned v2u __attribute__((ext_vector_type(2)));
typedef float f32x4 __attribute__((ext_vector_type(4)));
typedef float f32x2 __attribute__((ext_vector_type(2)));
typedef short bf16x8 __attribute__((ext_vector_type(8)));

__device__ __forceinline__ unsigned f2bf(float f) { unsigned u = __builtin_bit_cast(unsigned, f); return (u + 0x7fffu + ((u >> 16) & 1u)) >> 16; }
__device__ __forceinline__ unsigned pk2(float lo, float hi) { return f2bf(lo) | (f2bf(hi) << 16); }
typedef float f32x2q __attribute__((ext_vector_type(2))); typedef __bf16 bf16x2q __attribute__((ext_vector_type(2)));
__device__ __forceinline__ unsigned pkhw(float lo, float hi) { f32x2q v = {lo, hi}; bf16x2q b = __builtin_convertvector(v, bf16x2q); return __builtin_bit_cast(unsigned, b); }
__device__ __forceinline__ float bf2f(unsigned short h) { return __builtin_bit_cast(float, (unsigned)h << 16); }
__device__ __forceinline__ float bflo(unsigned w) { return __builtin_bit_cast(float, w << 16); }
__device__ __forceinline__ float bfhi(unsigned w) { return __builtin_bit_cast(float, w & 0xffff0000u); }
__device__ __forceinline__ float wave_sum(float v) {
#pragma unroll
    for (int o = 1; o < 64; o <<= 1) v += __shfl_xor(v, o);
    return v;
}
__device__ __forceinline__ float sigmoidf_(float x) { return __builtin_amdgcn_rcpf(1.0f + __builtin_amdgcn_exp2f(-x * LOG2E)); }

struct Params {
    const float* x; const int* pos; const float* rel_bias; const float* g_final; const float* g_mix; const float* w_in; const float* sinks;
    const float* g_qn; const float* w_qup; const float* g_kvn; const float* w_kvup; const float* w_dw; const float* b_dw; const float* g_cln; const float* b_cln;
    const float* w_branch; const float* w_out; const float* g_mlp; const float* w_up; const float* w_down;
    float* out; unsigned char* ws;
};

namespace pg8 {
enum { EPI_BF16 = 0, EPI_SIG = 1, EPI_GATEMUL = 2, EPI_RES = 3, EPI_RELU2 = 4 };
typedef float f32x2p __attribute__((ext_vector_type(2))); typedef __bf16 bf16x2p __attribute__((ext_vector_type(2)));
__device__ __forceinline__ unsigned pkbf(float lo, float hi) { f32x2p v = {lo, hi}; bf16x2p b = __builtin_convertvector(v, bf16x2p); return __builtin_bit_cast(unsigned, b); }
template <int MODE> struct Epi {
    static constexpr bool PERM = true, AFTER_DRAIN = false;
    bf16_t* O; int ldc; const bf16_t* G; int first; const float* base; float* outf; float bscale;
    __device__ __forceinline__ void operator()(const f32x4 (&acc)[2][2][4][2], const Unit& u, int wr, int wc, int fr, int fq) const {
        const int row0 = u.pm * BM + wr * 64 + fr; const int col0 = u.pn * BM + wc * 32 + 8 * fq;
#pragma unroll
        for (int ai = 0; ai < 2; ++ai)
#pragma unroll
            for (int m = 0; m < 4; ++m) {
                const size_t roff = (size_t)(row0 + ai * HALF + m * 16) * (size_t)ldc + col0;
#pragma unroll
                for (int bj = 0; bj < 2; ++bj) {
                    f32x4 v0 = acc[ai][bj][m][0], v1 = acc[ai][bj][m][1];
                    const size_t off = roff + bj * HALF;
                    if constexpr (MODE == EPI_RES) {
                        const f32x4 b0 = *(const f32x4*)(base + off), b1 = *(const f32x4*)(base + off + 4);
                        *(f32x4*)(outf + off) = b0 + v0; *(f32x4*)(outf + off + 4) = b1 + v1;
                    } else {
                        if constexpr (MODE == EPI_SIG) {
#pragma unroll
                            for (int e = 0; e < 4; ++e) { v0[e] = sigmoidf_(v0[e]); v1[e] = sigmoidf_(v1[e]); }
                        }
                        if constexpr (MODE == EPI_RELU2) {
#pragma unroll
                            for (int e = 0; e < 4; ++e) { float a = fmaxf(v0[e], 0.f), b = fmaxf(v1[e], 0.f); v0[e] = a * a; v1[e] = b * b; }
                        }
                        if constexpr (MODE == EPI_GATEMUL) {
                            const u32x4 gw = *(const u32x4*)(G + off); v0 = v0 * bscale; v1 = v1 * bscale;
                            v0[0] *= bflo(gw.x); v0[1] *= bfhi(gw.x); v0[2] *= bflo(gw.y); v0[3] *= bfhi(gw.y);
                            v1[0] *= bflo(gw.z); v1[1] *= bfhi(gw.z); v1[2] *= bflo(gw.w); v1[3] *= bfhi(gw.w);
                            if (!first) {
                                const u32x4 ow = *(const u32x4*)(O + off);
                                v0[0] += bflo(ow.x); v0[1] += bfhi(ow.x); v0[2] += bflo(ow.y); v0[3] += bfhi(ow.y);
                                v1[0] += bflo(ow.z); v1[1] += bfhi(ow.z); v1[2] += bflo(ow.w); v1[3] += bfhi(ow.w);
                            }
                        }
                        u32x4 w; w.x = pkbf(v0[0], v0[1]); w.y = pkbf(v0[2], v0[3]); w.z = pkbf(v1[0], v1[1]); w.w = pkbf(v1[2], v1[3]);
                        *(u32x4*)(O + off) = w;
                    }
                }
            }
    }
};
}

struct Ctx { LAS unsigned char* lds; int tid, lane, wave, G, bid; };

__device__ __forceinline__ Ctx relaunder(const Ctx& C0) {
    Ctx C = C0; int t_ = C0.tid; asm volatile("" : "+v"(t_)); C.tid = t_; C.lane = t_ & 63; C.wave = __builtin_amdgcn_readfirstlane(t_ >> 6); return C;
}

__device__ __forceinline__ void tr_item(const float* W, int ldw, int c0, bf16* WT, int ldk, int r0, int nblk, int item, LAS float* scr, int lane) {
    const int kb = item / nblk, nb = item % nblk, k0 = 64 * kb, n0 = 32 * nb;
#pragma unroll 8
    for (int i = 0; i < 32; ++i) { const int kk = 2 * i + (lane >> 5); scr[kk * 33 + (lane & 31)] = W[(size_t)(k0 + kk) * ldw + c0 + n0 + (lane & 31)]; }
    asm volatile("s_waitcnt lgkmcnt(0)" ::: "memory");
    const int c = lane & 7;
#pragma unroll
    for (int j = 0; j < 4; ++j) { const int n = (lane >> 3) + 8 * j; const LAS float* s = scr + (8 * c) * 33 + n;
        v4u o; o.x = pk2(s[0 * 33], s[1 * 33]); o.y = pk2(s[2 * 33], s[3 * 33]); o.z = pk2(s[4 * 33], s[5 * 33]); o.w = pk2(s[6 * 33], s[7 * 33]);
        *(v4u*)(WT + (size_t)(r0 + n0 + n) * ldk + k0 + 8 * c) = o; }
    asm volatile("s_waitcnt lgkmcnt(0)" ::: "memory");
}

__device__ __forceinline__ void phase_convert_weights(const Ctx& C0, const Params& p, int l) {
    const Ctx C = relaunder(C0);
    LAS float* scr = (LAS float*)(C.lds + C.wave * 16384);
    bf16* W = (bf16*)(p.ws + WS_W);
    const int gw = C.bid * 8 + C.wave, NGW = C.G * 8;
    const float* w_in = p.w_in + (size_t)l * 1024 * INC;
    const float* w_qup = p.w_qup + (size_t)l * 256 * 768;
    const float* w_kvup = p.w_kvup + (size_t)l * 128 * 1024;
    const float* w_br = p.w_branch + (size_t)l * 3 * 512 * 1024;
    const float* w_out = p.w_out + (size_t)l * 1024 * 1024;
    const float* w_up = p.w_up + (size_t)l * 1024 * 4096;
    const float* w_down = p.w_down + (size_t)l * 4096 * 1024;
    constexpr int I_IN = 16 * 69, I_G = 16 * 96, I_Q = 4 * 24, I_KV = 16 * 4, I_B = 3 * 8 * 32, I_O = 16 * 32, I_U = 16 * 128, I_D = 64 * 32;
    constexpr int NITEMS = I_IN + I_G + I_Q + I_KV + I_B + I_O + I_U + I_D;
    for (int it = gw; it < NITEMS; it += NGW) {
        int r = it;
        if (r < I_IN) { tr_item(w_in, INC, 0, W + WO_IN, 1024, 0, 69, r, scr, C.lane); continue; } r -= I_IN;
        if (r < I_G) { tr_item(w_in, INC, C_GATE, W + WO_G, 1024, 0, 96, r, scr, C.lane); continue; } r -= I_G;
        if (r < I_Q) { tr_item(w_qup, 768, 0, W + WO_Q, 256, 0, 24, r, scr, C.lane); continue; } r -= I_Q;
        if (r < I_KV) { const int job = r >> 2, sub = r & 3, h = job >> 1, part = job & 1;
            tr_item(w_kvup, 1024, h * 128 + part * 64, W + (part ? WO_V : WO_K), 256, h * 64, 2, sub, scr, C.lane); continue; } r -= I_KV;
        if (r < I_B) { const int n = r / 256, s = r % 256; tr_item(w_br + (size_t)n * 512 * 1024, 1024, 0, W + WO_B + (size_t)n * 1024 * 512, 512, 0, 32, s, scr, C.lane); continue; } r -= I_B;
        if (r < I_O) { tr_item(w_out, 1024, 0, W + WO_O, 1024, 0, 32, r, scr, C.lane); continue; } r -= I_O;
        if (r < I_U) { tr_item(w_up, 4096, 0, W + WO_U, 1024, 0, 128, r, scr, C.lane); continue; } r -= I_U;
        tr_item(w_down, 1024, 0, W + WO_D, 4096, 0, 32, r, scr, C.lane);
    }
    const int gt = C.bid * 512 + C.tid, NGT = C.G * 512;
    for (int i = gt; i < 96 * 1024 / 8; i += NGT) *(v4u*)(W + WO_IN + (size_t)2208 * 1024 + (size_t)i * 8) = (v4u){0u, 0u, 0u, 0u};
    for (int i = gt; i < 1024 * 16; i += NGT) { const int row = i >> 4, c = i & 15; *(v4u*)(W + WO_K + (size_t)row * 256 + 128 + c * 8) = (v4u){0u, 0u, 0u, 0u}; }
}

__device__ __forceinline__ void phase_tables(const Ctx& C, const Params& p) {
    const int gt = C.bid * 512 + C.tid, NGT = C.G * 512;
    f32x2* cs = (f32x2*)(p.ws + WS_ROPE);
    for (int idx = gt; idx < T * 16; idx += NGT) {
        const int t = idx >> 4, i = idx & 15;
        const float freq = (float)exp(-9.210340371976184 * (double)i / 16.0);
        const float ang = (float)p.pos[t] * freq;
        double r = (double)ang * 0.15915494309189535; r -= rint(r);
        const double xx = r * 6.283185307179586, x2 = xx * xx;
        double s = 1.0 / 51090942171709440000.0, c = 1.0 / 1124000727777607680000.0;
        s = s * x2 - 1.0 / 121645100408832000.0;  c = c * -x2 + 1.0 / 2432902008176640000.0;
        s = s * x2 + 1.0 / 355687428096000.0;
        s = s * x2 - 1.0 / 1307674368000.0;
        s = s * x2 + 1.0 / 6227020800.0;
        s = s * x2 - 1.0 / 39916800.0;
        s = s * x2 + 1.0 / 362880.0;
        s = s * x2 - 1.0 / 5040.0;
        s = s * x2 + 1.0 / 120.0;
        s = s * x2 - 1.0 / 6.0;
        s = s * x2 + 1.0;
        s = s * xx;
        c = c * x2 - 1.0 / 6402373705728000.0;
        c = c * x2 + 1.0 / 20922789888000.0;
        c = c * x2 - 1.0 / 87178291200.0;
        c = c * x2 + 1.0 / 479001600.0;
        c = c * x2 - 1.0 / 3628800.0;
        c = c * x2 + 1.0 / 40320.0;
        c = c * x2 - 1.0 / 720.0;
        c = c * x2 + 1.0 / 24.0;
        c = c * x2 - 0.5;
        c = c * x2 + 1.0;
        cs[idx] = (f32x2){(float)c, (float)s};
    }
    float* bt = (float*)(p.ws + WS_BT);
    for (int idx = gt; idx < 129 * 8; idx += NGT) {
        const int n = idx >> 3, h = idx & 7; int bucket;
        if (n < 16) bucket = n;
        else { const float nf = (float)n; int large = 16 + (int)(logf(nf / 16.0f) / 2.0794415416798357f * 16.0f); bucket = large < 31 ? large : 31; }
        bt[idx] = p.rel_bias[bucket * 8 + h];
    }
}

__device__ __forceinline__ void phase_norm(const Ctx& C0, const float* xin, const float* g, bf16* hout) {
    const Ctx C = relaunder(C0);
    const int gw = C.bid * 8 + C.wave, NGW = C.G * 8;
    f32x4 gv[4];
#pragma unroll
    for (int j = 0; j < 4; ++j) gv[j] = *((const f32x4*)g + C.lane + 64 * j);
    for (int m = gw; m < T; m += 2 * NGW) {
        const int m2 = m + NGW; const bool has2 = m2 < T;
        const f32x4* xr = (const f32x4*)(xin + (size_t)m * DM) + C.lane; const f32x4* xr2 = (const f32x4*)(xin + (size_t)(has2 ? m2 : m) * DM) + C.lane;
        f32x4 v[4], u[4]; float s = 0.f, s2 = 0.f;
#pragma unroll
        for (int j = 0; j < 4; ++j) { v[j] = xr[64 * j]; u[j] = xr2[64 * j]; }
#pragma unroll
        for (int j = 0; j < 4; ++j) { s += (v[j].x * v[j].x + v[j].y * v[j].y) + (v[j].z * v[j].z + v[j].w * v[j].w); s2 += (u[j].x * u[j].x + u[j].y * u[j].y) + (u[j].z * u[j].z + u[j].w * u[j].w); }
        const float rstd = 1.0f / sqrtf(wave_sum(s) * (1.f / DM) + EPS), rstd2 = 1.0f / sqrtf(wave_sum(s2) * (1.f / DM) + EPS);
        v2u* o8 = (v2u*)(hout + (size_t)m * DM) + C.lane;
#pragma unroll
        for (int j = 0; j < 4; ++j) { v2u w; w.x = pk2(v[j].x * rstd * gv[j].x, v[j].y * rstd * gv[j].y); w.y = pk2(v[j].z * rstd * gv[j].z, v[j].w * rstd * gv[j].w); o8[64 * j] = w; }
        if (has2) { v2u* p8 = (v2u*)(hout + (size_t)m2 * DM) + C.lane;
#pragma unroll
            for (int j = 0; j < 4; ++j) { v2u w; w.x = pk2(u[j].x * rstd2 * gv[j].x, u[j].y * rstd2 * gv[j].y); w.y = pk2(u[j].z * rstd2 * gv[j].z, u[j].w * rstd2 * gv[j].w); p8[64 * j] = w; } }
    }
}
__device__ __forceinline__ void phase_final_norm(const Ctx& C, const float* g, float* x, float dbg_add = 0.f) {
    const int gw = C.bid * 8 + C.wave, NGW = C.G * 8;
    f32x4 gv[4];
#pragma unroll
    for (int j = 0; j < 4; ++j) gv[j] = *((const f32x4*)g + C.lane + 64 * j);
    for (int m = gw; m < T; m += NGW) {
        f32x4* xr = (f32x4*)(x + (size_t)m * DM) + C.lane;
        f32x4 v[4]; float s = 0.f;
#pragma unroll
        for (int j = 0; j < 4; ++j) { v[j] = xr[64 * j]; s += (v[j].x * v[j].x + v[j].y * v[j].y) + (v[j].z * v[j].z + v[j].w * v[j].w); }
        const float rstd = 1.0f / sqrtf(wave_sum(s) * (1.f / DM) + EPS);
#pragma unroll
        for (int j = 0; j < 4; ++j) xr[64 * j] = v[j] * rstd * gv[j] + dbg_add;
#ifdef DBG_ZERO
        { const int s_ = m & (SEQ - 1); if (DBG_ZERO) {
#pragma unroll
            for (int j = 0; j < 4; ++j) xr[64 * j] = (f32x4){0.f, 0.f, 0.f, 0.f}; } }
#endif
    }
}

__device__ __forceinline__ void rownorm_rows(const Ctx& C0, const Params& p, int l, int gw, int NGW) {
    const Ctx C = relaunder(C0);
    bf16* P = (bf16*)(p.ws + WS_P);
    const f32x2* cs = (const f32x2*)(p.ws + WS_ROPE);
    const float* gq = p.g_qn + l * 256; const float* gkv = p.g_kvn + l * 128;
    const f32x4 gqv = *((const f32x4*)gq + C.lane); const f32x2 gkvv = *((const f32x2*)gkv + C.lane);
    for (int m = gw; m < T; m += 2 * NGW) {
        const int mm[2] = {m, (m + NGW < T) ? m + NGW : m}; const int nrow = (m + NGW < T) ? 2 : 1;
        v2u cw[2]; unsigned kw[2]; float x1[2], x2[2]; f32x2 cc[2];
#pragma unroll
        for (int r = 0; r < 2; ++r) { const bf16* row = P + (size_t)mm[r] * PN; cw[r] = *((const v2u*)(row + C_CQ) + C.lane); kw[r] = *((const unsigned*)(row + C_CKV) + C.lane);
            x1[r] = bf2f(row[C_KPE + (C.lane & 15)]); x2[r] = bf2f(row[C_KPE + 16 + (C.lane & 15)]); cc[r] = cs[(size_t)mm[r] * 16 + (C.lane & 15)]; }
#pragma unroll
        for (int r = 0; r < 2; ++r) {
            if (r < nrow) {
            bf16* row = P + (size_t)mm[r] * PN;
            const float a0 = bflo(cw[r].x), a1 = bfhi(cw[r].x), a2 = bflo(cw[r].y), a3 = bfhi(cw[r].y);
            const float rq = 1.0f / sqrtf(wave_sum((a0 * a0 + a1 * a1) + (a2 * a2 + a3 * a3)) * (1.f / 256.f) + EPS);
            const float b0 = bflo(kw[r]), b1 = bfhi(kw[r]);
            const float rk = 1.0f / sqrtf(wave_sum(b0 * b0 + b1 * b1) * (1.f / 128.f) + EPS);
            v2u ow; ow.x = pk2(a0 * rq * gqv.x, a1 * rq * gqv.y); ow.y = pk2(a2 * rq * gqv.z, a3 * rq * gqv.w); *((v2u*)(row + C_CQ) + C.lane) = ow;
            *((unsigned*)(row + C_CKV) + C.lane) = pk2(b0 * rk * gkvv.x, b1 * rk * gkvv.y);
            if (C.lane < 16) {
                f32x2 c = cc[r];
#ifdef DBG_NOROPE
                c = (f32x2){1.f, 0.f};
#endif
                row[C_KPE + C.lane] = (bf16)f2bf(x1[r] * c.x - x2[r] * c.y);
                row[C_KPE + 16 + C.lane] = (bf16)f2bf(x2[r] * c.x + x1[r] * c.y);
            }
            }
        }
    }
}

template <bool SWA>
__device__ __forceinline__ void attn_unit(const Ctx& C, const Params& p, int l, int unit) {
    constexpr int NKK = SWA ? 2 : 3;
    const int lane = C.lane, fr = lane & 15, fq = lane >> 4;
    int b, h, qb;
    if constexpr (SWA) { b = unit >> 8; h = (unit >> 5) & 7; qb = unit & 31; }
    else {
        const int k = unit >> 8, i = unit & 255, g = i >> 6, bh = i & 63;
        qb = 31 - 4 * k - ((k & 1) ? (3 - g) : g); b = bh >> 3; h = bh & 7;
    }
    const int q0 = qb * 128 + C.wave * 16;
    const size_t tok0 = (size_t)b * SEQ;
    const size_t qrow = tok0 + q0 + fr;
    const bf16* P = (const bf16*)(p.ws + WS_P);
    bf16x8 qf[NKK];
    if constexpr (SWA) {
        const bf16* qp = P + qrow * PN + C_QA + h * 64 + fq * 8;
        qf[0] = *(const bf16x8*)qp; qf[1] = *(const bf16x8*)(qp + 32);
    } else {
        const bf16* qp = (const bf16*)(p.ws + WS_QM) + qrow * 768 + h * 96 + fq * 8;
        qf[0] = *(const bf16x8*)qp; qf[1] = *(const bf16x8*)(qp + 32);
        const v4u raw = *(const v4u*)(qp + 64);
        const f32x2* cs = (const f32x2*)(p.ws + WS_ROPE) + qrow * 16 + (fq & 1) * 8;
        float own[8] = {bflo(raw.x), bfhi(raw.x), bflo(raw.y), bfhi(raw.y), bflo(raw.z), bfhi(raw.z), bflo(raw.w), bfhi(raw.w)};
        float res[8];
#pragma unroll
        for (int e = 0; e < 8; ++e) { const float oth = __shfl_xor(own[e], 32); f32x2 c = cs[e];
#ifdef DBG_NOROPE
            c = (f32x2){1.f, 0.f};
#endif

            res[e] = (fq < 2) ? (own[e] * c.x - oth * c.y) : (own[e] * c.x + oth * c.y); }
        v4u rw; rw.x = pk2(res[0], res[1]); rw.y = pk2(res[2], res[3]); rw.z = pk2(res[4], res[5]); rw.w = pk2(res[6], res[7]);
        qf[2] = __builtin_bit_cast(bf16x8, rw);
    }
    const float scale = SWA ? 0.125f : 0.10206207261596577f;
    float sink2 = 0.f, m = -1e30f, lsum = 0.f;
    if constexpr (SWA) { sink2 = p.sinks[l * 8 + h] * LOG2E; m = sink2; }
    f32x4 o[4];
#pragma unroll
    for (int d = 0; d < 4; ++d) o[d] = (f32x4){0.f, 0.f, 0.f, 0.f};
    const int kt_lo = SWA ? ((q0 - 127 > 0 ? q0 - 127 : 0) >> 5) : 0, kt_hi = (q0 + 15) >> 5;
    const int qi = q0 + fr;
    int pq = 0; if constexpr (SWA) pq = p.pos[qrow];
    const float* bt = (const float*)(p.ws + WS_BT) + h;
    const bf16* Kb; int ldk; const bf16* Vt;
    if constexpr (SWA) { Kb = P + C_KA + (h >> 2) * 64; ldk = PN; Vt = (const bf16*)(p.ws + WS_VTA) + (size_t)((h >> 2) * 64) * T; }
    else { Kb = (const bf16*)(p.ws + WS_KM) + h * 64; ldk = 512; Vt = (const bf16*)(p.ws + WS_VTM) + (size_t)(h * 64) * T; }
    for (int kt = kt_lo; kt <= kt_hi; ++kt) {
        const int k0 = kt * 32;
        f32x4 s0 = (f32x4){0.f, 0.f, 0.f, 0.f}, s1 = (f32x4){0.f, 0.f, 0.f, 0.f};
        const size_t kra = tok0 + k0 + fr, krb = kra + 16;
#pragma unroll
        for (int kk = 0; kk < NKK; ++kk) {
            bf16x8 ka, kb;
            if (SWA || kk < 2) { ka = *(const bf16x8*)(Kb + kra * ldk + kk * 32 + fq * 8); kb = *(const bf16x8*)(Kb + krb * ldk + kk * 32 + fq * 8); }
            else { ka = *(const bf16x8*)(P + kra * PN + C_KPE + fq * 8); kb = *(const bf16x8*)(P + krb * PN + C_KPE + fq * 8); }
            s0 = __builtin_amdgcn_mfma_f32_16x16x32_bf16(ka, qf[kk], s0, 0, 0, 0);
            s1 = __builtin_amdgcn_mfma_f32_16x16x32_bf16(kb, qf[kk], s1, 0, 0, 0);
        }
        float v[8];
        int pka[4] = {0, 0, 0, 0}, pkb[4] = {0, 0, 0, 0};
        if constexpr (SWA) { const int4 t0 = *(const int4*)(p.pos + tok0 + k0 + fq * 4), t1 = *(const int4*)(p.pos + tok0 + k0 + 16 + fq * 4);
            pka[0] = t0.x; pka[1] = t0.y; pka[2] = t0.z; pka[3] = t0.w; pkb[0] = t1.x; pkb[1] = t1.y; pkb[2] = t1.z; pkb[3] = t1.w; }
#pragma unroll
        for (int j = 0; j < 4; ++j) {
            const int keya = k0 + fq * 4 + j, keyb = keya + 16;
            float sa = s0[j] * scale, sb = s1[j] * scale;
            bool oka = keya <= qi, okb = keyb <= qi;
            if constexpr (SWA) {
                int da = pq - pka[j]; da = da < 0 ? 0 : (da > 128 ? 128 : da);
                int db = pq - pkb[j]; db = db < 0 ? 0 : (db > 128 ? 128 : db);
#ifndef DBG_NOBIAS
                sa += bt[da * 8]; sb += bt[db * 8];
#endif
                oka = oka && (qi - keya < 128); okb = okb && (qi - keyb < 128);
            }
            v[j] = oka ? sa * LOG2E : -1e30f; v[4 + j] = okb ? sb * LOG2E : -1e30f;
        }
        float mx = fmaxf(fmaxf(fmaxf(v[0], v[1]), fmaxf(v[2], v[3])), fmaxf(fmaxf(v[4], v[5]), fmaxf(v[6], v[7])));
        mx = fmaxf(mx, __shfl_xor(mx, 16)); mx = fmaxf(mx, __shfl_xor(mx, 32));
        const float mn = fmaxf(m, mx), alpha = __builtin_amdgcn_exp2f(m - mn); m = mn;
        float ps = 0.f;
#pragma unroll
        for (int e = 0; e < 8; ++e) { v[e] = __builtin_amdgcn_exp2f(v[e] - mn); ps += v[e]; }
        lsum = lsum * alpha + ps;
#pragma unroll
        for (int d = 0; d < 4; ++d) o[d] = o[d] * alpha;
        v4u pw; pw.x = pk2(v[0], v[1]); pw.y = pk2(v[2], v[3]); pw.z = pk2(v[4], v[5]); pw.w = pk2(v[6], v[7]);
        const bf16x8 pf = __builtin_bit_cast(bf16x8, pw);
#pragma unroll
        for (int d = 0; d < 4; ++d) {
            const bf16* vp = Vt + (size_t)(d * 16 + fr) * T + tok0 + k0 + fq * 4;
            const v2u lo = *(const v2u*)vp, hi = *(const v2u*)(vp + 16);
            const v4u vw = (v4u){lo.x, lo.y, hi.x, hi.y};
            o[d] = __builtin_amdgcn_mfma_f32_16x16x32_bf16(__builtin_bit_cast(bf16x8, vw), pf, o[d], 0, 0, 0);
        }
    }
    lsum += __shfl_xor(lsum, 16); lsum += __shfl_xor(lsum, 32);
    if constexpr (SWA) lsum += __builtin_amdgcn_exp2f(sink2 - m);
    const float inv = 1.0f / lsum;
    bf16* Y = (bf16*)(p.ws + WS_Y) + (SWA ? (size_t)0 : (size_t)2 * T * 512) + qrow * 512 + h * 64 + fq * 4;
#pragma unroll
    for (int d = 0; d < 4; ++d) { v2u w; w.x = pk2(o[d][0] * inv, o[d][1] * inv); w.y = pk2(o[d][2] * inv, o[d][3] * inv); *(v2u*)(Y + d * 16) = w; }
}

__device__ __forceinline__ void conv_unit(const Ctx& C0, const Params& p, int l, int unit) {
    const Ctx C = relaunder(C0);
    LAS float* U = (LAS float*)C.lds;
    const int c = C.tid, t0 = unit * 32, s0 = t0 & (SEQ - 1);
    const bf16* P = (const bf16*)(p.ws + WS_P);
    { const int cg8 = (c & 63) * 8, rsub = c >> 6;
#pragma unroll
      for (int pass = 0; pass < 8; ++pass) {
        const int r = pass * 8 + rsub;
        if (r < 62) {
            const int s = s0 - 30 + r; f32x4 u0 = (f32x4){0.f, 0.f, 0.f, 0.f}, u1 = u0;
            if (s >= 0) { const bf16* row = P + (size_t)(t0 - 30 + r) * PN + C_UB + cg8; const v4u a = *(const v4u*)row, g = *(const v4u*)(row + 512);
                u0[0] = bflo(a.x) * sigmoidf_(bflo(g.x)); u0[1] = bfhi(a.x) * sigmoidf_(bfhi(g.x)); u0[2] = bflo(a.y) * sigmoidf_(bflo(g.y)); u0[3] = bfhi(a.y) * sigmoidf_(bfhi(g.y));
                u1[0] = bflo(a.z) * sigmoidf_(bflo(g.z)); u1[1] = bfhi(a.z) * sigmoidf_(bfhi(g.z)); u1[2] = bflo(a.w) * sigmoidf_(bflo(g.w)); u1[3] = bfhi(a.w) * sigmoidf_(bfhi(g.w)); }
            *(LAS f32x4*)(U + r * 512 + cg8) = u0; *(LAS f32x4*)(U + r * 512 + cg8 + 4) = u1;
        }
      }
    }
    __syncthreads();
    float w[31];
#pragma unroll
    for (int j = 0; j < 31; ++j) w[j] = p.w_dw[(size_t)l * 31 * 512 + j * 512 + c];
    const float bias = p.b_dw[l * 512 + c];
    for (int tb = 0; tb < 32; tb += 8) {
        float acc[8];
#pragma unroll
        for (int k = 0; k < 8; ++k) acc[k] = bias;
#pragma unroll
        for (int jj = 0; jj < 38; ++jj) {
            const float u = U[(tb + jj) * 512 + c];
#pragma unroll
            for (int k = 0; k < 8; ++k) { const int j = jj - k; if (j >= 0 && j < 31) acc[k] += w[j] * u; }
        }
#pragma unroll
        for (int k = 0; k < 8; ++k) U[(tb + k) * 512 + c] = acc[k];
    }
    __syncthreads();
    const float* gl = p.g_cln + l * 512; const float* bl = p.b_cln + l * 512;
    bf16* Y = (bf16*)(p.ws + WS_Y) + (size_t)1 * T * 512;
    for (int q = 0; q < 4; ++q) {
        const int tl = C.wave * 4 + q; float xv[8]; float s = 0.f;
#pragma unroll
        for (int i = 0; i < 8; ++i) { xv[i] = U[tl * 512 + C.lane + 64 * i]; s += xv[i]; }
        const float mean = wave_sum(s) * (1.f / 512.f); float s2 = 0.f;
#pragma unroll
        for (int i = 0; i < 8; ++i) { xv[i] -= mean; s2 += xv[i] * xv[i]; }
        const float rstd = 1.0f / sqrtf(wave_sum(s2) * (1.f / 512.f) + EPS);
#pragma unroll
        for (int i = 0; i < 8; ++i) { const int ch = C.lane + 64 * i; const float y = xv[i] * rstd * gl[ch] + bl[ch]; Y[(size_t)(t0 + tl) * 512 + ch] = (bf16)f2bf(y * sigmoidf_(y)); }
    }
    __syncthreads();
}

constexpr int AK_ROW = 208, AV_ROW = 144, AK_BYTES = 64 * AK_ROW, AV_BYTES = 64 * AV_ROW, ABUF = AK_BYTES + AV_BYTES;
__device__ __forceinline__ void mla_unit(const Ctx& C, const Params& p, int unit) {
    int tid_ = C.tid; asm volatile("" : "+v"(tid_));
    const int tid = tid_, lane = tid & 63, fr = lane & 15, fq = lane >> 4;
    int b, h, qb;
    { const int k = unit >> 8, i = unit & 255, g = i >> 6, bh = i & 63; qb = 15 - 4 * k - ((k & 1) ? (3 - g) : g); b = bh >> 3; h = bh & 7; }
    const int q0w = qb * 256 + C.wave * 32;
    const size_t tok0 = (size_t)b * SEQ;
    const bf16* P = (const bf16*)(p.ws + WS_P); const bf16* QM = (const bf16*)(p.ws + WS_QM); const bf16* KM = (const bf16*)(p.ws + WS_KM); const bf16* VTM = (const bf16*)(p.ws + WS_VTM);
    bf16x8 qf[2][3];
#pragma unroll
    for (int g = 0; g < 2; ++g) {
        const size_t qrow = tok0 + q0w + 16 * g + fr;
        const bf16* qp = QM + qrow * 768 + h * 96 + fq * 8;
        qf[g][0] = *(const bf16x8*)qp; qf[g][1] = *(const bf16x8*)(qp + 32);
        const v4u raw = *(const v4u*)(qp + 64);
        const f32x2* cs = (const f32x2*)(p.ws + WS_ROPE) + qrow * 16 + (fq & 1) * 8;
        const float own[8] = {bflo(raw.x), bfhi(raw.x), bflo(raw.y), bfhi(raw.y), bflo(raw.z), bfhi(raw.z), bflo(raw.w), bfhi(raw.w)};
        float res[8];
#pragma unroll
        for (int e = 0; e < 8; ++e) { const float oth = __shfl_xor(own[e], 32); const f32x2 c = cs[e]; res[e] = (fq < 2) ? (own[e] * c.x - oth * c.y) : (own[e] * c.x + oth * c.y); }
        v4u rw; rw.x = pkhw(res[0], res[1]); rw.y = pkhw(res[2], res[3]); rw.z = pkhw(res[4], res[5]); rw.w = pkhw(res[6], res[7]);
        qf[g][2] = __builtin_bit_cast(bf16x8, rw);
    }
    float m[2] = {-1e30f, -1e30f}, lsum[2] = {0.f, 0.f};
    f32x4 o[2][4];
#pragma unroll
    for (int g = 0; g < 2; ++g)
#pragma unroll
        for (int d = 0; d < 4; ++d) o[g][d] = (f32x4){0.f, 0.f, 0.f, 0.f};
    const int nt = 4 * (qb + 1), my_last = (q0w + 31) >> 6;
    const int kc0 = tid, kc1 = tid + 512;
    const int key0 = kc0 / 12, part0 = kc0 % 12, key1 = kc1 / 12, part1 = kc1 % 12; const bool has1 = kc1 < 768;
    const bf16* ksrc0 = (part0 < 8) ? (KM + (tok0 + key0) * 512 + h * 64 + part0 * 8) : (P + (tok0 + key0) * PN + C_KPE + (part0 - 8) * 8);
    const bf16* ksrc1 = (part1 < 8) ? (KM + (tok0 + key1) * 512 + h * 64 + part1 * 8) : (P + (tok0 + key1) * PN + C_KPE + (part1 - 8) * 8);
    const size_t kstep0 = (part0 < 8) ? (size_t)64 * 512 : (size_t)64 * PN, kstep1 = (part1 < 8) ? (size_t)64 * 512 : (size_t)64 * PN;
    const int kdst0 = key0 * AK_ROW + part0 * 16, kdst1 = key1 * AK_ROW + part1 * 16;
    const bf16* vsrc = VTM + (size_t)(h * 64 + (tid >> 3)) * T + tok0 + (tid & 7) * 8;
    const int vdst = AK_BYTES + (tid >> 3) * AV_ROW + ((((tid & 7) >> 2) * 32 + (2 * (tid & 1)) * 8 + (((tid & 7) >> 1) & 1) * 4) * 2);
    LAS unsigned char* lds = C.lds;
    v4u r0[2], r1[2], r2[2];
#pragma unroll
    for (int sb = 0; sb < 2; ++sb) { r1[sb] = (v4u){0u, 0u, 0u, 0u}; r0[sb] = *(const v4u*)(ksrc0 + (size_t)sb * kstep0); if (has1) r1[sb] = *(const v4u*)(ksrc1 + (size_t)sb * kstep1); r2[sb] = *(const v4u*)(vsrc + (size_t)sb * 64); }
#pragma unroll
    for (int sb = 0; sb < 2; ++sb) { LAS unsigned char* nb = lds + sb * ABUF; *(LAS v4u*)(nb + kdst0) = r0[sb]; if (has1) *(LAS v4u*)(nb + kdst1) = r1[sb]; { const v4u vv_ = r2[sb]; *(LAS v2u*)(nb + vdst) = (v2u){vv_.x, vv_.y}; *(LAS v2u*)(nb + vdst + 16) = (v2u){vv_.z, vv_.w}; } }
    __syncthreads();
    const float c2 = 0.10206207261596577f * LOG2E;
    for (int kp = 0; kp < nt / 2; ++kp) {
        const bool more = 2 * kp + 2 < nt;
        if (more) {
#pragma unroll
            for (int sb = 0; sb < 2; ++sb) { const int tn = 2 * kp + 2 + sb; r0[sb] = *(const v4u*)(ksrc0 + (size_t)tn * kstep0); if (has1) r1[sb] = *(const v4u*)(ksrc1 + (size_t)tn * kstep1); r2[sb] = *(const v4u*)(vsrc + (size_t)tn * 64); } }
#pragma unroll 1
        for (int sub = 0; sub < 2; ++sub) {
        const int kt = 2 * kp + sub;
        if (kt <= my_last) {
            const LAS unsigned char* Kb = lds + ((kp & 1) * 2 + sub) * ABUF; const LAS unsigned char* Vb = Kb + AK_BYTES;
            const int k0 = kt * 64;
            f32x4 s[2][4];
#pragma unroll
            for (int g = 0; g < 2; ++g)
#pragma unroll
                for (int blk = 0; blk < 4; ++blk) s[g][blk] = (f32x4){0.f, 0.f, 0.f, 0.f};
#pragma unroll
            for (int kk = 0; kk < 3; ++kk)
#pragma unroll
                for (int blk = 0; blk < 4; ++blk) {
                    const bf16x8 kf = *(const LAS bf16x8*)(Kb + (blk * 16 + fr) * AK_ROW + (kk * 32 + fq * 8) * 2);
#pragma unroll
                    for (int g = 0; g < 2; ++g) s[g][blk] = __builtin_amdgcn_mfma_f32_16x16x32_bf16(kf, qf[g][kk], s[g][blk], 0, 0, 0);
                }
            const bool need_mask = (k0 + 63 > q0w);
            bf16x8 pf[2][2];
#pragma unroll
            for (int g = 0; g < 2; ++g) {
                const int qi = q0w + 16 * g + fr;
                if (need_mask) {
                    asm volatile("" ::: "memory");
#pragma unroll
                    for (int blk = 0; blk < 4; ++blk)
#pragma unroll
                        for (int j = 0; j < 4; ++j) { const int key = k0 + blk * 16 + fq * 4 + j; if (key > qi) s[g][blk][j] = -1e30f; }
                    asm volatile("" ::: "memory");
                }
                float mx = fmaxf(s[g][0][0], s[g][0][1]);
                mx = fmaxf(fmaxf(mx, s[g][0][2]), s[g][0][3]);
#pragma unroll
                for (int blk = 1; blk < 4; ++blk) { mx = fmaxf(fmaxf(mx, s[g][blk][0]), s[g][blk][1]); mx = fmaxf(fmaxf(mx, s[g][blk][2]), s[g][blk][3]); }
                mx = fmaxf(mx, __shfl_xor(mx, 16)); mx = fmaxf(mx, __shfl_xor(mx, 32));
                const float mn = fmaxf(m[g], mx * c2), alpha = __builtin_amdgcn_exp2f(m[g] - mn); m[g] = mn;
                float ps = 0.f;
#pragma unroll
                for (int blk = 0; blk < 4; ++blk)
#pragma unroll
                    for (int j = 0; j < 4; ++j) { const float pv = __builtin_amdgcn_exp2f(s[g][blk][j] * c2 - mn); s[g][blk][j] = pv; ps += pv; }
                lsum[g] = lsum[g] * alpha + ps;
                if (__builtin_amdgcn_ballot_w64(alpha != 1.0f) != 0ull) {
#pragma unroll
                    for (int d = 0; d < 4; ++d) o[g][d] = o[g][d] * alpha;
                }
#pragma unroll
                for (int hf = 0; hf < 2; ++hf) { v4u pw; pw.x = pkhw(s[g][2 * hf][0], s[g][2 * hf][1]); pw.y = pkhw(s[g][2 * hf][2], s[g][2 * hf][3]); pw.z = pkhw(s[g][2 * hf + 1][0], s[g][2 * hf + 1][1]); pw.w = pkhw(s[g][2 * hf + 1][2], s[g][2 * hf + 1][3]);
                    pf[g][hf] = __builtin_bit_cast(bf16x8, pw); }
            }
#pragma unroll
            for (int hf = 0; hf < 2; ++hf)
#pragma unroll
                for (int d = 0; d < 4; ++d) {
                    const bf16x8 vf = *(const LAS bf16x8*)(Vb + (d * 16 + fr) * AV_ROW + (hf * 32 + fq * 8) * 2);
#pragma unroll
                    for (int g = 0; g < 2; ++g) o[g][d] = __builtin_amdgcn_mfma_f32_16x16x32_bf16(vf, pf[g][hf], o[g][d], 0, 0, 0);
                }
        }
        }
        if (more) {
#pragma unroll
            for (int sb = 0; sb < 2; ++sb) { LAS unsigned char* nb = lds + (((kp + 1) & 1) * 2 + sb) * ABUF; *(LAS v4u*)(nb + kdst0) = r0[sb]; if (has1) *(LAS v4u*)(nb + kdst1) = r1[sb]; { const v4u vv_ = r2[sb]; *(LAS v2u*)(nb + vdst) = (v2u){vv_.x, vv_.y}; *(LAS v2u*)(nb + vdst + 16) = (v2u){vv_.z, vv_.w}; } } }
        __syncthreads();
    }
    bf16* Y = (bf16*)(p.ws + WS_Y) + (size_t)2 * T * 512;
#pragma unroll
    for (int g = 0; g < 2; ++g) {
        float lt = lsum[g]; lt += __shfl_xor(lt, 16); lt += __shfl_xor(lt, 32);
        const float inv = 1.0f / lt;
        bf16* yp = Y + (tok0 + q0w + 16 * g + fr) * 512 + h * 64 + fq * 4;
#pragma unroll
        for (int d = 0; d < 4; ++d) { v2u w; w.x = pkhw(o[g][d][0] * inv, o[g][d][1] * inv); w.y = pkhw(o[g][d][2] * inv, o[g][d][3] * inv); *(v2u*)(yp + d * 16) = w; }
    }
}

__device__ __forceinline__ void swa_unit(const Ctx& C, const Params& p, int l, int unit) {
    int tid_ = threadIdx.x; asm volatile("" : "+v"(tid_));
    const int tid = tid_, lane = tid & 63, fr = lane & 15, fq = lane >> 4, wave_ = __builtin_amdgcn_readfirstlane(tid >> 6);
    const int b = unit >> 5, kvh = (unit >> 4) & 1, qb = unit & 15;
    const int q0w = qb * 256 + wave_ * 32;
    const size_t tok0 = (size_t)b * SEQ;
    const bf16* P = (const bf16*)(p.ws + WS_P); const bf16* VTA = (const bf16*)(p.ws + WS_VTA);
    LAS unsigned char* lds = C.lds;
    constexpr int SROW = 144, STILE = 2 * 64 * SROW;
    LAS float* btl = (LAS float*)(lds + 6 * STILE);
    const int kt_lo = (4 * qb - 2 > 0) ? 4 * qb - 2 : 0, kt_hi = 4 * qb + 3, ntile = kt_hi - kt_lo + 1;
    const int my_lo = (q0w - 127 > 0 ? q0w - 127 : 0) >> 6, my_hi = (q0w + 31) >> 6;
    {
        const bf16* ksrc = P + (tok0 + (size_t)kt_lo * 64 + (tid >> 3)) * PN + C_KA + kvh * 64 + (tid & 7) * 8;
        const bf16* vsrc = VTA + (size_t)(kvh * 64 + (tid >> 3)) * T + tok0 + (size_t)kt_lo * 64 + (tid & 7) * 8;
        const int dst = (tid >> 3) * SROW + (tid & 7) * 16;
        v4u rk[6], rv[6];
#pragma unroll
        for (int t = 0; t < 6; ++t) if (t < ntile) { rk[t] = *(const v4u*)(ksrc + (size_t)t * 64 * PN); rv[t] = *(const v4u*)(vsrc + (size_t)t * 64); }
        for (int i = tid; i < 4 * 129; i += 512) { const int hh = i / 129, n = i - hh * 129; btl[i] = ((const float*)(p.ws + WS_BT))[n * 8 + kvh * 4 + hh] * LOG2E; }
#pragma unroll
        for (int t = 0; t < 6; ++t) if (t < ntile) { *(LAS v4u*)(lds + t * STILE + dst) = rk[t]; *(LAS v4u*)(lds + t * STILE + 64 * SROW + dst) = rv[t]; }
    }
    __syncthreads();
    const float c2 = 0.125f * LOG2E;
    int pq[2];
#pragma unroll
    for (int g = 0; g < 2; ++g) pq[g] = p.pos[tok0 + q0w + 16 * g + fr];
#pragma unroll 1
    for (int hh = 0; hh < 4; ++hh) {
        const int h = kvh * 4 + hh;
        const LAS float* bth = btl + hh * 129;
        bf16x8 qf[2][2];
#pragma unroll
        for (int g = 0; g < 2; ++g) { const bf16* qp = P + (tok0 + q0w + 16 * g + fr) * PN + C_QA + h * 64 + fq * 8; qf[g][0] = *(const bf16x8*)qp; qf[g][1] = *(const bf16x8*)(qp + 32); }
        const float sink2 = p.sinks[l * 8 + h] * LOG2E;
        float m[2] = {sink2, sink2}, lsum[2] = {0.f, 0.f};
        f32x4 o[2][4];
#pragma unroll
        for (int g = 0; g < 2; ++g)
#pragma unroll
            for (int d = 0; d < 4; ++d) o[g][d] = (f32x4){0.f, 0.f, 0.f, 0.f};
#pragma unroll 1
        for (int kt = my_lo; kt <= my_hi; ++kt) {
            const LAS unsigned char* Kb = lds + (kt - kt_lo) * STILE; const LAS unsigned char* Vb = Kb + 64 * SROW;
            const int k0 = kt * 64;
            f32x4 s[2][4];
#pragma unroll
            for (int blk = 0; blk < 4; ++blk) {
                bf16x8 kf[2];
#pragma unroll
                for (int kk = 0; kk < 2; ++kk) kf[kk] = *(const LAS bf16x8*)(Kb + (blk * 16 + fr) * SROW + (kk * 32 + fq * 8) * 2);
#pragma unroll
                for (int g = 0; g < 2; ++g) { f32x4 a = (f32x4){0.f, 0.f, 0.f, 0.f};
#pragma unroll
                    for (int kk = 0; kk < 2; ++kk) a = __builtin_amdgcn_mfma_f32_16x16x32_bf16(kf[kk], qf[g][kk], a, 0, 0, 0);
                    s[g][blk] = a; }
            }
            bf16x8 pf[2][2];
#pragma unroll
            for (int g = 0; g < 2; ++g) {
                const int qi = q0w + 16 * g + fr;
#pragma unroll
                for (int blk = 0; blk < 4; ++blk) { const int4 t4 = *(const int4*)(p.pos + tok0 + k0 + blk * 16 + fq * 4); const int pkv[4] = {t4.x, t4.y, t4.z, t4.w};
#pragma unroll
                    for (int j = 0; j < 4; ++j) { const int key = k0 + blk * 16 + fq * 4 + j; int dd = pq[g] - pkv[j]; dd = dd < 0 ? 0 : (dd > 128 ? 128 : dd);
                        const float v = s[g][blk][j] * c2 + bth[dd]; const bool ok = (key <= qi) && (qi - key < 128); s[g][blk][j] = ok ? v : -1e30f; } }
                float mx = fmaxf(fmaxf(s[g][0][0], s[g][0][1]), fmaxf(s[g][0][2], s[g][0][3]));
#pragma unroll
                for (int blk = 1; blk < 4; ++blk) mx = fmaxf(mx, fmaxf(fmaxf(s[g][blk][0], s[g][blk][1]), fmaxf(s[g][blk][2], s[g][blk][3])));
                mx = fmaxf(mx, __shfl_xor(mx, 16)); mx = fmaxf(mx, __shfl_xor(mx, 32));
                const float mn = fmaxf(m[g], mx), alpha = __builtin_amdgcn_exp2f(m[g] - mn); m[g] = mn;
                float ps = 0.f;
#pragma unroll
                for (int blk = 0; blk < 4; ++blk)
#pragma unroll
                    for (int j = 0; j < 4; ++j) { const float pv = __builtin_amdgcn_exp2f(s[g][blk][j] - mn); s[g][blk][j] = pv; ps += pv; }
                lsum[g] = lsum[g] * alpha + ps;
#pragma unroll
                for (int d = 0; d < 4; ++d) o[g][d] = o[g][d] * alpha;
#pragma unroll
                for (int hf = 0; hf < 2; ++hf) { v4u pw; pw.x = pkhw(s[g][2 * hf][0], s[g][2 * hf][1]); pw.y = pkhw(s[g][2 * hf][2], s[g][2 * hf][3]); pw.z = pkhw(s[g][2 * hf + 1][0], s[g][2 * hf + 1][1]); pw.w = pkhw(s[g][2 * hf + 1][2], s[g][2 * hf + 1][3]);
                    pf[g][hf] = __builtin_bit_cast(bf16x8, pw); }
            }
#pragma unroll
            for (int hf = 0; hf < 2; ++hf)
#pragma unroll
                for (int d = 0; d < 4; ++d) {
                    const LAS unsigned char* vp = Vb + (d * 16 + fr) * SROW + (hf * 32 + fq * 4) * 2;
                    const v2u lo = *(const LAS v2u*)vp, hi = *(const LAS v2u*)(vp + 32);
                    const v4u vw = (v4u){lo.x, lo.y, hi.x, hi.y}; const bf16x8 vf = __builtin_bit_cast(bf16x8, vw);
#pragma unroll
                    for (int g = 0; g < 2; ++g) o[g][d] = __builtin_amdgcn_mfma_f32_16x16x32_bf16(vf, pf[g][hf], o[g][d], 0, 0, 0);
                }
        }
        bf16* Y = (bf16*)(p.ws + WS_Y);
#pragma unroll
        for (int g = 0; g < 2; ++g) {
            float lt = lsum[g]; lt += __shfl_xor(lt, 16); lt += __shfl_xor(lt, 32);
            lt += __builtin_amdgcn_exp2f(sink2 - m[g]);
            const float inv = 1.0f / lt;
            bf16* yp = Y + (tok0 + q0w + 16 * g + fr) * 512 + h * 64 + fq * 4;
#pragma unroll
            for (int d = 0; d < 4; ++d) { v2u w; w.x = pkhw(o[g][d][0] * inv, o[g][d][1] * inv); w.y = pkhw(o[g][d][2] * inv, o[g][d][3] * inv); *(v2u*)(yp + d * 16) = w; }
        }
    }
    __syncthreads();
}

#ifndef DBG_NAIVE
#define DBG_NAIVE 0
#endif
#if DBG_NAIVE
__device__ __forceinline__ int t5b_n(int rel) { int n = rel < 0 ? 0 : rel; if (n < 16) return n; float nf = (float)n; int lg = 16 + (int)(logf(nf / 16.0f) / 2.0794415416798357f * 16.0f); return lg < 31 ? lg : 31; }
__device__ __forceinline__ void naive_conv(const Ctx& C, const Params& p, int l) {
    LAS float* red = (LAS float*)C.lds; const bf16* P = (const bf16*)(p.ws + WS_P); bf16* Y = (bf16*)(p.ws + WS_Y) + (size_t)T * 512; const int c = C.tid;
    for (int t = C.bid; t < T; t += C.G) {
        const int s = t & (SEQ - 1); float acc = p.b_dw[l * 512 + c];
        for (int j = 0; j < 31; ++j) { const int ss = s - 30 + j; if (ss >= 0) { const bf16* row = P + (size_t)(t - 30 + j) * PN + C_UB; const float a = bf2f(row[c]), g = bf2f(row[512 + c]); acc += p.w_dw[(size_t)l * 31 * 512 + j * 512 + c] * (a / (1.f + expf(-g))); } }
        float sw = wave_sum(acc); if (C.lane == 0) red[C.wave] = sw; __syncthreads();
        float tot = 0.f; for (int w = 0; w < 8; ++w) tot += red[w]; const float mean = tot / 512.f; __syncthreads();
        const float dv = acc - mean; sw = wave_sum(dv * dv); if (C.lane == 0) red[C.wave] = sw; __syncthreads();
        tot = 0.f; for (int w = 0; w < 8; ++w) tot += red[w]; __syncthreads();
        float y = dv / sqrtf(tot / 512.f + EPS) * p.g_cln[l * 512 + c] + p.b_cln[l * 512 + c]; y = y / (1.f + expf(-y));
        Y[(size_t)t * 512 + c] = (bf16)f2bf(y);
    }
}
__device__ __forceinline__ void naive_swa(const Ctx& C, const Params& p, int l) {
    const bf16* P = (const bf16*)(p.ws + WS_P); bf16* Y = (bf16*)(p.ws + WS_Y);
    for (int it = C.bid * 512 + C.tid; it < T * 8; it += C.G * 512) {
        const int t = it >> 3, h = it & 7, s = t & (SEQ - 1), b0 = t - s; const bf16* q = P + (size_t)t * PN + h * 64;
        float qv[64];
#pragma unroll
        for (int d = 0; d < 64; ++d) qv[d] = bf2f(q[d]);
        float acc[64];
#pragma unroll
        for (int d = 0; d < 64; ++d) acc[d] = 0.f;
        const float sink = p.sinks[l * 8 + h]; float m = sink, lsum = 0.f;
        for (int ks = (s - 127 > 0 ? s - 127 : 0); ks <= s; ++ks) { const bf16* kr = P + (size_t)(b0 + ks) * PN + C_KA + (h >> 2) * 64; float sc = 0.f;
#pragma unroll
            for (int d = 0; d < 64; ++d) sc += qv[d] * bf2f(kr[d]);
            sc = sc * 0.125f + p.rel_bias[t5b_n(p.pos[t] - p.pos[b0 + ks]) * 8 + h];
            const float mn = fmaxf(m, sc), al = expf(m - mn), pp = expf(sc - mn); lsum = lsum * al + pp; m = mn; const bf16* vr = P + (size_t)(b0 + ks) * PN + C_VA + (h >> 2) * 64;
#pragma unroll
            for (int d = 0; d < 64; ++d) acc[d] = acc[d] * al + pp * bf2f(vr[d]); }
        lsum += expf(sink - m);
#pragma unroll
        for (int d = 0; d < 64; ++d) Y[(size_t)t * 512 + h * 64 + d] = (bf16)f2bf(acc[d] / lsum);
    }
}
__device__ __forceinline__ void naive_mla(const Ctx& C, const Params& p, int l) {
    const bf16* P = (const bf16*)(p.ws + WS_P); const bf16* QM = (const bf16*)(p.ws + WS_QM); const bf16* KM = (const bf16*)(p.ws + WS_KM); const bf16* VTM = (const bf16*)(p.ws + WS_VTM);
    bf16* Y = (bf16*)(p.ws + WS_Y) + (size_t)2 * T * 512; LAS float* qs = (LAS float*)C.lds + C.wave * 128;
    for (int it = C.bid * 8 + C.wave; it < T * 8; it += C.G * 8) {
        const int t = it >> 3, h = it & 7, s = t & (SEQ - 1), b0 = t - s; const bf16* q = QM + (size_t)t * 768 + h * 96;
        asm volatile("s_waitcnt lgkmcnt(0)" ::: "memory");
        qs[C.lane] = bf2f(q[C.lane]);
        if (C.lane < 16) { const float ang = (float)p.pos[t] * expf(-9.210340371976184f * (float)C.lane / 16.f); const float cc = __cosf(ang), sn = __sinf(ang);
            const float x1 = bf2f(q[64 + C.lane]), x2 = bf2f(q[80 + C.lane]); qs[64 + C.lane] = x1 * cc - x2 * sn; qs[80 + C.lane] = x2 * cc + x1 * sn; }
        asm volatile("s_waitcnt lgkmcnt(0)" ::: "memory");
        float acc[64];
#pragma unroll
        for (int d = 0; d < 64; ++d) acc[d] = 0.f;
        float m = -1e30f, lsum = 0.f;
        for (int ks = C.lane; ks <= s; ks += 64) { const size_t kt = (size_t)(b0 + ks); float sc = 0.f;
            for (int d = 0; d < 64; ++d) sc += qs[d] * bf2f(KM[kt * 512 + h * 64 + d]);
            for (int d = 0; d < 32; ++d) sc += qs[64 + d] * bf2f(P[kt * PN + C_KPE + d]);
            sc *= 0.10206207261596577f;
            const float mn = fmaxf(m, sc), al = expf(m - mn), pp = expf(sc - mn); lsum = lsum * al + pp; m = mn;
#pragma unroll
            for (int d = 0; d < 64; ++d) acc[d] = acc[d] * al + pp * bf2f(VTM[(size_t)(h * 64 + d) * T + kt]); }
        float mg = m;
#pragma unroll
        for (int o = 1; o < 64; o <<= 1) mg = fmaxf(mg, __shfl_xor(mg, o));
        const float f = expf(m - mg); const float lt = wave_sum(lsum * f);
#pragma unroll
        for (int d = 0; d < 64; ++d) { const float v = wave_sum(acc[d] * f); if (C.lane == (d & 63)) Y[(size_t)t * 512 + h * 64 + d] = (bf16)f2bf(v / lt); }
    }
}
#endif

#define XB_TMO      128
#define XB_XCNT(j)  (256  + 64 * (j))
#define XB_XSUB(j)  (1280 + 64 * (j))
#define XB_XGEN(j)  (2304 + 64 * (j))
#define XB_TOP      3328
#define XB_TOPGEN   3392
#define XCD_BAR_WORDS 3456
#define XB_SPIN_CAP (1u << 18)

__device__ __forceinline__ unsigned xb_ld(unsigned* p)              { return __hip_atomic_load(p, __ATOMIC_RELAXED, __HIP_MEMORY_SCOPE_AGENT); }
__device__ __forceinline__ unsigned xb_add(unsigned* p, unsigned v) { return __hip_atomic_fetch_add(p, v, __ATOMIC_RELAXED, __HIP_MEMORY_SCOPE_AGENT); }
__device__ __forceinline__ unsigned xb_xcc_id() { return (unsigned)__builtin_amdgcn_s_getreg((3 << 11) | 20) & 0xFu; }
#define XB_SPIN(cond, bar) do { unsigned _sp = 0; while (cond) { __builtin_amdgcn_s_sleep(1); \
    if ((++_sp & 255u) == 0u) { if (xb_ld(&(bar)[XB_TMO])) break; if (_sp > XB_SPIN_CAP) { atomicAdd(&(bar)[XB_TMO], 1u); break; } } } } while (0)

struct XcdBarrier {
    unsigned* bar; unsigned x;
    volatile LAS unsigned* st;
};

__device__ __forceinline__ XcdBarrier xcd_barrier_post(unsigned* bar, volatile LAS unsigned* st) {
    XcdBarrier b; b.bar = bar; b.x = xb_xcc_id(); b.st = st;
    if (threadIdx.x == 0) (void)xb_add(&bar[XB_XCNT(b.x)], 1u);
    return b;
}
__device__ __forceinline__ void xcd_barrier_complete(unsigned* bar, unsigned x, unsigned& nloc, unsigned& nx) {
    const unsigned G = gridDim.x * gridDim.y * gridDim.z;
    unsigned sum, cnt, mine, sp = 0u;
    for (;;) {
        sum = 0u; cnt = 0u; mine = 0u;
#pragma unroll
        for (unsigned j = 0; j < 16; ++j) { const unsigned c = xb_ld(&bar[XB_XCNT(j)]); sum += c; cnt += (c > 0u) ? 1u : 0u; mine = (j == x) ? c : mine; }
        if (sum == G) break;
        __builtin_amdgcn_s_sleep(1);
        if ((++sp & 255u) == 0u) { if (xb_ld(&bar[XB_TMO])) break; if (sp > XB_SPIN_CAP) { atomicAdd(&bar[XB_TMO], 1u); break; } }
    }
    nloc = mine > 0u ? mine : 1u; nx = cnt > 0u ? cnt : 1u;
}

__device__ __forceinline__ void xcd_barrier(const XcdBarrier& b) {
    asm volatile("s_waitcnt vmcnt(0)" ::: "memory");
    __syncthreads();
    if (threadIdx.x == 0) {
        unsigned* bar = b.bar;
        __builtin_amdgcn_s_waitcnt(0);
        unsigned nloc = b.st[0], nx = b.st[1];
        if (nloc == 0u) { xcd_barrier_complete(bar, b.x, nloc, nx); b.st[0] = nloc; b.st[1] = nx; }
        const unsigned old = xb_add(&bar[XB_XSUB(b.x)], 1u);
        const unsigned gen = old / nloc;
        if (old + 1u == (gen + 1u) * nloc) {
            __builtin_amdgcn_fence(__ATOMIC_RELEASE, "agent");
            asm volatile("s_waitcnt vmcnt(0)" ::: "memory");
            const unsigned og = xb_add(&bar[XB_TOP], 1u);
            const unsigned tg = og / nx;
            if (og + 1u == (tg + 1u) * nx) xb_add(&bar[XB_TOPGEN], 1u);
            else XB_SPIN(xb_ld(&bar[XB_TOPGEN]) == tg, bar);
            __builtin_amdgcn_fence(__ATOMIC_ACQUIRE, "agent");
            xb_add(&bar[XB_XGEN(b.x)], 1u);
            asm volatile("s_waitcnt vmcnt(0)" ::: "memory");
        } else {
            XB_SPIN(xb_ld(&bar[XB_XGEN(b.x)]) == gen, bar);
            __builtin_amdgcn_fence(__ATOMIC_ACQUIRE, "agent");
            asm volatile("s_waitcnt vmcnt(0)" ::: "memory");
        }
    }
    __syncthreads();
}

template <int MODE>
__device__ __forceinline__ void run_gemm(const Ctx& C, const bf16* A, int lda, const bf16* Bt, int ldb, int M, int N, int K, const pg8::Epi<MODE>& E, int crot = 0) {
    pg8::Gemm g{A, Bt, lda, ldb, M, N, K}; pg8::StaticOrder S; S.init(M, N, C.G, (C.bid + crot) % C.G);
    pg8::gemm_phase<pg8::Epi<MODE>, pg8::StaticOrder, true, true>(C.lds, g, S, E);
    __syncthreads();
}

#define GSYNC() do { xcd_barrier(xbar); } while (0)
__global__ void __launch_bounds__(512) mega_fwd(Params p) {
    extern __shared__ __attribute__((aligned(16))) unsigned char lds_raw[];
    cg::grid_group grid = cg::this_grid();
    Ctx C; C.lds = (LAS unsigned char*)lds_raw; C.tid = threadIdx.x; C.lane = C.tid & 63; C.wave = __builtin_amdgcn_readfirstlane(C.tid >> 6); C.G = gridDim.x; C.bid = blockIdx.x;
    unsigned char* ws = p.ws;
    bf16* W = (bf16*)(ws + WS_W); bf16* H = (bf16*)(ws + WS_H); bf16* P = (bf16*)(ws + WS_P); bf16* Y = (bf16*)(ws + WS_Y);
    bf16* QM = (bf16*)(ws + WS_QM); bf16* KM = (bf16*)(ws + WS_KM); bf16* VTM = (bf16*)(ws + WS_VTM); bf16* VTA = (bf16*)(ws + WS_VTA);
    bf16* MG = (bf16*)(ws + WS_MG); bf16* GS = (bf16*)(ws + WS_GS); bf16* HID = (bf16*)(ws + WS_HID);

    volatile LAS unsigned* xst = (volatile LAS unsigned*)(C.lds + RING_BYTES + 64);
    if (threadIdx.x < 2) xst[threadIdx.x] = 0u;
    __syncthreads();
    XcdBarrier xbar = xcd_barrier_post((unsigned*)(p.ws), xst);
    phase_tables(C, p);
    asm volatile("s_waitcnt vmcnt(0) lgkmcnt(0)" ::: "memory"); grid.sync();
    for (int l = 0; l < DEPTH; ++l) {
        { int t_ = threadIdx.x; asm volatile("" : "+v"(t_)); C.tid = t_; C.lane = t_ & 63; C.wave = __builtin_amdgcn_readfirstlane(t_ >> 6); }
        const float* xcur = (l == 0) ? p.x : p.out;
        for (int rep_ = 0; rep_ < DBG_REP_A; ++rep_) {
        phase_convert_weights(C, p, l);
        phase_norm(C, xcur, p.g_mix + l * DM, H);
        }
        GSYNC();
        for (int rep_ = 0; rep_ < DBG_XSYNC; ++rep_) GSYNC();
        for (int rep_ = 0; rep_ < DBG_REP_G; ++rep_) {
        { pg8::Epi<pg8::EPI_BF16> E{P, PN, nullptr, 0, nullptr, nullptr, 1.f}; run_gemm(C, H, DM, W + WO_IN, DM, T, PN, DM, E); }
        { pg8::Epi<pg8::EPI_BF16> E{VTA, T, nullptr, 0, nullptr, nullptr, 1.f}; run_gemm(C, W + WO_IN + (size_t)C_VA * DM, DM, H, DM, 256, T, DM, E, C.G / 2); }
        }
        GSYNC();
        {
            rownorm_rows(C, p, l, C.bid * 8 + C.wave, C.G * 8);
            for (int rep_ = 0; rep_ < DBG_REP_C; ++rep_) {
#if DBG_NAIVE & 1
            naive_swa(C, p, l);
#else
#ifdef SWA_V1
            for (int u = C.bid; u < 2048; u += C.G) attn_unit<true>(C, p, l, u);
#else
            for (int rs_ = 0; rs_ < DBG_REP_S; ++rs_) for (int u = C.bid; u < 256; u += C.G) swa_unit(C, p, l, u);
#endif
#endif
#if DBG_NAIVE & 2
            naive_conv(C, p, l);
#else
            for (int u = C.bid; u < T / 32; u += C.G) conv_unit(C, p, l, u);
#endif
            }
        }
        GSYNC();
        for (int rep_ = 0; rep_ < DBG_REP_G; ++rep_) {
        { pg8::Epi<pg8::EPI_BF16> E{QM, 768, nullptr, 0, nullptr, nullptr, 1.f}; run_gemm(C, P + C_CQ, PN, W + WO_Q, 256, T, 768, 256, E); }
        { pg8::Epi<pg8::EPI_BF16> E{KM, 512, nullptr, 0, nullptr, nullptr, 1.f}; run_gemm(C, P + C_CKV, PN, W + WO_K, 256, T, 512, 256, E); }
        { pg8::Epi<pg8::EPI_BF16> E{VTM, T, nullptr, 0, nullptr, nullptr, 1.f}; run_gemm(C, W + WO_V, 256, P + C_CKV, PN, 512, T, 256, E); }
        }
        GSYNC();
#if DBG_NAIVE & 4
        naive_mla(C, p, l);
#else
#ifdef MLA_V1
        for (int rep = 0; rep < DBG_REP_E; ++rep) for (int u = C.bid; u < 2048; u += C.G) attn_unit<false>(C, p, l, u);
#else
        for (int rep_ = 0; rep_ < DBG_REP_E; ++rep_) for (int u = C.bid; u < 1024; u += C.G) mla_unit(C, p, u);
#endif
#endif
        GSYNC();
#ifndef DBG_REP_E
#define DBG_REP_E 1
#endif
#ifndef DBG_REP_G
#define DBG_REP_G 1
#endif
#ifndef DBG_REP_C
#define DBG_REP_C 1
#endif
#ifndef DBG_SKIP
#define DBG_SKIP 0
#endif
#ifndef DBG_DBL
#define DBG_DBL 0
#endif
        for (int rep_ = 0; rep_ < DBG_REP_G; ++rep_) { int firstn = 1;
        for (int n = 0; n < 3; ++n) {
            if ((DBG_SKIP >> n) & 1) continue;
            { pg8::Epi<pg8::EPI_SIG> E{GS, DM, nullptr, 0, nullptr, nullptr, 1.f}; run_gemm(C, H, DM, W + WO_G + (size_t)n * DM * DM, DM, T, DM, DM, E); }
#ifdef DBG_FSYNC
            GSYNC();
#endif
            { pg8::Epi<pg8::EPI_GATEMUL> E{MG, DM, GS, firstn, nullptr, nullptr, ((DBG_DBL >> n) & 1) ? 2.f : 1.f}; run_gemm(C, Y + (size_t)n * T * 512, 512, W + WO_B + (size_t)n * DM * 512, 512, T, DM, 512, E); }
            firstn = 0;
        } }
        GSYNC();
        { pg8::Epi<pg8::EPI_RES> E{nullptr, DM, nullptr, 0, xcur, p.out, 1.f}; run_gemm(C, MG, DM, W + WO_O, DM, T, DM, DM, E); }
        GSYNC();
        for (int rep_ = 0; rep_ < DBG_REP_A; ++rep_) phase_norm(C, p.out, p.g_mlp + l * DM, H);
        GSYNC();
        for (int rep_ = 0; rep_ < DBG_REP_G; ++rep_)
        { pg8::Epi<pg8::EPI_RELU2> E{HID, DFF, nullptr, 0, nullptr, nullptr, 1.f}; run_gemm(C, H, DM, W + WO_U, DM, T, DFF, DM, E); }
        GSYNC();
        { pg8::Epi<pg8::EPI_RES> E{nullptr, DM, nullptr, 0, p.out, p.out, 1.f}; run_gemm(C, HID, DFF, W + WO_D, DFF, T, DM, DFF, E); }
        GSYNC();
    }
    phase_final_norm(C, p.g_final, p.out);
}

extern "C" void kernel_launch(void* const* d_in, const int* in_sizes, int n_in, void* d_out, int out_size, void* d_ws, size_t ws_size, hipStream_t stream) {
    static int grid = 0;
    if (grid == 0) {
        int dev = 0, cus = 0, per_cu = 0;
        hipGetDevice(&dev);
        hipDeviceGetAttribute(&cus, hipDeviceAttributeMultiprocessorCount, dev);
        hipFuncSetAttribute((const void*)mega_fwd, hipFuncAttributeMaxDynamicSharedMemorySize, LDS_BYTES);
        hipOccupancyMaxActiveBlocksPerMultiprocessor(&per_cu, (const void*)mega_fwd, 512, LDS_BYTES);
        if (per_cu < 1) per_cu = 1;
        grid = cus * per_cu;
        if (ws_size < WS_END) fprintf(stderr, "kernel_launch: workspace too small: %zu < %zu\n", ws_size, (size_t)WS_END);
    }
    Params p{};
    p.x = (const float*)d_in[0]; p.pos = (const int*)d_in[1]; p.rel_bias = (const float*)d_in[2]; p.g_final = (const float*)d_in[3]; p.g_mix = (const float*)d_in[4];
    p.w_in = (const float*)d_in[5]; p.sinks = (const float*)d_in[6]; p.g_qn = (const float*)d_in[7]; p.w_qup = (const float*)d_in[8]; p.g_kvn = (const float*)d_in[9];
    p.w_kvup = (const float*)d_in[10]; p.w_dw = (const float*)d_in[11]; p.b_dw = (const float*)d_in[12]; p.g_cln = (const float*)d_in[13]; p.b_cln = (const float*)d_in[14];
    p.w_branch = (const float*)d_in[15]; p.w_out = (const float*)d_in[16]; p.g_mlp = (const float*)d_in[17]; p.w_up = (const float*)d_in[18]; p.w_down = (const float*)d_in[19];
    p.out = (float*)d_out; p.ws = (unsigned char*)d_ws;
    hipMemsetAsync(d_ws, 0, XCD_BAR_WORDS * 4, stream);
    void* args[] = {&p};
    hipError_t e = hipLaunchCooperativeKernel((const void*)mega_fwd, dim3(grid), dim3(512), args, LDS_BYTES, stream);
    if (e != hipSuccess) fprintf(stderr, "cooperative launch failed: %s (grid %d)\n", hipGetErrorString(e), grid);
}
```

```cpp
#include <hip/hip_runtime.h>
#include <hip/hip_cooperative_groups.h>
#include <cstdio>
#include <cstdint>
namespace cg = cooperative_groups;

#ifndef DBG_REP_E
#define DBG_REP_E 1
#endif
#ifndef DBG_REP_G
#define DBG_REP_G 1
#endif
#ifndef DBG_REP_C
#define DBG_REP_C 1
#endif
#ifndef DBG_REP_A
#define DBG_REP_A 1
#endif
#ifndef DBG_XSYNC
#define DBG_XSYNC 0
#endif
#ifndef DBG_REP_S
#define DBG_REP_S 1
#endif
namespace pg8 {
#define PG8_LAS __attribute__((address_space(3)))
typedef unsigned short bf16_t;
typedef short bf16x8 __attribute__((ext_vector_type(8)));
typedef float f32x4 __attribute__((ext_vector_type(4)));
typedef unsigned u32x4 __attribute__((ext_vector_type(4)));
constexpr int BM = 256, BK = 64, HALF = 128, HTB = HALF * BK * 2  , STAGE_BYTES = 8 * HTB, NXCD = 8, WGM = 8;

__host__ __device__ __forceinline__ int lds_byte(int r, int c) { const int st = (r >> 4) * 2 + (c >> 5), rr = r & 15, cc = c & 31, ob = rr * 64 + cc * 2; return st * 1024 + (ob ^ (((ob >> 9) & 1) << 5)); }
__host__ __device__ __forceinline__ void stage_rc(int b, int& R, int& C) { const int st = b / 1024, sb = b % 1024, swz = sb ^ (((sb >> 9) & 1) << 5); R = (st >> 1) * 16 + swz / 64; C = (st & 1) * 32 + (swz % 64) / 2; }
__host__ __device__ __forceinline__ int perm32(int rho) { const int n = rho >> 4, i = rho & 15; return 8 * (i >> 2) + 4 * n + (i & 3); }

struct Unit { int pm, pn; };
struct Gemm { const bf16_t* A; const bf16_t* Bt; int lda, ldb, M, N, K; };

struct StaticOrder {
    int nM, nN, nwg, G, c;
    __host__ __device__ void init(int M, int N, int G_, int c_) { nM = M / BM; nN = N / BM; nwg = nM * nN; G = G_; c = c_; }
    __host__ __device__ bool next(int i, Unit& u) const {
        const long L = (long)i * G + c; if (L >= nwg) return false;
        int wgid = (int)L; { const int q = nwg / NXCD, r = nwg % NXCD, xcd = wgid % NXCD, off = wgid / NXCD; wgid = (xcd < r ? xcd * (q + 1) : r * (q + 1) + (xcd - r) * q) + off; }
        const int nig = WGM * nN, gid = wgid / nig, fm = gid * WGM, gsz = (nM - fm) < WGM ? (nM - fm) : WGM;
        u.pm = fm + ((wgid % nig) % gsz); u.pn = (wgid % nig) / gsz; return true;
    }
    __device__ __forceinline__ void a_ready(const Unit&) const {}
    __device__ __forceinline__ void done(const Unit&) const {}
};

__device__ __forceinline__ unsigned cvt_pk_bf16(float lo, float hi) { unsigned r; asm volatile("v_cvt_pk_bf16_f32 %0, %1, %2" : "=v"(r) : "v"(lo), "v"(hi)); return r; }

template <class Epi, class Sched, bool ALIGN_EPI = false, bool SP2 = false>
__device__ __forceinline__ void gemm_phase(PG8_LAS unsigned char* lds, const Gemm g, const Sched& S, const Epi& E) {
    int tid_ = threadIdx.x; asm volatile("" : "+v"(tid_));
    const int tid = tid_, wid = __builtin_amdgcn_readfirstlane(tid >> 6), lane = tid & 63, wr = wid >> 2, wc = wid & 3, fr = lane & 15, fq = lane >> 4;
    const int K = g.K, nt = K / BK;
    unsigned voffA[2], voffB[2];
#pragma unroll
    for (int i = 0; i < 2; ++i) { int R, C; stage_rc(tid * 16 + i * 8192, R, C); const int Rb = Epi::PERM ? ((R & ~31) + perm32(R & 31)) : R;
        voffA[i] = (unsigned)(R * g.lda + C) * 2u; voffB[i] = (unsigned)(Rb * g.ldb + C) * 2u; }
    const size_t kstep = (size_t)(BK * 2);
    const size_t hstepA = (size_t)HALF * g.lda * 2, hstepB = (size_t)HALF * g.ldb * 2;
    const size_t tstepA = 2 * hstepA, tstepB = 2 * hstepB;
    const unsigned ldsw = (unsigned)wid * 1024u;
    const int aoff = lds_byte(wr * 64 + fr, fq * 8), boff = lds_byte(wc * 32 + fr, fq * 8);
#define PG8_SA(b, h) (((b) * 2 + (h)) * HTB)
#define PG8_SB(b, h) ((4 + (b) * 2 + (h)) * HTB)
#define PG8_STAGE(bufoff, gbase, voff) do { _Pragma("unroll") for (int _i = 0; _i < 2; ++_i) \
        __builtin_amdgcn_global_load_lds((const unsigned*)((const char*)(gbase) + (voff)[_i]), (PG8_LAS unsigned*)(lds + (bufoff) + ldsw + _i * 8192), 16, 0, 0); } while (0)
#define PG8_LDA(dst, b, h) do { _Pragma("unroll") for (int m = 0; m < 4; ++m) _Pragma("unroll") for (int k = 0; k < 2; ++k) dst[m][k] = *(const PG8_LAS bf16x8*)(lds + PG8_SA(b, h) + aoff + m * 2048 + k * 1024); } while (0)
#define PG8_LDB(dst, b, h) do { _Pragma("unroll") for (int n = 0; n < 2; ++n) _Pragma("unroll") for (int k = 0; k < 2; ++k) dst[n][k] = *(const PG8_LAS bf16x8*)(lds + PG8_SB(b, h) + boff + n * 2048 + k * 1024); } while (0)
#define PG8_MMA(ai, bj, At, Bt) do { __builtin_amdgcn_s_setprio(1); _Pragma("unroll") for (int m = 0; m < 4; ++m) _Pragma("unroll") for (int n = 0; n < 2; ++n) _Pragma("unroll") for (int k = 0; k < 2; ++k) \
        acc[ai][bj][m][n] = __builtin_amdgcn_mfma_f32_16x16x32_bf16(Bt[n][k], At[m][k], acc[ai][bj][m][n], 0, 0, 0); __builtin_amdgcn_s_setprio(0); } while (0)
#define PG8_WAIT_V(n) asm volatile("s_waitcnt vmcnt(" #n ")" ::: "memory")
#define PG8_WAIT_L(n) asm volatile("s_waitcnt lgkmcnt(" #n ")" ::: "memory")
#define PG8_BAR __builtin_amdgcn_s_barrier()
#define PG8_SCHED __builtin_amdgcn_sched_barrier(0)
    Unit cur, nxt; int ui = 0;
    if (!S.next(0, cur)) return;
    f32x4 acc[2][2][4][2];
#pragma unroll
    for (int a = 0; a < 2; ++a)
#pragma unroll
        for (int b = 0; b < 2; ++b)
#pragma unroll
            for (int m = 0; m < 4; ++m)
#pragma unroll
                for (int n = 0; n < 2; ++n) acc[a][b][m][n] = (f32x4){0.f, 0.f, 0.f, 0.f};
    bf16x8 At[4][2], B0[2][2], B1[2][2];
    const char* cA = (const char*)g.A + (size_t)cur.pm * tstepA; const char* cB = (const char*)g.Bt + (size_t)cur.pn * tstepB;
    S.a_ready(cur);
    if constexpr (SP2) {
        PG8_STAGE(PG8_SB(0, 0), cB, voffB); PG8_STAGE(PG8_SB(0, 1), cB + hstepB, voffB); PG8_STAGE(PG8_SA(0, 0), cA, voffA); PG8_STAGE(PG8_SA(0, 1), cA + hstepA, voffA);
        if (wr == 1) PG8_BAR;
        PG8_WAIT_V(2); PG8_BAR;
        PG8_STAGE(PG8_SB(1, 0), cB + kstep, voffB); PG8_STAGE(PG8_SA(1, 0), cA + kstep, voffA); PG8_STAGE(PG8_SB(1, 1), cB + hstepB + kstep, voffB);
        PG8_WAIT_V(6); PG8_BAR;
    } else {
        PG8_STAGE(PG8_SB(0, 0), cB, voffB); PG8_STAGE(PG8_SA(0, 0), cA, voffA); PG8_STAGE(PG8_SB(0, 1), cB + hstepB, voffB); PG8_STAGE(PG8_SA(0, 1), cA + hstepA, voffA);
        if (wr == 1) PG8_BAR;
        PG8_WAIT_V(4); PG8_BAR;
        PG8_STAGE(PG8_SB(1, 0), cB + kstep, voffB); PG8_STAGE(PG8_SA(1, 0), cA + kstep, voffA); PG8_STAGE(PG8_SB(1, 1), cB + hstepB + kstep, voffB);
        PG8_WAIT_V(6); PG8_BAR;
    }
    for (;;) {
        const bool has_next = S.next(ui + 1, nxt);
        const char* nA = has_next ? (const char*)g.A + (size_t)nxt.pm * tstepA : cA; const char* nB = has_next ? (const char*)g.Bt + (size_t)nxt.pn * tstepB : cB;
        for (int t = 0; t < nt; t += 2) {
            const bool last = (t == nt - 2);
            const char* a1 = cA + (size_t)(t + 1) * kstep;
            const char* a2 = last ? nA : cA + (size_t)(t + 2) * kstep; const char* b2 = last ? nB : cB + (size_t)(t + 2) * kstep;
            const char* a3 = a2 + kstep; const char* b3 = b2 + kstep;
            if (last && has_next) S.a_ready(nxt);
            if constexpr (SP2) {
            PG8_LDB(B0, 0, 0); PG8_LDB(B1, 0, 1); PG8_SCHED; PG8_LDA(At, 0, 0); PG8_STAGE(PG8_SA(1, 1), a1 + hstepA, voffA);
            PG8_WAIT_V(8); PG8_WAIT_L(0); PG8_BAR; PG8_MMA(0, 0, At, B0); PG8_MMA(0, 1, At, B1); PG8_BAR; PG8_SCHED;
            PG8_LDA(At, 0, 1); PG8_STAGE(PG8_SB(0, 0), b2, voffB); PG8_STAGE(PG8_SB(0, 1), b2 + hstepB, voffB); PG8_STAGE(PG8_SA(0, 0), a2, voffA);
            PG8_WAIT_V(8); PG8_WAIT_L(0); PG8_BAR; PG8_MMA(1, 0, At, B0); PG8_MMA(1, 1, At, B1); PG8_BAR; PG8_SCHED;
            PG8_LDB(B0, 1, 0); PG8_LDB(B1, 1, 1); PG8_SCHED; PG8_LDA(At, 1, 0); PG8_STAGE(PG8_SA(0, 1), a2 + hstepA, voffA);
            PG8_WAIT_V(8); PG8_WAIT_L(0); PG8_BAR; PG8_MMA(0, 0, At, B0); PG8_MMA(0, 1, At, B1); PG8_BAR; PG8_SCHED;
            PG8_LDA(At, 1, 1); PG8_STAGE(PG8_SB(1, 0), b3, voffB); PG8_STAGE(PG8_SB(1, 1), b3 + hstepB, voffB); PG8_STAGE(PG8_SA(1, 0), a3, voffA);
            PG8_WAIT_V(8); PG8_WAIT_L(0); PG8_BAR; PG8_MMA(1, 0, At, B0); PG8_MMA(1, 1, At, B1); PG8_BAR; PG8_SCHED;
            } else {
            PG8_LDB(B0, 0, 0); PG8_SCHED; PG8_LDA(At, 0, 0); PG8_STAGE(PG8_SA(1, 1), a1 + hstepA, voffA);
            PG8_WAIT_L(8); PG8_BAR; PG8_WAIT_L(0); PG8_MMA(0, 0, At, B0); PG8_BAR; PG8_SCHED;
            PG8_LDB(B1, 0, 1); PG8_STAGE(PG8_SB(0, 0), b2, voffB);
            PG8_BAR; PG8_WAIT_L(0); PG8_MMA(0, 1, At, B1); PG8_BAR;
            PG8_LDA(At, 0, 1); PG8_STAGE(PG8_SA(0, 0), a2, voffA);
            PG8_BAR; PG8_WAIT_L(0); PG8_MMA(1, 0, At, B0); PG8_BAR; PG8_SCHED;
            PG8_STAGE(PG8_SB(0, 1), b2 + hstepB, voffB);
            PG8_WAIT_V(6); PG8_BAR; PG8_MMA(1, 1, At, B1); PG8_BAR;
            PG8_LDB(B0, 1, 0); PG8_SCHED; PG8_LDA(At, 1, 0); PG8_STAGE(PG8_SA(0, 1), a2 + hstepA, voffA);
            PG8_WAIT_L(8); PG8_BAR; PG8_WAIT_L(0); PG8_MMA(0, 0, At, B0); PG8_BAR; PG8_SCHED;
            PG8_LDB(B1, 1, 1); PG8_STAGE(PG8_SB(1, 0), b3, voffB);
            PG8_BAR; PG8_WAIT_L(0); PG8_MMA(0, 1, At, B1); PG8_BAR;
            PG8_LDA(At, 1, 1); PG8_STAGE(PG8_SA(1, 0), a3, voffA);
            PG8_BAR; PG8_WAIT_L(0); PG8_MMA(1, 0, At, B0); PG8_BAR; PG8_SCHED;
            PG8_STAGE(PG8_SB(1, 1), b3 + hstepB, voffB);
            PG8_WAIT_V(6); PG8_BAR; PG8_MMA(1, 1, At, B1); PG8_BAR;
            }
        }
        if constexpr (ALIGN_EPI) { if (wr == 0) PG8_BAR; }
        if constexpr (!Epi::AFTER_DRAIN) { E(acc, cur, wr, wc, fr, fq); S.done(cur); }
        if (!has_next) break;
#pragma unroll
        for (int a = 0; a < 2; ++a)
#pragma unroll
            for (int b = 0; b < 2; ++b)
#pragma unroll
                for (int m = 0; m < 4; ++m)
#pragma unroll
                    for (int n = 0; n < 2; ++n) acc[a][b][m][n] = (f32x4){0.f, 0.f, 0.f, 0.f};
        cur = nxt; cA = nA; cB = nB; ++ui;
        if constexpr (ALIGN_EPI) { if (wr == 1) PG8_BAR; }
    }
    PG8_WAIT_V(0);
    if constexpr (!ALIGN_EPI) { if (wr == 0) PG8_BAR; }
    PG8_BAR;
    if constexpr (Epi::AFTER_DRAIN) { E.fused(acc, cur, wr, wc, fr, fq, lds, wid, lane); S.done(cur); }
#undef PG8_SA
#undef PG8_SB
#undef PG8_STAGE
#undef PG8_LDA
#undef PG8_LDB
#undef PG8_MMA
#undef PG8_WAIT_V
#undef PG8_WAIT_L
#undef PG8_BAR
#undef PG8_SCHED
}
}

constexpr int BATCH = 8, SEQ = 4096, DM = 1024, DEPTH = 4, T = BATCH * SEQ;
constexpr int INC = 5280, PN = 2304, DFF = 4096;
constexpr int C_QA = 0, C_KA = 512, C_VA = 640, C_UB = 768, C_CQ = 1792, C_CKV = 2048, C_KPE = 2176, C_GATE = 2208;
constexpr float EPS = 1e-6f, LOG2E = 1.4426950408889634f;
constexpr size_t MiB = 1u << 20;
constexpr size_t WS_ROPE = 1 * MiB;
constexpr size_t WS_BT = 5 * MiB;
constexpr size_t WS_W = 8 * MiB;
constexpr size_t WS_H = 41 * MiB;
constexpr size_t WS_P = 105 * MiB;
constexpr size_t WS_Y = 249 * MiB;
constexpr size_t WS_QM = 345 * MiB;
constexpr size_t WS_KM = 393 * MiB;
constexpr size_t WS_VTM = 425 * MiB;
constexpr size_t WS_VTA = 457 * MiB;
constexpr size_t WS_END = 473 * MiB;
constexpr size_t WS_MG = WS_QM;
constexpr size_t WS_GS = WS_P;
constexpr size_t WS_HID = WS_P;
constexpr size_t WO_IN = 0;
constexpr size_t WO_G = WO_IN + (size_t)2304 * 1024;
constexpr size_t WO_Q = WO_G + (size_t)3072 * 1024;
constexpr size_t WO_K = WO_Q + (size_t)768 * 256;
constexpr size_t WO_V = WO_K + (size_t)512 * 256;
constexpr size_t WO_B = WO_V + (size_t)512 * 256;
constexpr size_t WO_O = WO_B + (size_t)3 * 1024 * 512;
constexpr size_t WO_U = WO_O + (size_t)1024 * 1024;
constexpr size_t WO_D = WO_U + (size_t)4096 * 1024;
constexpr size_t WO_END = WO_D + (size_t)1024 * 4096;
static_assert(WO_END * 2 <= 33 * MiB, "weights fit");

constexpr int RING_BYTES = 131072, LDS_BYTES = 135168;
#define LAS __attribute__((address_space(3)))
typedef unsigned short bf16;
typedef unsigned v4u __attribute__((ext_vector_type(4)));
typedef unsigned v2u __attribute__((ext_vector_type(2)));
typedef float f32x4 __attribute__((ext_vector_type(4)));
typedef float f32x2 __attribute__((ext_vector_type(2)));
typedef short bf16x8 __attribute__((ext_vector_type(8)));

__device__ __forceinline__ unsigned f2bf(float f) { unsigned u = __builtin_bit_cast(unsigned, f); return (u + 0x7fffu + ((u >> 16) & 1u)) >> 16; }
__device__ __forceinline__ unsigned pk2(float lo, float hi) { return f2bf(lo) | (f2bf(hi) << 16); }
typedef float f32x2q __attribute__((ext_vector_type(2))); typedef __bf16 bf16x2q __attribute__((ext_vector_type(2)));
__device__ __forceinline__ unsigned pkhw(float lo, float hi) { f32x2q v = {lo, hi}; bf16x2q b = __builtin_convertvector(v, bf16x2q); return __builtin_bit_cast(unsigned, b); }
__device__ __forceinline__ float rowmax4(float v) {
    auto r16 = __builtin_amdgcn_permlane16_swap(__float_as_uint(v), __float_as_uint(v), false, false);
    v = fmaxf(__uint_as_float(r16[0]), __uint_as_float(r16[1]));
    auto r32 = __builtin_amdgcn_permlane32_swap(__float_as_uint(v), __float_as_uint(v), false, false);
    return fmaxf(__uint_as_float(r32[0]), __uint_as_float(r32[1]));
}
__device__ __forceinline__ float bf2f(unsigned short h) { return __builtin_bit_cast(float, (unsigned)h << 16); }
__device__ __forceinline__ float bflo(unsigned w) { return __builtin_bit_cast(float, w << 16); }
__device__ __forceinline__ float bfhi(unsigned w) { return __builtin_bit_cast(float, w & 0xffff0000u); }
__device__ __forceinline__ float wave_sum(float v) {
#pragma unroll
    for (int o = 1; o < 64; o <<= 1) v += __shfl_xor(v, o);
    return v;
}
__device__ __forceinline__ float sigmoidf_(float x) { return __builtin_amdgcn_rcpf(1.0f + __builtin_amdgcn_exp2f(-x * LOG2E)); }

struct Params {
    const float* x; const int* pos; const float* rel_bias; const float* g_final; const float* g_mix; const float* w_in; const float* sinks;
    const float* g_qn; const float* w_qup; const float* g_kvn; const float* w_kvup; const float* w_dw; const float* b_dw; const float* g_cln; const float* b_cln;
    const float* w_branch; const float* w_out; const float* g_mlp; const float* w_up; const float* w_down;
    float* out; unsigned char* ws;
};

namespace pg8 {
enum { EPI_BF16 = 0, EPI_SIG = 1, EPI_GATEMUL = 2, EPI_RES = 3, EPI_RELU2 = 4 };
typedef float f32x2p __attribute__((ext_vector_type(2))); typedef __bf16 bf16x2p __attribute__((ext_vector_type(2)));
__device__ __forceinline__ unsigned pkbf(float lo, float hi) { f32x2p v = {lo, hi}; bf16x2p b = __builtin_convertvector(v, bf16x2p); return __builtin_bit_cast(unsigned, b); }
template <int MODE> struct Epi {
    static constexpr bool PERM = true, AFTER_DRAIN = false;
    bf16_t* O; int ldc; const bf16_t* G; int first; const float* base; float* outf; float bscale;
    __device__ __forceinline__ void operator()(const f32x4 (&acc)[2][2][4][2], const Unit& u, int wr, int wc, int fr, int fq) const {
        const int row0 = u.pm * BM + wr * 64 + fr; const int col0 = u.pn * BM + wc * 32 + 8 * fq;
#pragma unroll
        for (int ai = 0; ai < 2; ++ai)
#pragma unroll
            for (int m = 0; m < 4; ++m) {
                const size_t roff = (size_t)(row0 + ai * HALF + m * 16) * (size_t)ldc + col0;
#pragma unroll
                for (int bj = 0; bj < 2; ++bj) {
                    f32x4 v0 = acc[ai][bj][m][0], v1 = acc[ai][bj][m][1];
                    const size_t off = roff + bj * HALF;
                    if constexpr (MODE == EPI_RES) {
                        const f32x4 b0 = *(const f32x4*)(base + off), b1 = *(const f32x4*)(base + off + 4);
                        *(f32x4*)(outf + off) = b0 + v0; *(f32x4*)(outf + off + 4) = b1 + v1;
                    } else {
                        if constexpr (MODE == EPI_SIG) {
#pragma unroll
                            for (int e = 0; e < 4; ++e) { v0[e] = sigmoidf_(v0[e]); v1[e] = sigmoidf_(v1[e]); }
                        }
                        if constexpr (MODE == EPI_RELU2) {
#pragma unroll
                            for (int e = 0; e < 4; ++e) { float a = fmaxf(v0[e], 0.f), b = fmaxf(v1[e], 0.f); v0[e] = a * a; v1[e] = b * b; }
                        }
                        if constexpr (MODE == EPI_GATEMUL) {
                            const u32x4 gw = *(const u32x4*)(G + off); v0 = v0 * bscale; v1 = v1 * bscale;
                            v0[0] *= bflo(gw.x); v0[1] *= bfhi(gw.x); v0[2] *= bflo(gw.y); v0[3] *= bfhi(gw.y);
                            v1[0] *= bflo(gw.z); v1[1] *= bfhi(gw.z); v1[2] *= bflo(gw.w); v1[3] *= bfhi(gw.w);
                            if (!first) {
                                const u32x4 ow = *(const u32x4*)(O + off);
                                v0[0] += bflo(ow.x); v0[1] += bfhi(ow.x); v0[2] += bflo(ow.y); v0[3] += bfhi(ow.y);
                                v1[0] += bflo(ow.z); v1[1] += bfhi(ow.z); v1[2] += bflo(ow.w); v1[3] += bfhi(ow.w);
                            }
                        }
                        u32x4 w; w.x = pkbf(v0[0], v0[1]); w.y = pkbf(v0[2], v0[3]); w.z = pkbf(v1[0], v1[1]); w.w = pkbf(v1[2], v1[3]);
                        *(u32x4*)(O + off) = w;
                    }
                }
            }
    }
};
}

struct Ctx { LAS unsigned char* lds; int tid, lane, wave, G, bid; };

__device__ __forceinline__ Ctx relaunder(const Ctx& C0) {
    Ctx C = C0; int t_ = C0.tid; asm volatile("" : "+v"(t_)); C.tid = t_; C.lane = t_ & 63; C.wave = __builtin_amdgcn_readfirstlane(t_ >> 6); return C;
}

__device__ __forceinline__ void tr_item(const float* W, int ldw, int c0, bf16* WT, int ldk, int r0, int nblk, int item, LAS float* scr, int lane) {
    const int kb = item / nblk, nb = item % nblk, k0 = 64 * kb, n0 = 32 * nb;
#pragma unroll 8
    for (int i = 0; i < 32; ++i) { const int kk = 2 * i + (lane >> 5); scr[kk * 33 + (lane & 31)] = W[(size_t)(k0 + kk) * ldw + c0 + n0 + (lane & 31)]; }
    asm volatile("s_waitcnt lgkmcnt(0)" ::: "memory");
    const int c = lane & 7;
#pragma unroll
    for (int j = 0; j < 4; ++j) { const int n = (lane >> 3) + 8 * j; const LAS float* s = scr + (8 * c) * 33 + n;
        v4u o; o.x = pk2(s[0 * 33], s[1 * 33]); o.y = pk2(s[2 * 33], s[3 * 33]); o.z = pk2(s[4 * 33], s[5 * 33]); o.w = pk2(s[6 * 33], s[7 * 33]);
        *(v4u*)(WT + (size_t)(r0 + n0 + n) * ldk + k0 + 8 * c) = o; }
    asm volatile("s_waitcnt lgkmcnt(0)" ::: "memory");
}

__device__ __forceinline__ void phase_convert_weights(const Ctx& C0, const Params& p, int l) {
    const Ctx C = relaunder(C0);
    LAS float* scr = (LAS float*)(C.lds + C.wave * 16384);
    bf16* W = (bf16*)(p.ws + WS_W);
    const int gw = C.bid * 8 + C.wave, NGW = C.G * 8;
    const float* w_in = p.w_in + (size_t)l * 1024 * INC;
    const float* w_qup = p.w_qup + (size_t)l * 256 * 768;
    const float* w_kvup = p.w_kvup + (size_t)l * 128 * 1024;
    const float* w_br = p.w_branch + (size_t)l * 3 * 512 * 1024;
    const float* w_out = p.w_out + (size_t)l * 1024 * 1024;
    const float* w_up = p.w_up + (size_t)l * 1024 * 4096;
    const float* w_down = p.w_down + (size_t)l * 4096 * 1024;
    constexpr int I_IN = 16 * 69, I_G = 16 * 96, I_Q = 4 * 24, I_KV = 16 * 4, I_B = 3 * 8 * 32, I_O = 16 * 32, I_U = 16 * 128, I_D = 64 * 32;
    constexpr int NITEMS = I_IN + I_G + I_Q + I_KV + I_B + I_O + I_U + I_D;
    for (int it = gw; it < NITEMS; it += NGW) {
        int r = it;
        if (r < I_IN) { tr_item(w_in, INC, 0, W + WO_IN, 1024, 0, 69, r, scr, C.lane); continue; } r -= I_IN;
        if (r < I_G) { tr_item(w_in, INC, C_GATE, W + WO_G, 1024, 0, 96, r, scr, C.lane); continue; } r -= I_G;
        if (r < I_Q) { tr_item(w_qup, 768, 0, W + WO_Q, 256, 0, 24, r, scr, C.lane); continue; } r -= I_Q;
        if (r < I_KV) { const int job = r >> 2, sub = r & 3, h = job >> 1, part = job & 1;
            tr_item(w_kvup, 1024, h * 128 + part * 64, W + (part ? WO_V : WO_K), 256, h * 64, 2, sub, scr, C.lane); continue; } r -= I_KV;
        if (r < I_B) { const int n = r / 256, s = r % 256; tr_item(w_br + (size_t)n * 512 * 1024, 1024, 0, W + WO_B + (size_t)n * 1024 * 512, 512, 0, 32, s, scr, C.lane); continue; } r -= I_B;
        if (r < I_O) { tr_item(w_out, 1024, 0, W + WO_O, 1024, 0, 32, r, scr, C.lane); continue; } r -= I_O;
        if (r < I_U) { tr_item(w_up, 4096, 0, W + WO_U, 1024, 0, 128, r, scr, C.lane); continue; } r -= I_U;
        tr_item(w_down, 1024, 0, W + WO_D, 4096, 0, 32, r, scr, C.lane);
    }
    const int gt = C.bid * 512 + C.tid, NGT = C.G * 512;
    for (int i = gt; i < 96 * 1024 / 8; i += NGT) *(v4u*)(W + WO_IN + (size_t)2208 * 1024 + (size_t)i * 8) = (v4u){0u, 0u, 0u, 0u};
    for (int i = gt; i < 1024 * 16; i += NGT) { const int row = i >> 4, c = i & 15; *(v4u*)(W + WO_K + (size_t)row * 256 + 128 + c * 8) = (v4u){0u, 0u, 0u, 0u}; }
}

__device__ __forceinline__ void phase_tables(const Ctx& C, const Params& p) {
    const int gt = C.bid * 512 + C.tid, NGT = C.G * 512;
    f32x2* cs = (f32x2*)(p.ws + WS_ROPE);
    for (int idx = gt; idx < T * 16; idx += NGT) {
        const int t = idx >> 4, i = idx & 15;
        const float freq = (float)exp(-9.210340371976184 * (double)i / 16.0);
        const float ang = (float)p.pos[t] * freq;
        double r = (double)ang * 0.15915494309189535; r -= rint(r);
        const double xx = r * 6.283185307179586, x2 = xx * xx;
        double s = 1.0 / 51090942171709440000.0, c = 1.0 / 1124000727777607680000.0;
        s = s * x2 - 1.0 / 121645100408832000.0;  c = c * -x2 + 1.0 / 2432902008176640000.0;
        s = s * x2 + 1.0 / 355687428096000.0;
        s = s * x2 - 1.0 / 1307674368000.0;
        s = s * x2 + 1.0 / 6227020800.0;
        s = s * x2 - 1.0 / 39916800.0;
        s = s * x2 + 1.0 / 362880.0;
        s = s * x2 - 1.0 / 5040.0;
        s = s * x2 + 1.0 / 120.0;
        s = s * x2 - 1.0 / 6.0;
        s = s * x2 + 1.0;
        s = s * xx;
        c = c * x2 - 1.0 / 6402373705728000.0;
        c = c * x2 + 1.0 / 20922789888000.0;
        c = c * x2 - 1.0 / 87178291200.0;
        c = c * x2 + 1.0 / 479001600.0;
        c = c * x2 - 1.0 / 3628800.0;
        c = c * x2 + 1.0 / 40320.0;
        c = c * x2 - 1.0 / 720.0;
        c = c * x2 + 1.0 / 24.0;
        c = c * x2 - 0.5;
        c = c * x2 + 1.0;
        cs[idx] = (f32x2){(float)c, (float)s};
    }
    float* bt = (float*)(p.ws + WS_BT);
    for (int idx = gt; idx < 129 * 8; idx += NGT) {
        const int n = idx >> 3, h = idx & 7; int bucket;
        if (n < 16) bucket = n;
        else { const float nf = (float)n; int large = 16 + (int)(logf(nf / 16.0f) / 2.0794415416798357f * 16.0f); bucket = large < 31 ? large : 31; }
        bt[idx] = p.rel_bias[bucket * 8 + h];
    }
}

__device__ __forceinline__ void phase_norm(const Ctx& C0, const float* xin, const float* g, bf16* hout) {
    const Ctx C = relaunder(C0);
    const int gw = C.bid * 8 + C.wave, NGW = C.G * 8;
    f32x4 gv[4];
#pragma unroll
    for (int j = 0; j < 4; ++j) gv[j] = *((const f32x4*)g + C.lane + 64 * j);
    for (int m = gw; m < T; m += 2 * NGW) {
        const int m2 = m + NGW; const bool has2 = m2 < T;
        const f32x4* xr = (const f32x4*)(xin + (size_t)m * DM) + C.lane; const f32x4* xr2 = (const f32x4*)(xin + (size_t)(has2 ? m2 : m) * DM) + C.lane;
        f32x4 v[4], u[4]; float s = 0.f, s2 = 0.f;
#pragma unroll
        for (int j = 0; j < 4; ++j) { v[j] = xr[64 * j]; u[j] = xr2[64 * j]; }
#pragma unroll
        for (int j = 0; j < 4; ++j) { s += (v[j].x * v[j].x + v[j].y * v[j].y) + (v[j].z * v[j].z + v[j].w * v[j].w); s2 += (u[j].x * u[j].x + u[j].y * u[j].y) + (u[j].z * u[j].z + u[j].w * u[j].w); }
        const float rstd = 1.0f / sqrtf(wave_sum(s) * (1.f / DM) + EPS), rstd2 = 1.0f / sqrtf(wave_sum(s2) * (1.f / DM) + EPS);
        v2u* o8 = (v2u*)(hout + (size_t)m * DM) + C.lane;
#pragma unroll
        for (int j = 0; j < 4; ++j) { v2u w; w.x = pk2(v[j].x * rstd * gv[j].x, v[j].y * rstd * gv[j].y); w.y = pk2(v[j].z * rstd * gv[j].z, v[j].w * rstd * gv[j].w); o8[64 * j] = w; }
        if (has2) { v2u* p8 = (v2u*)(hout + (size_t)m2 * DM) + C.lane;
#pragma unroll
            for (int j = 0; j < 4; ++j) { v2u w; w.x = pk2(u[j].x * rstd2 * gv[j].x, u[j].y * rstd2 * gv[j].y); w.y = pk2(u[j].z * rstd2 * gv[j].z, u[j].w * rstd2 * gv[j].w); p8[64 * j] = w; } }
    }
}
__device__ __forceinline__ void phase_final_norm(const Ctx& C, const float* g, float* x, float dbg_add = 0.f) {
    const int gw = C.bid * 8 + C.wave, NGW = C.G * 8;
    f32x4 gv[4];
#pragma unroll
    for (int j = 0; j < 4; ++j) gv[j] = *((const f32x4*)g + C.lane + 64 * j);
    for (int m = gw; m < T; m += NGW) {
        f32x4* xr = (f32x4*)(x + (size_t)m * DM) + C.lane;
        f32x4 v[4]; float s = 0.f;
#pragma unroll
        for (int j = 0; j < 4; ++j) { v[j] = xr[64 * j]; s += (v[j].x * v[j].x + v[j].y * v[j].y) + (v[j].z * v[j].z + v[j].w * v[j].w); }
        const float rstd = 1.0f / sqrtf(wave_sum(s) * (1.f / DM) + EPS);
#pragma unroll
        for (int j = 0; j < 4; ++j) xr[64 * j] = v[j] * rstd * gv[j] + dbg_add;
#ifdef DBG_ZERO
        { const int s_ = m & (SEQ - 1); if (DBG_ZERO) {
#pragma unroll
            for (int j = 0; j < 4; ++j) xr[64 * j] = (f32x4){0.f, 0.f, 0.f, 0.f}; } }
#endif
    }
}

__device__ __forceinline__ void rownorm_rows(const Ctx& C0, const Params& p, int l, int gw, int NGW) {
    const Ctx C = relaunder(C0);
    bf16* P = (bf16*)(p.ws + WS_P);
    const f32x2* cs = (const f32x2*)(p.ws + WS_ROPE);
    const float* gq = p.g_qn + l * 256; const float* gkv = p.g_kvn + l * 128;
    const f32x4 gqv = *((const f32x4*)gq + C.lane); const f32x2 gkvv = *((const f32x2*)gkv + C.lane);
    for (int m = gw; m < T; m += 2 * NGW) {
        const int mm[2] = {m, (m + NGW < T) ? m + NGW : m}; const int nrow = (m + NGW < T) ? 2 : 1;
        v2u cw[2]; unsigned kw[2]; float x1[2], x2[2]; f32x2 cc[2];
#pragma unroll
        for (int r = 0; r < 2; ++r) { const bf16* row = P + (size_t)mm[r] * PN; cw[r] = *((const v2u*)(row + C_CQ) + C.lane); kw[r] = *((const unsigned*)(row + C_CKV) + C.lane);
            x1[r] = bf2f(row[C_KPE + (C.lane & 15)]); x2[r] = bf2f(row[C_KPE + 16 + (C.lane & 15)]); cc[r] = cs[(size_t)mm[r] * 16 + (C.lane & 15)]; }
#pragma unroll
        for (int r = 0; r < 2; ++r) {
            if (r < nrow) {
            bf16* row = P + (size_t)mm[r] * PN;
            const float a0 = bflo(cw[r].x), a1 = bfhi(cw[r].x), a2 = bflo(cw[r].y), a3 = bfhi(cw[r].y);
            const float rq = 1.0f / sqrtf(wave_sum((a0 * a0 + a1 * a1) + (a2 * a2 + a3 * a3)) * (1.f / 256.f) + EPS);
            const float b0 = bflo(kw[r]), b1 = bfhi(kw[r]);
            const float rk = 1.0f / sqrtf(wave_sum(b0 * b0 + b1 * b1) * (1.f / 128.f) + EPS);
            v2u ow; ow.x = pk2(a0 * rq * gqv.x, a1 * rq * gqv.y); ow.y = pk2(a2 * rq * gqv.z, a3 * rq * gqv.w); *((v2u*)(row + C_CQ) + C.lane) = ow;
            *((unsigned*)(row + C_CKV) + C.lane) = pk2(b0 * rk * gkvv.x, b1 * rk * gkvv.y);
            if (C.lane < 16) {
                f32x2 c = cc[r];
#ifdef DBG_NOROPE
                c = (f32x2){1.f, 0.f};
#endif
                row[C_KPE + C.lane] = (bf16)f2bf(x1[r] * c.x - x2[r] * c.y);
                row[C_KPE + 16 + C.lane] = (bf16)f2bf(x2[r] * c.x + x1[r] * c.y);
            }
            }
        }
    }
}

template <bool SWA>
__device__ __forceinline__ void attn_unit(const Ctx& C, const Params& p, int l, int unit) {
    constexpr int NKK = SWA ? 2 : 3;
    const int lane = C.lane, fr = lane & 15, fq = lane >> 4;
    int b, h, qb;
    if constexpr (SWA) { b = unit >> 8; h = (unit >> 5) & 7; qb = unit & 31; }
    else {
        const int k = unit >> 8, i = unit & 255, g = i >> 6, bh = i & 63;
        qb = 31 - 4 * k - ((k & 1) ? (3 - g) : g); b = bh >> 3; h = bh & 7;
    }
    const int q0 = qb * 128 + C.wave * 16;
    const size_t tok0 = (size_t)b * SEQ;
    const size_t qrow = tok0 + q0 + fr;
    const bf16* P = (const bf16*)(p.ws + WS_P);
    bf16x8 qf[NKK];
    if constexpr (SWA) {
        const bf16* qp = P + qrow * PN + C_QA + h * 64 + fq * 8;
        qf[0] = *(const bf16x8*)qp; qf[1] = *(const bf16x8*)(qp + 32);
    } else {
        const bf16* qp = (const bf16*)(p.ws + WS_QM) + qrow * 768 + h * 96 + fq * 8;
        qf[0] = *(const bf16x8*)qp; qf[1] = *(const bf16x8*)(qp + 32);
        const v4u raw = *(const v4u*)(qp + 64);
        const f32x2* cs = (const f32x2*)(p.ws + WS_ROPE) + qrow * 16 + (fq & 1) * 8;
        float own[8] = {bflo(raw.x), bfhi(raw.x), bflo(raw.y), bfhi(raw.y), bflo(raw.z), bfhi(raw.z), bflo(raw.w), bfhi(raw.w)};
        float res[8];
#pragma unroll
        for (int e = 0; e < 8; ++e) { const float oth = __shfl_xor(own[e], 32); f32x2 c = cs[e];
#ifdef DBG_NOROPE
            c = (f32x2){1.f, 0.f};
#endif

            res[e] = (fq < 2) ? (own[e] * c.x - oth * c.y) : (own[e] * c.x + oth * c.y); }
        v4u rw; rw.x = pk2(res[0], res[1]); rw.y = pk2(res[2], res[3]); rw.z = pk2(res[4], res[5]); rw.w = pk2(res[6], res[7]);
        qf[2] = __builtin_bit_cast(bf16x8, rw);
    }
    const float scale = SWA ? 0.125f : 0.10206207261596577f;
    float sink2 = 0.f, m = -1e30f, lsum = 0.f;
    if constexpr (SWA) { sink2 = p.sinks[l * 8 + h] * LOG2E; m = sink2; }
    f32x4 o[4];
#pragma unroll
    for (int d = 0; d < 4; ++d) o[d] = (f32x4){0.f, 0.f, 0.f, 0.f};
    const int kt_lo = SWA ? ((q0 - 127 > 0 ? q0 - 127 : 0) >> 5) : 0, kt_hi = (q0 + 15) >> 5;
    const int qi = q0 + fr;
    int pq = 0; if constexpr (SWA) pq = p.pos[qrow];
    const float* bt = (const float*)(p.ws + WS_BT) + h;
    const bf16* Kb; int ldk; const bf16* Vt;
    if constexpr (SWA) { Kb = P + C_KA + (h >> 2) * 64; ldk = PN; Vt = (const bf16*)(p.ws + WS_VTA) + (size_t)((h >> 2) * 64) * T; }
    else { Kb = (const bf16*)(p.ws + WS_KM) + h * 64; ldk = 512; Vt = (const bf16*)(p.ws + WS_VTM) + (size_t)(h * 64) * T; }
    for (int kt = kt_lo; kt <= kt_hi; ++kt) {
        const int k0 = kt * 32;
        f32x4 s0 = (f32x4){0.f, 0.f, 0.f, 0.f}, s1 = (f32x4){0.f, 0.f, 0.f, 0.f};
        const size_t kra = tok0 + k0 + fr, krb = kra + 16;
#pragma unroll
        for (int kk = 0; kk < NKK; ++kk) {
            bf16x8 ka, kb;
            if (SWA || kk < 2) { ka = *(const bf16x8*)(Kb + kra * ldk + kk * 32 + fq * 8); kb = *(const bf16x8*)(Kb + krb * ldk + kk * 32 + fq * 8); }
            else { ka = *(const bf16x8*)(P + kra * PN + C_KPE + fq * 8); kb = *(const bf16x8*)(P + krb * PN + C_KPE + fq * 8); }
            s0 = __builtin_amdgcn_mfma_f32_16x16x32_bf16(ka, qf[kk], s0, 0, 0, 0);
            s1 = __builtin_amdgcn_mfma_f32_16x16x32_bf16(kb, qf[kk], s1, 0, 0, 0);
        }
        float v[8];
        int pka[4] = {0, 0, 0, 0}, pkb[4] = {0, 0, 0, 0};
        if constexpr (SWA) { const int4 t0 = *(const int4*)(p.pos + tok0 + k0 + fq * 4), t1 = *(const int4*)(p.pos + tok0 + k0 + 16 + fq * 4);
            pka[0] = t0.x; pka[1] = t0.y; pka[2] = t0.z; pka[3] = t0.w; pkb[0] = t1.x; pkb[1] = t1.y; pkb[2] = t1.z; pkb[3] = t1.w; }
#pragma unroll
        for (int j = 0; j < 4; ++j) {
            const int keya = k0 + fq * 4 + j, keyb = keya + 16;
            float sa = s0[j] * scale, sb = s1[j] * scale;
            bool oka = keya <= qi, okb = keyb <= qi;
            if constexpr (SWA) {
                int da = pq - pka[j]; da = da < 0 ? 0 : (da > 128 ? 128 : da);
                int db = pq - pkb[j]; db = db < 0 ? 0 : (db > 128 ? 128 : db);
#ifndef DBG_NOBIAS
                sa += bt[da * 8]; sb += bt[db * 8];
#endif
                oka = oka && (qi - keya < 128); okb = okb && (qi - keyb < 128);
            }
            v[j] = oka ? sa * LOG2E : -1e30f; v[4 + j] = okb ? sb * LOG2E : -1e30f;
        }
        float mx = fmaxf(fmaxf(fmaxf(v[0], v[1]), fmaxf(v[2], v[3])), fmaxf(fmaxf(v[4], v[5]), fmaxf(v[6], v[7])));
        mx = fmaxf(mx, __shfl_xor(mx, 16)); mx = fmaxf(mx, __shfl_xor(mx, 32));
        const float mn = fmaxf(m, mx), alpha = __builtin_amdgcn_exp2f(m - mn); m = mn;
        float ps = 0.f;
#pragma unroll
        for (int e = 0; e < 8; ++e) { v[e] = __builtin_amdgcn_exp2f(v[e] - mn); ps += v[e]; }
        lsum = lsum * alpha + ps;
#pragma unroll
        for (int d = 0; d < 4; ++d) o[d] = o[d] * alpha;
        v4u pw; pw.x = pk2(v[0], v[1]); pw.y = pk2(v[2], v[3]); pw.z = pk2(v[4], v[5]); pw.w = pk2(v[6], v[7]);
        const bf16x8 pf = __builtin_bit_cast(bf16x8, pw);
#pragma unroll
        for (int d = 0; d < 4; ++d) {
            const bf16* vp = Vt + (size_t)(d * 16 + fr) * T + tok0 + k0 + fq * 4;
            const v2u lo = *(const v2u*)vp, hi = *(const v2u*)(vp + 16);
            const v4u vw = (v4u){lo.x, lo.y, hi.x, hi.y};
            o[d] = __builtin_amdgcn_mfma_f32_16x16x32_bf16(__builtin_bit_cast(bf16x8, vw), pf, o[d], 0, 0, 0);
        }
    }
    lsum += __shfl_xor(lsum, 16); lsum += __shfl_xor(lsum, 32);
    if constexpr (SWA) lsum += __builtin_amdgcn_exp2f(sink2 - m);
    const float inv = 1.0f / lsum;
    bf16* Y = (bf16*)(p.ws + WS_Y) + (SWA ? (size_t)0 : (size_t)2 * T * 512) + qrow * 512 + h * 64 + fq * 4;
#pragma unroll
    for (int d = 0; d < 4; ++d) { v2u w; w.x = pk2(o[d][0] * inv, o[d][1] * inv); w.y = pk2(o[d][2] * inv, o[d][3] * inv); *(v2u*)(Y + d * 16) = w; }
}

__device__ __forceinline__ void conv_unit(const Ctx& C0, const Params& p, int l, int unit) {
    const Ctx C = relaunder(C0);
    LAS float* U = (LAS float*)C.lds;
    const int c = C.tid, t0 = unit * 32, s0 = t0 & (SEQ - 1);
    const bf16* P = (const bf16*)(p.ws + WS_P);
    { const int cg8 = (c & 63) * 8, rsub = c >> 6;
#pragma unroll
      for (int pass = 0; pass < 8; ++pass) {
        const int r = pass * 8 + rsub;
        if (r < 62) {
            const int s = s0 - 30 + r; f32x4 u0 = (f32x4){0.f, 0.f, 0.f, 0.f}, u1 = u0;
            if (s >= 0) { const bf16* row = P + (size_t)(t0 - 30 + r) * PN + C_UB + cg8; const v4u a = *(const v4u*)row, g = *(const v4u*)(row + 512);
                u0[0] = bflo(a.x) * sigmoidf_(bflo(g.x)); u0[1] = bfhi(a.x) * sigmoidf_(bfhi(g.x)); u0[2] = bflo(a.y) * sigmoidf_(bflo(g.y)); u0[3] = bfhi(a.y) * sigmoidf_(bfhi(g.y));
                u1[0] = bflo(a.z) * sigmoidf_(bflo(g.z)); u1[1] = bfhi(a.z) * sigmoidf_(bfhi(g.z)); u1[2] = bflo(a.w) * sigmoidf_(bflo(g.w)); u1[3] = bfhi(a.w) * sigmoidf_(bfhi(g.w)); }
            *(LAS f32x4*)(U + r * 512 + cg8) = u0; *(LAS f32x4*)(U + r * 512 + cg8 + 4) = u1;
        }
      }
    }
    __syncthreads();
    float w[31];
#pragma unroll
    for (int j = 0; j < 31; ++j) w[j] = p.w_dw[(size_t)l * 31 * 512 + j * 512 + c];
    const float bias = p.b_dw[l * 512 + c];
    for (int tb = 0; tb < 32; tb += 8) {
        float acc[8];
#pragma unroll
        for (int k = 0; k < 8; ++k) acc[k] = bias;
#pragma unroll
        for (int jj = 0; jj < 38; ++jj) {
            const float u = U[(tb + jj) * 512 + c];
#pragma unroll
            for (int k = 0; k < 8; ++k) { const int j = jj - k; if (j >= 0 && j < 31) acc[k] += w[j] * u; }
        }
#pragma unroll
        for (int k = 0; k < 8; ++k) U[(tb + k) * 512 + c] = acc[k];
    }
    __syncthreads();
    const float* gl = p.g_cln + l * 512; const float* bl = p.b_cln + l * 512;
    bf16* Y = (bf16*)(p.ws + WS_Y) + (size_t)1 * T * 512;
    for (int q = 0; q < 4; ++q) {
        const int tl = C.wave * 4 + q; float xv[8]; float s = 0.f;
#pragma unroll
        for (int i = 0; i < 8; ++i) { xv[i] = U[tl * 512 + C.lane + 64 * i]; s += xv[i]; }
        const float mean = wave_sum(s) * (1.f / 512.f); float s2 = 0.f;
#pragma unroll
        for (int i = 0; i < 8; ++i) { xv[i] -= mean; s2 += xv[i] * xv[i]; }
        const float rstd = 1.0f / sqrtf(wave_sum(s2) * (1.f / 512.f) + EPS);
#pragma unroll
        for (int i = 0; i < 8; ++i) { const int ch = C.lane + 64 * i; const float y = xv[i] * rstd * gl[ch] + bl[ch]; Y[(size_t)(t0 + tl) * 512 + ch] = (bf16)f2bf(y * sigmoidf_(y)); }
    }
    __syncthreads();
}

constexpr int AK_ROW = 208, AV_ROW = 144, AK_BYTES = 64 * AK_ROW, AV_BYTES = 64 * AV_ROW, ABUF = AK_BYTES + AV_BYTES;
__device__ __forceinline__ void mla_unit(const Ctx& C, const Params& p, int unit) {
    int tid_ = C.tid; asm volatile("" : "+v"(tid_));
    const int tid = tid_, lane = tid & 63, fr = lane & 15, fq = lane >> 4;
    int b, h, qb;
    { const int k = unit >> 8, i = unit & 255, g = i >> 6, bh = i & 63; qb = 15 - 4 * k - ((k & 1) ? (3 - g) : g); b = bh >> 3; h = bh & 7; }
    const int q0w = qb * 256 + C.wave * 32;
    const size_t tok0 = (size_t)b * SEQ;
    const bf16* P = (const bf16*)(p.ws + WS_P); const bf16* QM = (const bf16*)(p.ws + WS_QM); const bf16* KM = (const bf16*)(p.ws + WS_KM); const bf16* VTM = (const bf16*)(p.ws + WS_VTM);
    bf16x8 qf[2][3];
#pragma unroll
    for (int g = 0; g < 2; ++g) {
        const size_t qrow = tok0 + q0w + 16 * g + fr;
        const bf16* qp = QM + qrow * 768 + h * 96 + fq * 8;
        qf[g][0] = *(const bf16x8*)qp; qf[g][1] = *(const bf16x8*)(qp + 32);
        const v4u raw = *(const v4u*)(qp + 64);
        const f32x2* cs = (const f32x2*)(p.ws + WS_ROPE) + qrow * 16 + (fq & 1) * 8;
        const float own[8] = {bflo(raw.x), bfhi(raw.x), bflo(raw.y), bfhi(raw.y), bflo(raw.z), bfhi(raw.z), bflo(raw.w), bfhi(raw.w)};
        float res[8];
#pragma unroll
        for (int e = 0; e < 8; ++e) { const float oth = __shfl_xor(own[e], 32); const f32x2 c = cs[e]; res[e] = (fq < 2) ? (own[e] * c.x - oth * c.y) : (own[e] * c.x + oth * c.y); }
        v4u rw; rw.x = pkhw(res[0], res[1]); rw.y = pkhw(res[2], res[3]); rw.z = pkhw(res[4], res[5]); rw.w = pkhw(res[6], res[7]);
        qf[g][2] = __builtin_bit_cast(bf16x8, rw);
    }
    float m[2] = {-1e30f, -1e30f}, lsum[2] = {0.f, 0.f};
    f32x4 o[2][4];
#pragma unroll
    for (int g = 0; g < 2; ++g)
#pragma unroll
        for (int d = 0; d < 4; ++d) o[g][d] = (f32x4){0.f, 0.f, 0.f, 0.f};
    const int nt = 4 * (qb + 1), my_last = (q0w + 31) >> 6;
    const int kc0 = tid, kc1 = tid + 512;
    const int key0 = kc0 / 12, part0 = kc0 % 12, key1 = kc1 / 12, part1 = kc1 % 12; const bool has1 = kc1 < 768;
    const bf16* ksrc0 = (part0 < 8) ? (KM + (tok0 + key0) * 512 + h * 64 + part0 * 8) : (P + (tok0 + key0) * PN + C_KPE + (part0 - 8) * 8);
    const bf16* ksrc1 = (part1 < 8) ? (KM + (tok0 + key1) * 512 + h * 64 + part1 * 8) : (P + (tok0 + key1) * PN + C_KPE + (part1 - 8) * 8);
    const size_t kstep0 = (part0 < 8) ? (size_t)64 * 512 : (size_t)64 * PN, kstep1 = (part1 < 8) ? (size_t)64 * 512 : (size_t)64 * PN;
    const int kdst0 = key0 * AK_ROW + part0 * 16, kdst1 = key1 * AK_ROW + part1 * 16;
    const bf16* vsrc = VTM + (size_t)(h * 64 + (tid >> 3)) * T + tok0 + (tid & 7) * 8;
    const int vdst = AK_BYTES + (tid >> 3) * AV_ROW + (tid & 7) * 16;
    LAS unsigned char* lds = C.lds;
    v4u r0[2], r1[2], r2[2];
#pragma unroll
    for (int sb = 0; sb < 2; ++sb) { r1[sb] = (v4u){0u, 0u, 0u, 0u}; r0[sb] = *(const v4u*)(ksrc0 + (size_t)sb * kstep0); if (has1) r1[sb] = *(const v4u*)(ksrc1 + (size_t)sb * kstep1); r2[sb] = *(const v4u*)(vsrc + (size_t)sb * 64); }
#pragma unroll
    for (int sb = 0; sb < 2; ++sb) { LAS unsigned char* nb = lds + sb * ABUF; *(LAS v4u*)(nb + kdst0) = r0[sb]; if (has1) *(LAS v4u*)(nb + kdst1) = r1[sb]; *(LAS v4u*)(nb + vdst) = r2[sb]; }
    __syncthreads();
    const float c2 = 0.10206207261596577f * LOG2E;
    for (int kp = 0; kp < nt / 2; ++kp) {
        const bool more = 2 * kp + 2 < nt;
        if (more) {
#pragma unroll
            for (int sb = 0; sb < 2; ++sb) { const int tn = 2 * kp + 2 + sb; r0[sb] = *(const v4u*)(ksrc0 + (size_t)tn * kstep0); if (has1) r1[sb] = *(const v4u*)(ksrc1 + (size_t)tn * kstep1); r2[sb] = *(const v4u*)(vsrc + (size_t)tn * 64); } }
#pragma unroll 1
        for (int sub = 0; sub < 2; ++sub) {
        const int kt = 2 * kp + sub;
        if (kt <= my_last) {
            const LAS unsigned char* Kb = lds + ((kp & 1) * 2 + sub) * ABUF; const LAS unsigned char* Vb = Kb + AK_BYTES;
            const int k0 = kt * 64;
            f32x4 s[2][4];
#pragma unroll
            for (int g = 0; g < 2; ++g)
#pragma unroll
                for (int blk = 0; blk < 4; ++blk) s[g][blk] = (f32x4){0.f, 0.f, 0.f, 0.f};
#pragma unroll
            for (int kk = 0; kk < 3; ++kk)
#pragma unroll
                for (int blk = 0; blk < 4; ++blk) {
                    const bf16x8 kf = *(const LAS bf16x8*)(Kb + (blk * 16 + fr) * AK_ROW + (kk * 32 + fq * 8) * 2);
#pragma unroll
                    for (int g = 0; g < 2; ++g) s[g][blk] = __builtin_amdgcn_mfma_f32_16x16x32_bf16(kf, qf[g][kk], s[g][blk], 0, 0, 0);
                }
            const bool need_mask = (k0 + 63 > q0w);
            bf16x8 pf[2][2];
#pragma unroll
            for (int g = 0; g < 2; ++g) {
                const int qi = q0w + 16 * g + fr;
                if (need_mask) {
                    asm volatile("" ::: "memory");
#pragma unroll
                    for (int blk = 0; blk < 4; ++blk)
#pragma unroll
                        for (int j = 0; j < 4; ++j) { const int key = k0 + blk * 16 + fq * 4 + j; if (key > qi) s[g][blk][j] = -1e30f; }
                    asm volatile("" ::: "memory");
                }
                float mx = fmaxf(s[g][0][0], s[g][0][1]);
                mx = fmaxf(fmaxf(mx, s[g][0][2]), s[g][0][3]);
#pragma unroll
                for (int blk = 1; blk < 4; ++blk) { mx = fmaxf(fmaxf(mx, s[g][blk][0]), s[g][blk][1]); mx = fmaxf(fmaxf(mx, s[g][blk][2]), s[g][blk][3]); }
                mx = rowmax4(mx);
                const float mn = fmaxf(m[g], mx * c2), alpha = __builtin_amdgcn_exp2f(m[g] - mn); m[g] = mn;
                f32x2 ps2 = (f32x2){0.f, 0.f};
                const f32x2 c2v = (f32x2){c2, c2}, mnv = (f32x2){mn, mn};
#pragma unroll
                for (int blk = 0; blk < 4; ++blk)
#pragma unroll
                    for (int jp = 0; jp < 2; ++jp) { f32x2 x = (f32x2){s[g][blk][2 * jp], s[g][blk][2 * jp + 1]}; x = x * c2v - mnv;
                        f32x2 pv; pv.x = __builtin_amdgcn_exp2f(x.x); pv.y = __builtin_amdgcn_exp2f(x.y); ps2 = ps2 + pv; s[g][blk][2 * jp] = pv.x; s[g][blk][2 * jp + 1] = pv.y; }
                const float ps = ps2.x + ps2.y;
                lsum[g] = lsum[g] * alpha + ps;
                if (__builtin_amdgcn_ballot_w64(alpha != 1.0f) != 0ull) {
#pragma unroll
                    for (int d = 0; d < 4; ++d) o[g][d] = o[g][d] * alpha;
                }
#pragma unroll
                for (int hf = 0; hf < 2; ++hf) { v4u pw; pw.x = pkhw(s[g][2 * hf][0], s[g][2 * hf][1]); pw.y = pkhw(s[g][2 * hf][2], s[g][2 * hf][3]); pw.z = pkhw(s[g][2 * hf + 1][0], s[g][2 * hf + 1][1]); pw.w = pkhw(s[g][2 * hf + 1][2], s[g][2 * hf + 1][3]);
                    pf[g][hf] = __builtin_bit_cast(bf16x8, pw); }
            }
#pragma unroll
            for (int hf = 0; hf < 2; ++hf)
#pragma unroll
                for (int d = 0; d < 4; ++d) {
                    const LAS unsigned char* vp = Vb + (d * 16 + fr) * AV_ROW + (hf * 32 + fq * 4) * 2;
                    const v2u lo = *(const LAS v2u*)vp, hi = *(const LAS v2u*)(vp + 32);
                    const v4u vw = (v4u){lo.x, lo.y, hi.x, hi.y}; const bf16x8 vf = __builtin_bit_cast(bf16x8, vw);
#pragma unroll
                    for (int g = 0; g < 2; ++g) o[g][d] = __builtin_amdgcn_mfma_f32_16x16x32_bf16(vf, pf[g][hf], o[g][d], 0, 0, 0);
                }
        }
        }
        if (more) {
#pragma unroll
            for (int sb = 0; sb < 2; ++sb) { LAS unsigned char* nb = lds + (((kp + 1) & 1) * 2 + sb) * ABUF; *(LAS v4u*)(nb + kdst0) = r0[sb]; if (has1) *(LAS v4u*)(nb + kdst1) = r1[sb]; *(LAS v4u*)(nb + vdst) = r2[sb]; } }
        __syncthreads();
    }
    bf16* Y = (bf16*)(p.ws + WS_Y) + (size_t)2 * T * 512;
#pragma unroll
    for (int g = 0; g < 2; ++g) {
        float lt = lsum[g]; lt += __shfl_xor(lt, 16); lt += __shfl_xor(lt, 32);
        const float inv = 1.0f / lt;
        bf16* yp = Y + (tok0 + q0w + 16 * g + fr) * 512 + h * 64 + fq * 4;
#pragma unroll
        for (int d = 0; d < 4; ++d) { v2u w; w.x = pkhw(o[g][d][0] * inv, o[g][d][1] * inv); w.y = pkhw(o[g][d][2] * inv, o[g][d][3] * inv); *(v2u*)(yp + d * 16) = w; }
    }
}

__device__ __forceinline__ void swa_unit(const Ctx& C, const Params& p, int l, int unit) {
    int tid_ = threadIdx.x; asm volatile("" : "+v"(tid_));
    const int tid = tid_, lane = tid & 63, fr = lane & 15, fq = lane >> 4, wave_ = __builtin_amdgcn_readfirstlane(tid >> 6);
    const int b = unit >> 5, kvh = (unit >> 4) & 1, qb = unit & 15;
    const int q0w = qb * 256 + wave_ * 32;
    const size_t tok0 = (size_t)b * SEQ;
    const bf16* P = (const bf16*)(p.ws + WS_P); const bf16* VTA = (const bf16*)(p.ws + WS_VTA);
    LAS unsigned char* lds = C.lds;
    constexpr int SROW = 144, STILE = 2 * 64 * SROW;
    LAS float* btl = (LAS float*)(lds + 6 * STILE);
    const int kt_lo = (4 * qb - 2 > 0) ? 4 * qb - 2 : 0, kt_hi = 4 * qb + 3, ntile = kt_hi - kt_lo + 1;
    const int my_lo = (q0w - 127 > 0 ? q0w - 127 : 0) >> 6, my_hi = (q0w + 31) >> 6;
    {
        const bf16* ksrc = P + (tok0 + (size_t)kt_lo * 64 + (tid >> 3)) * PN + C_KA + kvh * 64 + (tid & 7) * 8;
        const bf16* vsrc = VTA + (size_t)(kvh * 64 + (tid >> 3)) * T + tok0 + (size_t)kt_lo * 64 + (tid & 7) * 8;
        const int dst = (tid >> 3) * SROW + (tid & 7) * 16;
        v4u rk[6], rv[6];
#pragma unroll
        for (int t = 0; t < 6; ++t) if (t < ntile) { rk[t] = *(const v4u*)(ksrc + (size_t)t * 64 * PN); rv[t] = *(const v4u*)(vsrc + (size_t)t * 64); }
        for (int i = tid; i < 4 * 129; i += 512) { const int hh = i / 129, n = i - hh * 129; btl[i] = ((const float*)(p.ws + WS_BT))[n * 8 + kvh * 4 + hh] * LOG2E; }
#pragma unroll
        for (int t = 0; t < 6; ++t) if (t < ntile) { *(LAS v4u*)(lds + t * STILE + dst) = rk[t]; *(LAS v4u*)(lds + t * STILE + 64 * SROW + dst) = rv[t]; }
    }
    __syncthreads();
    const float c2 = 0.125f * LOG2E;
    int pq[2];
#pragma unroll
    for (int g = 0; g < 2; ++g) pq[g] = p.pos[tok0 + q0w + 16 * g + fr];
#pragma unroll 1
    for (int hh = 0; hh < 4; ++hh) {
        const int h = kvh * 4 + hh;
        const LAS float* bth = btl + hh * 129;
        bf16x8 qf[2][2];
#pragma unroll
        for (int g = 0; g < 2; ++g) { const bf16* qp = P + (tok0 + q0w + 16 * g + fr) * PN + C_QA + h * 64 + fq * 8; qf[g][0] = *(const bf16x8*)qp; qf[g][1] = *(const bf16x8*)(qp + 32); }
        const float sink2 = p.sinks[l * 8 + h] * LOG2E;
        float m[2] = {sink2, sink2}, lsum[2] = {0.f, 0.f};
        f32x4 o[2][4];
#pragma unroll
        for (int g = 0; g < 2; ++g)
#pragma unroll
            for (int d = 0; d < 4; ++d) o[g][d] = (f32x4){0.f, 0.f, 0.f, 0.f};
#pragma unroll 1
        for (int kt = my_lo; kt <= my_hi; ++kt) {
            const LAS unsigned char* Kb = lds + (kt - kt_lo) * STILE; const LAS unsigned char* Vb = Kb + 64 * SROW;
            const int k0 = kt * 64;
            f32x4 s[2][4];
#pragma unroll
            for (int blk = 0; blk < 4; ++blk) {
                bf16x8 kf[2];
#pragma unroll
                for (int kk = 0; kk < 2; ++kk) kf[kk] = *(const LAS bf16x8*)(Kb + (blk * 16 + fr) * SROW + (kk * 32 + fq * 8) * 2);
#pragma unroll
                for (int g = 0; g < 2; ++g) { f32x4 a = (f32x4){0.f, 0.f, 0.f, 0.f};
#pragma unroll
                    for (int kk = 0; kk < 2; ++kk) a = __builtin_amdgcn_mfma_f32_16x16x32_bf16(kf[kk], qf[g][kk], a, 0, 0, 0);
                    s[g][blk] = a; }
            }
            bf16x8 pf[2][2];
#pragma unroll
            for (int g = 0; g < 2; ++g) {
                const int qi = q0w + 16 * g + fr;
#pragma unroll
                for (int blk = 0; blk < 4; ++blk) { const int4 t4 = *(const int4*)(p.pos + tok0 + k0 + blk * 16 + fq * 4); const int pkv[4] = {t4.x, t4.y, t4.z, t4.w};
#pragma unroll
                    for (int j = 0; j < 4; ++j) { const int key = k0 + blk * 16 + fq * 4 + j; int dd = pq[g] - pkv[j]; dd = dd < 0 ? 0 : (dd > 128 ? 128 : dd);
                        const float v = s[g][blk][j] * c2 + bth[dd]; const bool ok = (key <= qi) && (qi - key < 128); s[g][blk][j] = ok ? v : -1e30f; } }
                float mx = fmaxf(fmaxf(s[g][0][0], s[g][0][1]), fmaxf(s[g][0][2], s[g][0][3]));
#pragma unroll
                for (int blk = 1; blk < 4; ++blk) mx = fmaxf(mx, fmaxf(fmaxf(s[g][blk][0], s[g][blk][1]), fmaxf(s[g][blk][2], s[g][blk][3])));
                mx = fmaxf(mx, __shfl_xor(mx, 16)); mx = fmaxf(mx, __shfl_xor(mx, 32));
                const float mn = fmaxf(m[g], mx), alpha = __builtin_amdgcn_exp2f(m[g] - mn); m[g] = mn;
                float ps = 0.f;
#pragma unroll
                for (int blk = 0; blk < 4; ++blk)
#pragma unroll
                    for (int j = 0; j < 4; ++j) { const float pv = __builtin_amdgcn_exp2f(s[g][blk][j] - mn); s[g][blk][j] = pv; ps += pv; }
                lsum[g] = lsum[g] * alpha + ps;
#pragma unroll
                for (int d = 0; d < 4; ++d) o[g][d] = o[g][d] * alpha;
#pragma unroll
                for (int hf = 0; hf < 2; ++hf) { v4u pw; pw.x = pkhw(s[g][2 * hf][0], s[g][2 * hf][1]); pw.y = pkhw(s[g][2 * hf][2], s[g][2 * hf][3]); pw.z = pkhw(s[g][2 * hf + 1][0], s[g][2 * hf + 1][1]); pw.w = pkhw(s[g][2 * hf + 1][2], s[g][2 * hf + 1][3]);
                    pf[g][hf] = __builtin_bit_cast(bf16x8, pw); }
            }
#pragma unroll
            for (int hf = 0; hf < 2; ++hf)
#pragma unroll
                for (int d = 0; d < 4; ++d) {
                    const LAS unsigned char* vp = Vb + (d * 16 + fr) * SROW + (hf * 32 + fq * 4) * 2;
                    const v2u lo = *(const LAS v2u*)vp, hi = *(const LAS v2u*)(vp + 32);
                    const v4u vw = (v4u){lo.x, lo.y, hi.x, hi.y}; const bf16x8 vf = __builtin_bit_cast(bf16x8, vw);
#pragma unroll
                    for (int g = 0; g < 2; ++g) o[g][d] = __builtin_amdgcn_mfma_f32_16x16x32_bf16(vf, pf[g][hf], o[g][d], 0, 0, 0);
                }
        }
        bf16* Y = (bf16*)(p.ws + WS_Y);
#pragma unroll
        for (int g = 0; g < 2; ++g) {
            float lt = lsum[g]; lt += __shfl_xor(lt, 16); lt += __shfl_xor(lt, 32);
            lt += __builtin_amdgcn_exp2f(sink2 - m[g]);
            const float inv = 1.0f / lt;
            bf16* yp = Y + (tok0 + q0w + 16 * g + fr) * 512 + h * 64 + fq * 4;
#pragma unroll
            for (int d = 0; d < 4; ++d) { v2u w; w.x = pkhw(o[g][d][0] * inv, o[g][d][1] * inv); w.y = pkhw(o[g][d][2] * inv, o[g][d][3] * inv); *(v2u*)(yp + d * 16) = w; }
        }
    }
    __syncthreads();
}

#ifndef DBG_NAIVE
#define DBG_NAIVE 0
#endif
#if DBG_NAIVE
__device__ __forceinline__ int t5b_n(int rel) { int n = rel < 0 ? 0 : rel; if (n < 16) return n; float nf = (float)n; int lg = 16 + (int)(logf(nf / 16.0f) / 2.0794415416798357f * 16.0f); return lg < 31 ? lg : 31; }
__device__ __forceinline__ void naive_conv(const Ctx& C, const Params& p, int l) {
    LAS float* red = (LAS float*)C.lds; const bf16* P = (const bf16*)(p.ws + WS_P); bf16* Y = (bf16*)(p.ws + WS_Y) + (size_t)T * 512; const int c = C.tid;
    for (int t = C.bid; t < T; t += C.G) {
        const int s = t & (SEQ - 1); float acc = p.b_dw[l * 512 + c];
        for (int j = 0; j < 31; ++j) { const int ss = s - 30 + j; if (ss >= 0) { const bf16* row = P + (size_t)(t - 30 + j) * PN + C_UB; const float a = bf2f(row[c]), g = bf2f(row[512 + c]); acc += p.w_dw[(size_t)l * 31 * 512 + j * 512 + c] * (a / (1.f + expf(-g))); } }
        float sw = wave_sum(acc); if (C.lane == 0) red[C.wave] = sw; __syncthreads();
        float tot = 0.f; for (int w = 0; w < 8; ++w) tot += red[w]; const float mean = tot / 512.f; __syncthreads();
        const float dv = acc - mean; sw = wave_sum(dv * dv); if (C.lane == 0) red[C.wave] = sw; __syncthreads();
        tot = 0.f; for (int w = 0; w < 8; ++w) tot += red[w]; __syncthreads();
        float y = dv / sqrtf(tot / 512.f + EPS) * p.g_cln[l * 512 + c] + p.b_cln[l * 512 + c]; y = y / (1.f + expf(-y));
        Y[(size_t)t * 512 + c] = (bf16)f2bf(y);
    }
}
__device__ __forceinline__ void naive_swa(const Ctx& C, const Params& p, int l) {
    const bf16* P = (const bf16*)(p.ws + WS_P); bf16* Y = (bf16*)(p.ws + WS_Y);
    for (int it = C.bid * 512 + C.tid; it < T * 8; it += C.G * 512) {
        const int t = it >> 3, h = it & 7, s = t & (SEQ - 1), b0 = t - s; const bf16* q = P + (size_t)t * PN + h * 64;
        float qv[64];
#pragma unroll
        for (int d = 0; d < 64; ++d) qv[d] = bf2f(q[d]);
        float acc[64];
#pragma unroll
        for (int d = 0; d < 64; ++d) acc[d] = 0.f;
        const float sink = p.sinks[l * 8 + h]; float m = sink, lsum = 0.f;
        for (int ks = (s - 127 > 0 ? s - 127 : 0); ks <= s; ++ks) { const bf16* kr = P + (size_t)(b0 + ks) * PN + C_KA + (h >> 2) * 64; float sc = 0.f;
#pragma unroll
            for (int d = 0; d < 64; ++d) sc += qv[d] * bf2f(kr[d]);
            sc = sc * 0.125f + p.rel_bias[t5b_n(p.pos[t] - p.pos[b0 + ks]) * 8 + h];
            const float mn = fmaxf(m, sc), al = expf(m - mn), pp = expf(sc - mn); lsum = lsum * al + pp; m = mn; const bf16* vr = P + (size_t)(b0 + ks) * PN + C_VA + (h >> 2) * 64;
#pragma unroll
            for (int d = 0; d < 64; ++d) acc[d] = acc[d] * al + pp * bf2f(vr[d]); }
        lsum += expf(sink - m);
#pragma unroll
        for (int d = 0; d < 64; ++d) Y[(size_t)t * 512 + h * 64 + d] = (bf16)f2bf(acc[d] / lsum);
    }
}
__device__ __forceinline__ void naive_mla(const Ctx& C, const Params& p, int l) {
    const bf16* P = (const bf16*)(p.ws + WS_P); const bf16* QM = (const bf16*)(p.ws + WS_QM); const bf16* KM = (const bf16*)(p.ws + WS_KM); const bf16* VTM = (const bf16*)(p.ws + WS_VTM);
    bf16* Y = (bf16*)(p.ws + WS_Y) + (size_t)2 * T * 512; LAS float* qs = (LAS float*)C.lds + C.wave * 128;
    for (int it = C.bid * 8 + C.wave; it < T * 8; it += C.G * 8) {
        const int t = it >> 3, h = it & 7, s = t & (SEQ - 1), b0 = t - s; const bf16* q = QM + (size_t)t * 768 + h * 96;
        asm volatile("s_waitcnt lgkmcnt(0)" ::: "memory");
        qs[C.lane] = bf2f(q[C.lane]);
        if (C.lane < 16) { const float ang = (float)p.pos[t] * expf(-9.210340371976184f * (float)C.lane / 16.f); const float cc = __cosf(ang), sn = __sinf(ang);
            const float x1 = bf2f(q[64 + C.lane]), x2 = bf2f(q[80 + C.lane]); qs[64 + C.lane] = x1 * cc - x2 * sn; qs[80 + C.lane] = x2 * cc + x1 * sn; }
        asm volatile("s_waitcnt lgkmcnt(0)" ::: "memory");
        float acc[64];
#pragma unroll
        for (int d = 0; d < 64; ++d) acc[d] = 0.f;
        float m = -1e30f, lsum = 0.f;
        for (int ks = C.lane; ks <= s; ks += 64) { const size_t kt = (size_t)(b0 + ks); float sc = 0.f;
            for (int d = 0; d < 64; ++d) sc += qs[d] * bf2f(KM[kt * 512 + h * 64 + d]);
            for (int d = 0; d < 32; ++d) sc += qs[64 + d] * bf2f(P[kt * PN + C_KPE + d]);
            sc *= 0.10206207261596577f;
            const float mn = fmaxf(m, sc), al = expf(m - mn), pp = expf(sc - mn); lsum = lsum * al + pp; m = mn;
#pragma unroll
            for (int d = 0; d < 64; ++d) acc[d] = acc[d] * al + pp * bf2f(VTM[(size_t)(h * 64 + d) * T + kt]); }
        float mg = m;
#pragma unroll
        for (int o = 1; o < 64; o <<= 1) mg = fmaxf(mg, __shfl_xor(mg, o));
        const float f = expf(m - mg); const float lt = wave_sum(lsum * f);
#pragma unroll
        for (int d = 0; d < 64; ++d) { const float v = wave_sum(acc[d] * f); if (C.lane == (d & 63)) Y[(size_t)t * 512 + h * 64 + d] = (bf16)f2bf(v / lt); }
    }
}
#endif

#define XB_TMO      128
#define XB_XCNT(j)  (256  + 64 * (j))
#define XB_XSUB(j)  (1280 + 64 * (j))
#define XB_XGEN(j)  (2304 + 64 * (j))
#define XB_TOP      3328
#define XB_TOPGEN   3392
#define XCD_BAR_WORDS 3456
#define XB_SPIN_CAP (1u << 18)

__device__ __forceinline__ unsigned xb_ld(unsigned* p)              { return __hip_atomic_load(p, __ATOMIC_RELAXED, __HIP_MEMORY_SCOPE_AGENT); }
__device__ __forceinline__ unsigned xb_add(unsigned* p, unsigned v) { return __hip_atomic_fetch_add(p, v, __ATOMIC_RELAXED, __HIP_MEMORY_SCOPE_AGENT); }
__device__ __forceinline__ unsigned xb_xcc_id() { return (unsigned)__builtin_amdgcn_s_getreg((3 << 11) | 20) & 0xFu; }
#define XB_SPIN(cond, bar) do { unsigned _sp = 0; while (cond) { __builtin_amdgcn_s_sleep(1); \
    if ((++_sp & 255u) == 0u) { if (xb_ld(&(bar)[XB_TMO])) break; if (_sp > XB_SPIN_CAP) { atomicAdd(&(bar)[XB_TMO], 1u); break; } } } } while (0)

struct XcdBarrier {
    unsigned* bar; unsigned x;
    volatile LAS unsigned* st;
};

__device__ __forceinline__ XcdBarrier xcd_barrier_post(unsigned* bar, volatile LAS unsigned* st) {
    XcdBarrier b; b.bar = bar; b.x = xb_xcc_id(); b.st = st;
    if (threadIdx.x == 0) (void)xb_add(&bar[XB_XCNT(b.x)], 1u);
    return b;
}
__device__ __forceinline__ void xcd_barrier_complete(unsigned* bar, unsigned x, unsigned& nloc, unsigned& nx) {
    const unsigned G = gridDim.x * gridDim.y * gridDim.z;
    unsigned sum, cnt, mine, sp = 0u;
    for (;;) {
        sum = 0u; cnt = 0u; mine = 0u;
#pragma unroll
        for (unsigned j = 0; j < 16; ++j) { const unsigned c = xb_ld(&bar[XB_XCNT(j)]); sum += c; cnt += (c > 0u) ? 1u : 0u; mine = (j == x) ? c : mine; }
        if (sum == G) break;
        __builtin_amdgcn_s_sleep(1);
        if ((++sp & 255u) == 0u) { if (xb_ld(&bar[XB_TMO])) break; if (sp > XB_SPIN_CAP) { atomicAdd(&bar[XB_TMO], 1u); break; } }
    }
    nloc = mine > 0u ? mine : 1u; nx = cnt > 0u ? cnt : 1u;
}

__device__ __forceinline__ void xcd_barrier(const XcdBarrier& b) {
    asm volatile("s_waitcnt vmcnt(0)" ::: "memory");
    __syncthreads();
    if (threadIdx.x == 0) {
        unsigned* bar = b.bar;
        __builtin_amdgcn_s_waitcnt(0);
        unsigned nloc = b.st[0], nx = b.st[1];
        if (nloc == 0u) { xcd_barrier_complete(bar, b.x, nloc, nx); b.st[0] = nloc; b.st[1] = nx; }
        const unsigned old = xb_add(&bar[XB_XSUB(b.x)], 1u);
        const unsigned gen = old / nloc;
        if (old + 1u == (gen + 1u) * nloc) {
            __builtin_amdgcn_fence(__ATOMIC_RELEASE, "agent");
            asm volatile("s_waitcnt vmcnt(0)" ::: "memory");
            const unsigned og = xb_add(&bar[XB_TOP], 1u);
            const unsigned tg = og / nx;
            if (og + 1u == (tg + 1u) * nx) xb_add(&bar[XB_TOPGEN], 1u);
            else XB_SPIN(xb_ld(&bar[XB_TOPGEN]) == tg, bar);
            __builtin_amdgcn_fence(__ATOMIC_ACQUIRE, "agent");
            xb_add(&bar[XB_XGEN(b.x)], 1u);
            asm volatile("s_waitcnt vmcnt(0)" ::: "memory");
        } else {
            XB_SPIN(xb_ld(&bar[XB_XGEN(b.x)]) == gen, bar);
            __builtin_amdgcn_fence(__ATOMIC_ACQUIRE, "agent");
            asm volatile("s_waitcnt vmcnt(0)" ::: "memory");
        }
    }
    __syncthreads();
}

template <int MODE>
__device__ __forceinline__ void run_gemm(const Ctx& C, const bf16* A, int lda, const bf16* Bt, int ldb, int M, int N, int K, const pg8::Epi<MODE>& E, int crot = 0) {
    pg8::Gemm g{A, Bt, lda, ldb, M, N, K}; pg8::StaticOrder S; S.init(M, N, C.G, (C.bid + crot) % C.G);
    pg8::gemm_phase<pg8::Epi<MODE>, pg8::StaticOrder, true, true>(C.lds, g, S, E);
    __syncthreads();
}

#define GSYNC() do { xcd_barrier(xbar); } while (0)
__global__ void __launch_bounds__(512) mega_fwd(Params p) {
    extern __shared__ __attribute__((aligned(16))) unsigned char lds_raw[];
    cg::grid_group grid = cg::this_grid();
    Ctx C; C.lds = (LAS unsigned char*)lds_raw; C.tid = threadIdx.x; C.lane = C.tid & 63; C.wave = __builtin_amdgcn_readfirstlane(C.tid >> 6); C.G = gridDim.x; C.bid = blockIdx.x;
    unsigned char* ws = p.ws;
    bf16* W = (bf16*)(ws + WS_W); bf16* H = (bf16*)(ws + WS_H); bf16* P = (bf16*)(ws + WS_P); bf16* Y = (bf16*)(ws + WS_Y);
    bf16* QM = (bf16*)(ws + WS_QM); bf16* KM = (bf16*)(ws + WS_KM); bf16* VTM = (bf16*)(ws + WS_VTM); bf16* VTA = (bf16*)(ws + WS_VTA);
    bf16* MG = (bf16*)(ws + WS_MG); bf16* GS = (bf16*)(ws + WS_GS); bf16* HID = (bf16*)(ws + WS_HID);

    volatile LAS unsigned* xst = (volatile LAS unsigned*)(C.lds + RING_BYTES + 64);
    if (threadIdx.x < 2) xst[threadIdx.x] = 0u;
    __syncthreads();
    XcdBarrier xbar = xcd_barrier_post((unsigned*)(p.ws), xst);
    phase_tables(C, p);
    asm volatile("s_waitcnt vmcnt(0) lgkmcnt(0)" ::: "memory"); grid.sync();
    for (int l = 0; l < DEPTH; ++l) {
        { int t_ = threadIdx.x; asm volatile("" : "+v"(t_)); C.tid = t_; C.lane = t_ & 63; C.wave = __builtin_amdgcn_readfirstlane(t_ >> 6); }
        const float* xcur = (l == 0) ? p.x : p.out;
        for (int rep_ = 0; rep_ < DBG_REP_A; ++rep_) {
        phase_convert_weights(C, p, l);
        phase_norm(C, xcur, p.g_mix + l * DM, H);
        }
        GSYNC();
        for (int rep_ = 0; rep_ < DBG_XSYNC; ++rep_) GSYNC();
        for (int rep_ = 0; rep_ < DBG_REP_G; ++rep_) {
        { pg8::Epi<pg8::EPI_BF16> E{P, PN, nullptr, 0, nullptr, nullptr, 1.f}; run_gemm(C, H, DM, W + WO_IN, DM, T, PN, DM, E); }
        { pg8::Epi<pg8::EPI_BF16> E{VTA, T, nullptr, 0, nullptr, nullptr, 1.f}; run_gemm(C, W + WO_IN + (size_t)C_VA * DM, DM, H, DM, 256, T, DM, E, C.G / 2); }
        }
        GSYNC();
        {
            rownorm_rows(C, p, l, C.bid * 8 + C.wave, C.G * 8);
            for (int rep_ = 0; rep_ < DBG_REP_C; ++rep_) {
#if DBG_NAIVE & 1
            naive_swa(C, p, l);
#else
#ifdef SWA_V1
            for (int u = C.bid; u < 2048; u += C.G) attn_unit<true>(C, p, l, u);
#else
            for (int rs_ = 0; rs_ < DBG_REP_S; ++rs_) for (int u = C.bid; u < 256; u += C.G) swa_unit(C, p, l, u);
#endif
#endif
#if DBG_NAIVE & 2
            naive_conv(C, p, l);
#else
            for (int u = C.bid; u < T / 32; u += C.G) conv_unit(C, p, l, u);
#endif
            }
        }
        GSYNC();
        for (int rep_ = 0; rep_ < DBG_REP_G; ++rep_) {
        { pg8::Epi<pg8::EPI_BF16> E{QM, 768, nullptr, 0, nullptr, nullptr, 1.f}; run_gemm(C, P + C_CQ, PN, W + WO_Q, 256, T, 768, 256, E); }
        { pg8::Epi<pg8::EPI_BF16> E{KM, 512, nullptr, 0, nullptr, nullptr, 1.f}; run_gemm(C, P + C_CKV, PN, W + WO_K, 256, T, 512, 256, E); }
        { pg8::Epi<pg8::EPI_BF16> E{VTM, T, nullptr, 0, nullptr, nullptr, 1.f}; run_gemm(C, W + WO_V, 256, P + C_CKV, PN, 512, T, 256, E); }
        }
        GSYNC();
#if DBG_NAIVE & 4
        naive_mla(C, p, l);
#else
#ifdef MLA_V1
        for (int rep = 0; rep < DBG_REP_E; ++rep) for (int u = C.bid; u < 2048; u += C.G) attn_unit<false>(C, p, l, u);
#else
        for (int rep_ = 0; rep_ < DBG_REP_E; ++rep_) for (int u = C.bid; u < 1024; u += C.G) mla_unit(C, p, u);
#endif
#endif
        GSYNC();
#ifndef DBG_REP_E
#define DBG_REP_E 1
#endif
#ifndef DBG_REP_G
#define DBG_REP_G 1
#endif
#ifndef DBG_REP_C
#define DBG_REP_C 1
#endif
#ifndef DBG_SKIP
#define DBG_SKIP 0
#endif
#ifndef DBG_DBL
#define DBG_DBL 0
#endif
        for (int rep_ = 0; rep_ < DBG_REP_G; ++rep_) { int firstn = 1;
        for (int n = 0; n < 3; ++n) {
            if ((DBG_SKIP >> n) & 1) continue;
            { pg8::Epi<pg8::EPI_SIG> E{GS, DM, nullptr, 0, nullptr, nullptr, 1.f}; run_gemm(C, H, DM, W + WO_G + (size_t)n * DM * DM, DM, T, DM, DM, E); }
#ifdef DBG_FSYNC
            GSYNC();
#endif
            { pg8::Epi<pg8::EPI_GATEMUL> E{MG, DM, GS, firstn, nullptr, nullptr, ((DBG_DBL >> n) & 1) ? 2.f : 1.f}; run_gemm(C, Y + (size_t)n * T * 512, 512, W + WO_B + (size_t)n * DM * 512, 512, T, DM, 512, E); }
            firstn = 0;
        } }
        GSYNC();
        { pg8::Epi<pg8::EPI_RES> E{nullptr, DM, nullptr, 0, xcur, p.out, 1.f}; run_gemm(C, MG, DM, W + WO_O, DM, T, DM, DM, E); }
        GSYNC();
        for (int rep_ = 0; rep_ < DBG_REP_A; ++rep_) phase_norm(C, p.out, p.g_mlp + l * DM, H);
        GSYNC();
        for (int rep_ = 0; rep_ < DBG_REP_G; ++rep_)
        { pg8::Epi<pg8::EPI_RELU2> E{HID, DFF, nullptr, 0, nullptr, nullptr, 1.f}; run_gemm(C, H, DM, W + WO_U, DM, T, DFF, DM, E); }
        GSYNC();
        { pg8::Epi<pg8::EPI_RES> E{nullptr, DM, nullptr, 0, p.out, p.out, 1.f}; run_gemm(C, HID, DFF, W + WO_D, DFF, T, DM, DFF, E); }
        GSYNC();
    }
    phase_final_norm(C, p.g_final, p.out);
}

extern "C" void kernel_launch(void* const* d_in, const int* in_sizes, int n_in, void* d_out, int out_size, void* d_ws, size_t ws_size, hipStream_t stream) {
    static int grid = 0;
    if (grid == 0) {
        int dev = 0, cus = 0, per_cu = 0;
        hipGetDevice(&dev);
        hipDeviceGetAttribute(&cus, hipDeviceAttributeMultiprocessorCount, dev);
        hipFuncSetAttribute((const void*)mega_fwd, hipFuncAttributeMaxDynamicSharedMemorySize, LDS_BYTES);
        hipOccupancyMaxActiveBlocksPerMultiprocessor(&per_cu, (const void*)mega_fwd, 512, LDS_BYTES);
        if (per_cu < 1) per_cu = 1;
        grid = cus * per_cu;
        if (ws_size < WS_END) fprintf(stderr, "kernel_launch: workspace too small: %zu < %zu\n", ws_size, (size_t)WS_END);
    }
    Params p{};
    p.x = (const float*)d_in[0]; p.pos = (const int*)d_in[1]; p.rel_bias = (const float*)d_in[2]; p.g_final = (const float*)d_in[3]; p.g_mix = (const float*)d_in[4];
    p.w_in = (const float*)d_in[5]; p.sinks = (const float*)d_in[6]; p.g_qn = (const float*)d_in[7]; p.w_qup = (const float*)d_in[8]; p.g_kvn = (const float*)d_in[9];
    p.w_kvup = (const float*)d_in[10]; p.w_dw = (const float*)d_in[11]; p.b_dw = (const float*)d_in[12]; p.g_cln = (const float*)d_in[13]; p.b_cln = (const float*)d_in[14];
    p.w_branch = (const float*)d_in[15]; p.w_out = (const float*)d_in[16]; p.g_mlp = (const float*)d_in[17]; p.w_up = (const float*)d_in[18]; p.w_down = (const float*)d_in[19];
    p.out = (float*)d_out; p.ws = (unsigned char*)d_ws;
    hipMemsetAsync(d_ws, 0, XCD_BAR_WORDS * 4, stream);
    void* args[] = {&p};
    hipError_t e = hipLaunchCooperativeKernel((const void*)mega_fwd, dim3(grid), dim3(512), args, LDS_BYTES, stream);
    if (e != hipSuccess) fprintf(stderr, "cooperative launch failed: %s (grid %d)\n", hipGetErrorString(e), grid);
}
```

```cpp
#include <hip/hip_runtime.h>
#include <hip/hip_cooperative_groups.h>
#include <cstdio>
#include <cstdint>
namespace cg = cooperative_groups;

#ifndef DBG_REP_E
#define DBG_REP_E 1
#endif
#ifndef DBG_REP_G
#define DBG_REP_G 1
#endif
#ifndef DBG_REP_C
#define DBG_REP_C 1
#endif
#ifndef DBG_REP_A
#define DBG_REP_A 1
#endif
#ifndef DBG_XSYNC
#define DBG_XSYNC 0
#endif
#ifndef DBG_REP_S
#define DBG_REP_S 1
#endif
namespace pg8 {
#define PG8_LAS __attribute__((address_space(3)))
typedef unsigned short bf16_t;
typedef short bf16x8 __attribute__((ext_vector_type(8)));
typedef float f32x4 __attribute__((ext_vector_type(4)));
typedef unsigned u32x4 __attribute__((ext_vector_type(4)));
constexpr int BM = 256, BK = 64, HALF = 128, HTB = HALF * BK * 2  , STAGE_BYTES = 8 * HTB, NXCD = 8, WGM = 8;

__host__ __device__ __forceinline__ int lds_byte(int r, int c) { const int st = (r >> 4) * 2 + (c >> 5), rr = r & 15, cc = c & 31, ob = rr * 64 + cc * 2; return st * 1024 + (ob ^ (((ob >> 9) & 1) << 5)); }
__host__ __device__ __forceinline__ void stage_rc(int b, int& R, int& C) { const int st = b / 1024, sb = b % 1024, swz = sb ^ (((sb >> 9) & 1) << 5); R = (st >> 1) * 16 + swz / 64; C = (st & 1) * 32 + (swz % 64) / 2; }
__host__ __device__ __forceinline__ int perm32(int rho) { const int n = rho >> 4, i = rho & 15; return 8 * (i >> 2) + 4 * n + (i & 3); }

struct Unit { int pm, pn; };
struct Gemm { const bf16_t* A; const bf16_t* Bt; int lda, ldb, M, N, K; };

struct StaticOrder {
    int nM, nN, nwg, G, c;
    __host__ __device__ void init(int M, int N, int G_, int c_) { nM = M / BM; nN = N / BM; nwg = nM * nN; G = G_; c = c_; }
    __host__ __device__ bool next(int i, Unit& u) const {
        const long L = (long)i * G + c; if (L >= nwg) return false;
        int wgid = (int)L; { const int q = nwg / NXCD, r = nwg % NXCD, xcd = wgid % NXCD, off = wgid / NXCD; wgid = (xcd < r ? xcd * (q + 1) : r * (q + 1) + (xcd - r) * q) + off; }
        const int nig = WGM * nN, gid = wgid / nig, fm = gid * WGM, gsz = (nM - fm) < WGM ? (nM - fm) : WGM;
        u.pm = fm + ((wgid % nig) % gsz); u.pn = (wgid % nig) / gsz; return true;
    }
    __device__ __forceinline__ void a_ready(const Unit&) const {}
    __device__ __forceinline__ void done(const Unit&) const {}
};

__device__ __forceinline__ unsigned cvt_pk_bf16(float lo, float hi) { unsigned r; asm volatile("v_cvt_pk_bf16_f32 %0, %1, %2" : "=v"(r) : "v"(lo), "v"(hi)); return r; }

template <class Epi, class Sched, bool ALIGN_EPI = false, bool SP2 = false>
__device__ __forceinline__ void gemm_phase(PG8_LAS unsigned char* lds, const Gemm g, const Sched& S, const Epi& E) {
    int tid_ = threadIdx.x; asm volatile("" : "+v"(tid_));
    const int tid = tid_, wid = __builtin_amdgcn_readfirstlane(tid >> 6), lane = tid & 63, wr = wid >> 2, wc = wid & 3, fr = lane & 15, fq = lane >> 4;
    const int K = g.K, nt = K / BK;
    unsigned voffA[2], voffB[2];
#pragma unroll
    for (int i = 0; i < 2; ++i) { int R, C; stage_rc(tid * 16 + i * 8192, R, C); const int Rb = Epi::PERM ? ((R & ~31) + perm32(R & 31)) : R;
        voffA[i] = (unsigned)(R * g.lda + C) * 2u; voffB[i] = (unsigned)(Rb * g.ldb + C) * 2u; }
    const size_t kstep = (size_t)(BK * 2);
    const size_t hstepA = (size_t)HALF * g.lda * 2, hstepB = (size_t)HALF * g.ldb * 2;
    const size_t tstepA = 2 * hstepA, tstepB = 2 * hstepB;
    const unsigned ldsw = (unsigned)wid * 1024u;
    const int aoff = lds_byte(wr * 64 + fr, fq * 8), boff = lds_byte(wc * 32 + fr, fq * 8);
#define PG8_SA(b, h) (((b) * 2 + (h)) * HTB)
#define PG8_SB(b, h) ((4 + (b) * 2 + (h)) * HTB)
#define PG8_STAGE(bufoff, gbase, voff) do { _Pragma("unroll") for (int _i = 0; _i < 2; ++_i) \
        __builtin_amdgcn_global_load_lds((const unsigned*)((const char*)(gbase) + (voff)[_i]), (PG8_LAS unsigned*)(lds + (bufoff) + ldsw + _i * 8192), 16, 0, 0); } while (0)
#define PG8_LDA(dst, b, h) do { _Pragma("unroll") for (int m = 0; m < 4; ++m) _Pragma("unroll") for (int k = 0; k < 2; ++k) dst[m][k] = *(const PG8_LAS bf16x8*)(lds + PG8_SA(b, h) + aoff + m * 2048 + k * 1024); } while (0)
#define PG8_LDB(dst, b, h) do { _Pragma("unroll") for (int n = 0; n < 2; ++n) _Pragma("unroll") for (int k = 0; k < 2; ++k) dst[n][k] = *(const PG8_LAS bf16x8*)(lds + PG8_SB(b, h) + boff + n * 2048 + k * 1024); } while (0)
#define PG8_MMA(ai, bj, At, Bt) do { __builtin_amdgcn_s_setprio(1); _Pragma("unroll") for (int m = 0; m < 4; ++m) _Pragma("unroll") for (int n = 0; n < 2; ++n) _Pragma("unroll") for (int k = 0; k < 2; ++k) \
        acc[ai][bj][m][n] = __builtin_amdgcn_mfma_f32_16x16x32_bf16(Bt[n][k], At[m][k], acc[ai][bj][m][n], 0, 0, 0); __builtin_amdgcn_s_setprio(0); } while (0)
#define PG8_WAIT_V(n) asm volatile("s_waitcnt vmcnt(" #n ")" ::: "memory")
#define PG8_WAIT_L(n) asm volatile("s_waitcnt lgkmcnt(" #n ")" ::: "memory")
#define PG8_BAR __builtin_amdgcn_s_barrier()
#define PG8_SCHED __builtin_amdgcn_sched_barrier(0)
    Unit cur, nxt; int ui = 0;
    if (!S.next(0, cur)) return;
    f32x4 acc[2][2][4][2];
#pragma unroll
    for (int a = 0; a < 2; ++a)
#pragma unroll
        for (int b = 0; b < 2; ++b)
#pragma unroll
            for (int m = 0; m < 4; ++m)
#pragma unroll
                for (int n = 0; n < 2; ++n) acc[a][b][m][n] = (f32x4){0.f, 0.f, 0.f, 0.f};
    bf16x8 At[4][2], B0[2][2], B1[2][2];
    const char* cA = (const char*)g.A + (size_t)cur.pm * tstepA; const char* cB = (const char*)g.Bt + (size_t)cur.pn * tstepB;
    S.a_ready(cur);
    if constexpr (SP2) {
        PG8_STAGE(PG8_SB(0, 0), cB, voffB); PG8_STAGE(PG8_SB(0, 1), cB + hstepB, voffB); PG8_STAGE(PG8_SA(0, 0), cA, voffA); PG8_STAGE(PG8_SA(0, 1), cA + hstepA, voffA);
        if (wr == 1) PG8_BAR;
        PG8_WAIT_V(2); PG8_BAR;
        PG8_STAGE(PG8_SB(1, 0), cB + kstep, voffB); PG8_STAGE(PG8_SA(1, 0), cA + kstep, voffA); PG8_STAGE(PG8_SB(1, 1), cB + hstepB + kstep, voffB);
        PG8_WAIT_V(6); PG8_BAR;
    } else {
        PG8_STAGE(PG8_SB(0, 0), cB, voffB); PG8_STAGE(PG8_SA(0, 0), cA, voffA); PG8_STAGE(PG8_SB(0, 1), cB + hstepB, voffB); PG8_STAGE(PG8_SA(0, 1), cA + hstepA, voffA);
        if (wr == 1) PG8_BAR;
        PG8_WAIT_V(4); PG8_BAR;
        PG8_STAGE(PG8_SB(1, 0), cB + kstep, voffB); PG8_STAGE(PG8_SA(1, 0), cA + kstep, voffA); PG8_STAGE(PG8_SB(1, 1), cB + hstepB + kstep, voffB);
        PG8_WAIT_V(6); PG8_BAR;
    }
    for (;;) {
        const bool has_next = S.next(ui + 1, nxt);
        const char* nA = has_next ? (const char*)g.A + (size_t)nxt.pm * tstepA : cA; const char* nB = has_next ? (const char*)g.Bt + (size_t)nxt.pn * tstepB : cB;
        for (int t = 0; t < nt; t += 2) {
            const bool last = (t == nt - 2);
            const char* a1 = cA + (size_t)(t + 1) * kstep;
            const char* a2 = last ? nA : cA + (size_t)(t + 2) * kstep; const char* b2 = last ? nB : cB + (size_t)(t + 2) * kstep;
            const char* a3 = a2 + kstep; const char* b3 = b2 + kstep;
            if (last && has_next) S.a_ready(nxt);
            if constexpr (SP2) {
            PG8_LDB(B0, 0, 0); PG8_LDB(B1, 0, 1); PG8_SCHED; PG8_LDA(At, 0, 0); PG8_STAGE(PG8_SA(1, 1), a1 + hstepA, voffA);
            PG8_WAIT_V(8); PG8_WAIT_L(0); PG8_BAR; PG8_MMA(0, 0, At, B0); PG8_MMA(0, 1, At, B1); PG8_BAR; PG8_SCHED;
            PG8_LDA(At, 0, 1); PG8_STAGE(PG8_SB(0, 0), b2, voffB); PG8_STAGE(PG8_SB(0, 1), b2 + hstepB, voffB); PG8_STAGE(PG8_SA(0, 0), a2, voffA);
            PG8_WAIT_V(8); PG8_WAIT_L(0); PG8_BAR; PG8_MMA(1, 0, At, B0); PG8_MMA(1, 1, At, B1); PG8_BAR; PG8_SCHED;
            PG8_LDB(B0, 1, 0); PG8_LDB(B1, 1, 1); PG8_SCHED; PG8_LDA(At, 1, 0); PG8_STAGE(PG8_SA(0, 1), a2 + hstepA, voffA);
            PG8_WAIT_V(8); PG8_WAIT_L(0); PG8_BAR; PG8_MMA(0, 0, At, B0); PG8_MMA(0, 1, At, B1); PG8_BAR; PG8_SCHED;
            PG8_LDA(At, 1, 1); PG8_STAGE(PG8_SB(1, 0), b3, voffB); PG8_STAGE(PG8_SB(1, 1), b3 + hstepB, voffB); PG8_STAGE(PG8_SA(1, 0), a3, voffA);
            PG8_WAIT_V(8); PG8_WAIT_L(0); PG8_BAR; PG8_MMA(1, 0, At, B0); PG8_MMA(1, 1, At, B1); PG8_BAR; PG8_SCHED;
            } else {
            PG8_LDB(B0, 0, 0); PG8_SCHED; PG8_LDA(At, 0, 0); PG8_STAGE(PG8_SA(1, 1), a1 + hstepA, voffA);
            PG8_WAIT_L(8); PG8_BAR; PG8_WAIT_L(0); PG8_MMA(0, 0, At, B0); PG8_BAR; PG8_SCHED;
            PG8_LDB(B1, 0, 1); PG8_STAGE(PG8_SB(0, 0), b2, voffB);
            PG8_BAR; PG8_WAIT_L(0); PG8_MMA(0, 1, At, B1); PG8_BAR;
            PG8_LDA(At, 0, 1); PG8_STAGE(PG8_SA(0, 0), a2, voffA);
            PG8_BAR; PG8_WAIT_L(0); PG8_MMA(1, 0, At, B0); PG8_BAR; PG8_SCHED;
            PG8_STAGE(PG8_SB(0, 1), b2 + hstepB, voffB);
            PG8_WAIT_V(6); PG8_BAR; PG8_MMA(1, 1, At, B1); PG8_BAR;
            PG8_LDB(B0, 1, 0); PG8_SCHED; PG8_LDA(At, 1, 0); PG8_STAGE(PG8_SA(0, 1), a2 + hstepA, voffA);
            PG8_WAIT_L(8); PG8_BAR; PG8_WAIT_L(0); PG8_MMA(0, 0, At, B0); PG8_BAR; PG8_SCHED;
            PG8_LDB(B1, 1, 1); PG8_STAGE(PG8_SB(1, 0), b3, voffB);
            PG8_BAR; PG8_WAIT_L(0); PG8_MMA(0, 1, At, B1); PG8_BAR;
            PG8_LDA(At, 1, 1); PG8_STAGE(PG8_SA(1, 0), a3, voffA);
            PG8_BAR; PG8_WAIT_L(0); PG8_MMA(1, 0, At, B0); PG8_BAR; PG8_SCHED;
            PG8_STAGE(PG8_SB(1, 1), b3 + hstepB, voffB);
            PG8_WAIT_V(6); PG8_BAR; PG8_MMA(1, 1, At, B1); PG8_BAR;
            }
        }
        if constexpr (ALIGN_EPI) { if (wr == 0) PG8_BAR; }
        if constexpr (!Epi::AFTER_DRAIN) { E(acc, cur, wr, wc, fr, fq); S.done(cur); }
        if (!has_next) break;
#pragma unroll
        for (int a = 0; a < 2; ++a)
#pragma unroll
            for (int b = 0; b < 2; ++b)
#pragma unroll
                for (int m = 0; m < 4; ++m)
#pragma unroll
                    for (int n = 0; n < 2; ++n) acc[a][b][m][n] = (f32x4){0.f, 0.f, 0.f, 0.f};
        cur = nxt; cA = nA; cB = nB; ++ui;
        if constexpr (ALIGN_EPI) { if (wr == 1) PG8_BAR; }
    }
    PG8_WAIT_V(0);
    if constexpr (!ALIGN_EPI) { if (wr == 0) PG8_BAR; }
    PG8_BAR;
    if constexpr (Epi::AFTER_DRAIN) { E.fused(acc, cur, wr, wc, fr, fq, lds, wid, lane); S.done(cur); }
#undef PG8_SA
#undef PG8_SB
#undef PG8_STAGE
#undef PG8_LDA
#undef PG8_LDB
#undef PG8_MMA
#undef PG8_WAIT_V
#undef PG8_WAIT_L
#undef PG8_BAR
#undef PG8_SCHED
}
}

constexpr int BATCH = 8, SEQ = 4096, DM = 1024, DEPTH = 4, T = BATCH * SEQ;
constexpr int INC = 5280, PN = 2304, DFF = 4096;
constexpr int C_QA = 0, C_KA = 512, C_VA = 640, C_UB = 768, C_CQ = 1792, C_CKV = 2048, C_KPE = 2176, C_GATE = 2208;
constexpr float EPS = 1e-6f, LOG2E = 1.4426950408889634f;
constexpr size_t MiB = 1u << 20;
constexpr size_t WS_ROPE = 1 * MiB;
constexpr size_t WS_BT = 5 * MiB;
constexpr size_t WS_W = 8 * MiB;
constexpr size_t WS_H = 41 * MiB;
constexpr size_t WS_P = 105 * MiB;
constexpr size_t WS_Y = 249 * MiB;
constexpr size_t WS_QM = 345 * MiB;
constexpr size_t WS_KM = 393 * MiB;
constexpr size_t WS_VTM = 425 * MiB;
constexpr size_t WS_VTA = 457 * MiB;
constexpr size_t WS_END = 473 * MiB;
constexpr size_t WS_MG = WS_QM;
constexpr size_t WS_GS = WS_P;
constexpr size_t WS_HID = WS_P;
constexpr size_t WO_IN = 0;
constexpr size_t WO_G = WO_IN + (size_t)2304 * 1024;
constexpr size_t WO_Q = WO_G + (size_t)3072 * 1024;
constexpr size_t WO_K = WO_Q + (size_t)768 * 256;
constexpr size_t WO_V = WO_K + (size_t)512 * 256;
constexpr size_t WO_B = WO_V + (size_t)512 * 256;
constexpr size_t WO_O = WO_B + (size_t)3 * 1024 * 512;
constexpr size_t WO_U = WO_O + (size_t)1024 * 1024;
constexpr size_t WO_D = WO_U + (size_t)4096 * 1024;
constexpr size_t WO_END = WO_D + (size_t)1024 * 4096;
static_assert(WO_END * 2 <= 33 * MiB, "weights fit");

constexpr int RING_BYTES = 131072, LDS_BYTES = 135168;
#define LAS __attribute__((address_space(3)))
typedef unsigned short bf16;
typedef unsigned v4u __attribute__((ext_vector_type(4)));
typedef unsigned v2u __attribute__((ext_vector_type(2)));
typedef float f32x4 __attribute__((ext_vector_type(4)));
typedef float f32x2 __attribute__((ext_vector_type(2)));
typedef short bf16x8 __attribute__((ext_vector_type(8)));

__device__ __forceinline__ unsigned f2bf(float f) { unsigned u = __builtin_bit_cast(unsigned, f); return (u + 0x7fffu + ((u >> 16) & 1u)) >> 16; }
__device__ __forceinline__ unsigned pk2(float lo, float hi) { return f2bf(lo) | (f2bf(hi) << 16); }
typedef float f32x2q __attribute__((ext_vector_type(2))); typedef __bf16 bf16x2q __attribute__((ext_vector_type(2)));
__device__ __forceinline__ unsigned pkhw(float lo, float hi) { f32x2q v = {lo, hi}; bf16x2q b = __builtin_convertvector(v, bf16x2q); return __builtin_bit_cast(unsigned, b); }
__device__ __forceinline__ float rowmax4(float v) {
    auto r16 = __builtin_amdgcn_permlane16_swap(__float_as_uint(v), __float_as_uint(v), false, false);
    v = fmaxf(__uint_as_float(r16[0]), __uint_as_float(r16[1]));
    auto r32 = __builtin_amdgcn_permlane32_swap(__float_as_uint(v), __float_as_uint(v), false, false);
    return fmaxf(__uint_as_float(r32[0]), __uint_as_float(r32[1]));
}
__device__ __forceinline__ float bf2f(unsigned short h) { return __builtin_bit_cast(float, (unsigned)h << 16); }
__device__ __forceinline__ float bflo(unsigned w) { return __builtin_bit_cast(float, w << 16); }
__device__ __forceinline__ float bfhi(unsigned w) { return __builtin_bit_cast(float, w & 0xffff0000u); }
__device__ __forceinline__ float wave_sum(float v) {
#pragma unroll
    for (int o = 1; o < 64; o <<= 1) v += __shfl_xor(v, o);
    return v;
}
__device__ __forceinline__ float sigmoidf_(float x) { return __builtin_amdgcn_rcpf(1.0f + __builtin_amdgcn_exp2f(-x * LOG2E)); }

struct Params {
    const float* x; const int* pos; const float* rel_bias; const float* g_final; const float* g_mix; const float* w_in; const float* sinks;
    const float* g_qn; const float* w_qup; const float* g_kvn; const float* w_kvup; const float* w_dw; const float* b_dw; const float* g_cln; const float* b_cln;
    const float* w_branch; const float* w_out; const float* g_mlp; const float* w_up; const float* w_down;
    float* out; unsigned char* ws;
};

namespace pg8 {
enum { EPI_BF16 = 0, EPI_SIG = 1, EPI_GATEMUL = 2, EPI_RES = 3, EPI_RELU2 = 4 };
typedef float f32x2p __attribute__((ext_vector_type(2))); typedef __bf16 bf16x2p __attribute__((ext_vector_type(2)));
__device__ __forceinline__ unsigned pkbf(float lo, float hi) { f32x2p v = {lo, hi}; bf16x2p b = __builtin_convertvector(v, bf16x2p); return __builtin_bit_cast(unsigned, b); }
template <int MODE> struct Epi {
    static constexpr bool PERM = true, AFTER_DRAIN = false;
    bf16_t* O; int ldc; const bf16_t* G; int first; const float* base; float* outf; float bscale;
    __device__ __forceinline__ void operator()(const f32x4 (&acc)[2][2][4][2], const Unit& u, int wr, int wc, int fr, int fq) const {
        const int row0 = u.pm * BM + wr * 64 + fr; const int col0 = u.pn * BM + wc * 32 + 8 * fq;
#pragma unroll
        for (int ai = 0; ai < 2; ++ai)
#pragma unroll
            for (int m = 0; m < 4; ++m) {
                const size_t roff = (size_t)(row0 + ai * HALF + m * 16) * (size_t)ldc + col0;
#pragma unroll
                for (int bj = 0; bj < 2; ++bj) {
                    f32x4 v0 = acc[ai][bj][m][0], v1 = acc[ai][bj][m][1];
                    const size_t off = roff + bj * HALF;
                    if constexpr (MODE == EPI_RES) {
                        const f32x4 b0 = *(const f32x4*)(base + off), b1 = *(const f32x4*)(base + off + 4);
                        *(f32x4*)(outf + off) = b0 + v0; *(f32x4*)(outf + off + 4) = b1 + v1;
                    } else {
                        if constexpr (MODE == EPI_SIG) {
#pragma unroll
                            for (int e = 0; e < 4; ++e) { v0[e] = sigmoidf_(v0[e]); v1[e] = sigmoidf_(v1[e]); }
                        }
                        if constexpr (MODE == EPI_RELU2) {
#pragma unroll
                            for (int e = 0; e < 4; ++e) { float a = fmaxf(v0[e], 0.f), b = fmaxf(v1[e], 0.f); v0[e] = a * a; v1[e] = b * b; }
                        }
                        if constexpr (MODE == EPI_GATEMUL) {
                            const u32x4 gw = *(const u32x4*)(G + off); v0 = v0 * bscale; v1 = v1 * bscale;
                            v0[0] *= bflo(gw.x); v0[1] *= bfhi(gw.x); v0[2] *= bflo(gw.y); v0[3] *= bfhi(gw.y);
                            v1[0] *= bflo(gw.z); v1[1] *= bfhi(gw.z); v1[2] *= bflo(gw.w); v1[3] *= bfhi(gw.w);
                            if (!first) {
                                const u32x4 ow = *(const u32x4*)(O + off);
                                v0[0] += bflo(ow.x); v0[1] += bfhi(ow.x); v0[2] += bflo(ow.y); v0[3] += bfhi(ow.y);
                                v1[0] += bflo(ow.z); v1[1] += bfhi(ow.z); v1[2] += bflo(ow.w); v1[3] += bfhi(ow.w);
                            }
                        }
                        u32x4 w; w.x = pkbf(v0[0], v0[1]); w.y = pkbf(v0[2], v0[3]); w.z = pkbf(v1[0], v1[1]); w.w = pkbf(v1[2], v1[3]);
                        *(u32x4*)(O + off) = w;
                    }
                }
            }
    }
};
}

struct Ctx { LAS unsigned char* lds; int tid, lane, wave, G, bid; };

__device__ __forceinline__ Ctx relaunder(const Ctx& C0) {
    Ctx C = C0; int t_ = C0.tid; asm volatile("" : "+v"(t_)); C.tid = t_; C.lane = t_ & 63; C.wave = __builtin_amdgcn_readfirstlane(t_ >> 6); return C;
}

__device__ __forceinline__ void tr_item(const float* W, int ldw, int c0, bf16* WT, int ldk, int r0, int nblk, int item, LAS float* scr, int lane) {
    const int kb = item / nblk, nb = item % nblk, k0 = 64 * kb, n0 = 32 * nb;
#pragma unroll 8
    for (int i = 0; i < 32; ++i) { const int kk = 2 * i + (lane >> 5); scr[kk * 33 + (lane & 31)] = W[(size_t)(k0 + kk) * ldw + c0 + n0 + (lane & 31)]; }
    asm volatile("s_waitcnt lgkmcnt(0)" ::: "memory");
    const int c = lane & 7;
#pragma unroll
    for (int j = 0; j < 4; ++j) { const int n = (lane >> 3) + 8 * j; const LAS float* s = scr + (8 * c) * 33 + n;
        v4u o; o.x = pk2(s[0 * 33], s[1 * 33]); o.y = pk2(s[2 * 33], s[3 * 33]); o.z = pk2(s[4 * 33], s[5 * 33]); o.w = pk2(s[6 * 33], s[7 * 33]);
        *(v4u*)(WT + (size_t)(r0 + n0 + n) * ldk + k0 + 8 * c) = o; }
    asm volatile("s_waitcnt lgkmcnt(0)" ::: "memory");
}

__device__ __forceinline__ void phase_convert_weights(const Ctx& C0, const Params& p, int l) {
    const Ctx C = relaunder(C0);
    LAS float* scr = (LAS float*)(C.lds + C.wave * 16384);
    bf16* W = (bf16*)(p.ws + WS_W);
    const int gw = C.bid * 8 + C.wave, NGW = C.G * 8;
    const float* w_in = p.w_in + (size_t)l * 1024 * INC;
    const float* w_qup = p.w_qup + (size_t)l * 256 * 768;
    const float* w_kvup = p.w_kvup + (size_t)l * 128 * 1024;
    const float* w_br = p.w_branch + (size_t)l * 3 * 512 * 1024;
    const float* w_out = p.w_out + (size_t)l * 1024 * 1024;
    const float* w_up = p.w_up + (size_t)l * 1024 * 4096;
    const float* w_down = p.w_down + (size_t)l * 4096 * 1024;
    constexpr int I_IN = 16 * 69, I_G = 16 * 96, I_Q = 4 * 24, I_KV = 16 * 4, I_B = 3 * 8 * 32, I_O = 16 * 32, I_U = 16 * 128, I_D = 64 * 32;
    constexpr int NITEMS = I_IN + I_G + I_Q + I_KV + I_B + I_O + I_U + I_D;
    for (int it = gw; it < NITEMS; it += NGW) {
        int r = it;
        if (r < I_IN) { tr_item(w_in, INC, 0, W + WO_IN, 1024, 0, 69, r, scr, C.lane); continue; } r -= I_IN;
        if (r < I_G) { tr_item(w_in, INC, C_GATE, W + WO_G, 1024, 0, 96, r, scr, C.lane); continue; } r -= I_G;
        if (r < I_Q) { tr_item(w_qup, 768, 0, W + WO_Q, 256, 0, 24, r, scr, C.lane); continue; } r -= I_Q;
        if (r < I_KV) { const int job = r >> 2, sub = r & 3, h = job >> 1, part = job & 1;
            tr_item(w_kvup, 1024, h * 128 + part * 64, W + (part ? WO_V : WO_K), 256, h * 64, 2, sub, scr, C.lane); continue; } r -= I_KV;
        if (r < I_B) { const int n = r / 256, s = r % 256; tr_item(w_br + (size_t)n * 512 * 1024, 1024, 0, W + WO_B + (size_t)n * 1024 * 512, 512, 0, 32, s, scr, C.lane); continue; } r -= I_B;
        if (r < I_O) { tr_item(w_out, 1024, 0, W + WO_O, 1024, 0, 32, r, scr, C.lane); continue; } r -= I_O;
        if (r < I_U) { tr_item(w_up, 4096, 0, W + WO_U, 1024, 0, 128, r, scr, C.lane); continue; } r -= I_U;
        tr_item(w_down, 1024, 0, W + WO_D, 4096, 0, 32, r, scr, C.lane);
    }
    const int gt = C.bid * 512 + C.tid, NGT = C.G * 512;
    for (int i = gt; i < 96 * 1024 / 8; i += NGT) *(v4u*)(W + WO_IN + (size_t)2208 * 1024 + (size_t)i * 8) = (v4u){0u, 0u, 0u, 0u};
    for (int i = gt; i < 1024 * 16; i += NGT) { const int row = i >> 4, c = i & 15; *(v4u*)(W + WO_K + (size_t)row * 256 + 128 + c * 8) = (v4u){0u, 0u, 0u, 0u}; }
}

__device__ __forceinline__ void phase_tables(const Ctx& C, const Params& p) {
    const int gt = C.bid * 512 + C.tid, NGT = C.G * 512;
    f32x2* cs = (f32x2*)(p.ws + WS_ROPE);
    for (int idx = gt; idx < T * 16; idx += NGT) {
        const int t = idx >> 4, i = idx & 15;
        const float freq = (float)exp(-9.210340371976184 * (double)i / 16.0);
        const float ang = (float)p.pos[t] * freq;
        double r = (double)ang * 0.15915494309189535; r -= rint(r);
        const double xx = r * 6.283185307179586, x2 = xx * xx;
        double s = 1.0 / 51090942171709440000.0, c = 1.0 / 1124000727777607680000.0;
        s = s * x2 - 1.0 / 121645100408832000.0;  c = c * -x2 + 1.0 / 2432902008176640000.0;
        s = s * x2 + 1.0 / 355687428096000.0;
        s = s * x2 - 1.0 / 1307674368000.0;
        s = s * x2 + 1.0 / 6227020800.0;
        s = s * x2 - 1.0 / 39916800.0;
        s = s * x2 + 1.0 / 362880.0;
        s = s * x2 - 1.0 / 5040.0;
        s = s * x2 + 1.0 / 120.0;
        s = s * x2 - 1.0 / 6.0;
        s = s * x2 + 1.0;
        s = s * xx;
        c = c * x2 - 1.0 / 6402373705728000.0;
        c = c * x2 + 1.0 / 20922789888000.0;
        c = c * x2 - 1.0 / 87178291200.0;
        c = c * x2 + 1.0 / 479001600.0;
        c = c * x2 - 1.0 / 3628800.0;
        c = c * x2 + 1.0 / 40320.0;
        c = c * x2 - 1.0 / 720.0;
        c = c * x2 + 1.0 / 24.0;
        c = c * x2 - 0.5;
        c = c * x2 + 1.0;
        cs[idx] = (f32x2){(float)c, (float)s};
    }
    float* bt = (float*)(p.ws + WS_BT);
    for (int idx = gt; idx < 129 * 8; idx += NGT) {
        const int n = idx >> 3, h = idx & 7; int bucket;
        if (n < 16) bucket = n;
        else { const float nf = (float)n; int large = 16 + (int)(logf(nf / 16.0f) / 2.0794415416798357f * 16.0f); bucket = large < 31 ? large : 31; }
        bt[idx] = p.rel_bias[bucket * 8 + h];
    }
}

__device__ __forceinline__ void phase_norm(const Ctx& C0, const float* xin, const float* g, bf16* hout) {
    const Ctx C = relaunder(C0);
    const int gw = C.bid * 8 + C.wave, NGW = C.G * 8;
    f32x4 gv[4];
#pragma unroll
    for (int j = 0; j < 4; ++j) gv[j] = *((const f32x4*)g + C.lane + 64 * j);
    for (int m = gw; m < T; m += 2 * NGW) {
        const int m2 = m + NGW; const bool has2 = m2 < T;
        const f32x4* xr = (const f32x4*)(xin + (size_t)m * DM) + C.lane; const f32x4* xr2 = (const f32x4*)(xin + (size_t)(has2 ? m2 : m) * DM) + C.lane;
        f32x4 v[4], u[4]; float s = 0.f, s2 = 0.f;
#pragma unroll
        for (int j = 0; j < 4; ++j) { v[j] = xr[64 * j]; u[j] = xr2[64 * j]; }
#pragma unroll
        for (int j = 0; j < 4; ++j) { s += (v[j].x * v[j].x + v[j].y * v[j].y) + (v[j].z * v[j].z + v[j].w * v[j].w); s2 += (u[j].x * u[j].x + u[j].y * u[j].y) + (u[j].z * u[j].z + u[j].w * u[j].w); }
        const float rstd = 1.0f / sqrtf(wave_sum(s) * (1.f / DM) + EPS), rstd2 = 1.0f / sqrtf(wave_sum(s2) * (1.f / DM) + EPS);
        v2u* o8 = (v2u*)(hout + (size_t)m * DM) + C.lane;
#pragma unroll
        for (int j = 0; j < 4; ++j) { v2u w; w.x = pk2(v[j].x * rstd * gv[j].x, v[j].y * rstd * gv[j].y); w.y = pk2(v[j].z * rstd * gv[j].z, v[j].w * rstd * gv[j].w); o8[64 * j] = w; }
        if (has2) { v2u* p8 = (v2u*)(hout + (size_t)m2 * DM) + C.lane;
#pragma unroll
            for (int j = 0; j < 4; ++j) { v2u w; w.x = pk2(u[j].x * rstd2 * gv[j].x, u[j].y * rstd2 * gv[j].y); w.y = pk2(u[j].z * rstd2 * gv[j].z, u[j].w * rstd2 * gv[j].w); p8[64 * j] = w; } }
    }
}
__device__ __forceinline__ void phase_final_norm(const Ctx& C, const float* g, float* x, float dbg_add = 0.f) {
    const int gw = C.bid * 8 + C.wave, NGW = C.G * 8;
    f32x4 gv[4];
#pragma unroll
    for (int j = 0; j < 4; ++j) gv[j] = *((const f32x4*)g + C.lane + 64 * j);
    for (int m = gw; m < T; m += NGW) {
        f32x4* xr = (f32x4*)(x + (size_t)m * DM) + C.lane;
        f32x4 v[4]; float s = 0.f;
#pragma unroll
        for (int j = 0; j < 4; ++j) { v[j] = xr[64 * j]; s += (v[j].x * v[j].x + v[j].y * v[j].y) + (v[j].z * v[j].z + v[j].w * v[j].w); }
        const float rstd = 1.0f / sqrtf(wave_sum(s) * (1.f / DM) + EPS);
#pragma unroll
        for (int j = 0; j < 4; ++j) xr[64 * j] = v[j] * rstd * gv[j] + dbg_add;
#ifdef DBG_ZERO
        { const int s_ = m & (SEQ - 1); if (DBG_ZERO) {
#pragma unroll
            for (int j = 0; j < 4; ++j) xr[64 * j] = (f32x4){0.f, 0.f, 0.f, 0.f}; } }
#endif
    }
}

__device__ __forceinline__ void rownorm_rows(const Ctx& C0, const Params& p, int l, int gw, int NGW) {
    const Ctx C = relaunder(C0);
    bf16* P = (bf16*)(p.ws + WS_P);
    const f32x2* cs = (const f32x2*)(p.ws + WS_ROPE);
    const float* gq = p.g_qn + l * 256; const float* gkv = p.g_kvn + l * 128;
    const f32x4 gqv = *((const f32x4*)gq + C.lane); const f32x2 gkvv = *((const f32x2*)gkv + C.lane);
    for (int m = gw; m < T; m += 2 * NGW) {
        const int mm[2] = {m, (m + NGW < T) ? m + NGW : m}; const int nrow = (m + NGW < T) ? 2 : 1;
        v2u cw[2]; unsigned kw[2]; float x1[2], x2[2]; f32x2 cc[2];
#pragma unroll
        for (int r = 0; r < 2; ++r) { const bf16* row = P + (size_t)mm[r] * PN; cw[r] = *((const v2u*)(row + C_CQ) + C.lane); kw[r] = *((const unsigned*)(row + C_CKV) + C.lane);
            x1[r] = bf2f(row[C_KPE + (C.lane & 15)]); x2[r] = bf2f(row[C_KPE + 16 + (C.lane & 15)]); cc[r] = cs[(size_t)mm[r] * 16 + (C.lane & 15)]; }
#pragma unroll
        for (int r = 0; r < 2; ++r) {
            if (r < nrow) {
            bf16* row = P + (size_t)mm[r] * PN;
            const float a0 = bflo(cw[r].x), a1 = bfhi(cw[r].x), a2 = bflo(cw[r].y), a3 = bfhi(cw[r].y);
            const float rq = 1.0f / sqrtf(wave_sum((a0 * a0 + a1 * a1) + (a2 * a2 + a3 * a3)) * (1.f / 256.f) + EPS);
            const float b0 = bflo(kw[r]), b1 = bfhi(kw[r]);
            const float rk = 1.0f / sqrtf(wave_sum(b0 * b0 + b1 * b1) * (1.f / 128.f) + EPS);
            v2u ow; ow.x = pk2(a0 * rq * gqv.x, a1 * rq * gqv.y); ow.y = pk2(a2 * rq * gqv.z, a3 * rq * gqv.w); *((v2u*)(row + C_CQ) + C.lane) = ow;
            *((unsigned*)(row + C_CKV) + C.lane) = pk2(b0 * rk * gkvv.x, b1 * rk * gkvv.y);
            if (C.lane < 16) {
                f32x2 c = cc[r];
#ifdef DBG_NOROPE
                c = (f32x2){1.f, 0.f};
#endif
                row[C_KPE + C.lane] = (bf16)f2bf(x1[r] * c.x - x2[r] * c.y);
                row[C_KPE + 16 + C.lane] = (bf16)f2bf(x2[r] * c.x + x1[r] * c.y);
            }
            }
        }
    }
}

template <bool SWA>
__device__ __forceinline__ void attn_unit(const Ctx& C, const Params& p, int l, int unit) {
    constexpr int NKK = SWA ? 2 : 3;
    const int lane = C.lane, fr = lane & 15, fq = lane >> 4;
    int b, h, qb;
    if constexpr (SWA) { b = unit >> 8; h = (unit >> 5) & 7; qb = unit & 31; }
    else {
        const int k = unit >> 8, i = unit & 255, g = i >> 6, bh = i & 63;
        qb = 31 - 4 * k - ((k & 1) ? (3 - g) : g); b = bh >> 3; h = bh & 7;
    }
    const int q0 = qb * 128 + C.wave * 16;
    const size_t tok0 = (size_t)b * SEQ;
    const size_t qrow = tok0 + q0 + fr;
    const bf16* P = (const bf16*)(p.ws + WS_P);
    bf16x8 qf[NKK];
    if constexpr (SWA) {
        const bf16* qp = P + qrow * PN + C_QA + h * 64 + fq * 8;
        qf[0] = *(const bf16x8*)qp; qf[1] = *(const bf16x8*)(qp + 32);
    } else {
        const bf16* qp = (const bf16*)(p.ws + WS_QM) + qrow * 768 + h * 96 + fq * 8;
        qf[0] = *(const bf16x8*)qp; qf[1] = *(const bf16x8*)(qp + 32);
        const v4u raw = *(const v4u*)(qp + 64);
        const f32x2* cs = (const f32x2*)(p.ws + WS_ROPE) + qrow * 16 + (fq & 1) * 8;
        float own[8] = {bflo(raw.x), bfhi(raw.x), bflo(raw.y), bfhi(raw.y), bflo(raw.z), bfhi(raw.z), bflo(raw.w), bfhi(raw.w)};
        float res[8];
#pragma unroll
        for (int e = 0; e < 8; ++e) { const float oth = __shfl_xor(own[e], 32); f32x2 c = cs[e];
#ifdef DBG_NOROPE
            c = (f32x2){1.f, 0.f};
#endif

            res[e] = (fq < 2) ? (own[e] * c.x - oth * c.y) : (own[e] * c.x + oth * c.y); }
        v4u rw; rw.x = pk2(res[0], res[1]); rw.y = pk2(res[2], res[3]); rw.z = pk2(res[4], res[5]); rw.w = pk2(res[6], res[7]);
        qf[2] = __builtin_bit_cast(bf16x8, rw);
    }
    const float scale = SWA ? 0.125f : 0.10206207261596577f;
    float sink2 = 0.f, m = -1e30f, lsum = 0.f;
    if constexpr (SWA) { sink2 = p.sinks[l * 8 + h] * LOG2E; m = sink2; }
    f32x4 o[4];
#pragma unroll
    for (int d = 0; d < 4; ++d) o[d] = (f32x4){0.f, 0.f, 0.f, 0.f};
    const int kt_lo = SWA ? ((q0 - 127 > 0 ? q0 - 127 : 0) >> 5) : 0, kt_hi = (q0 + 15) >> 5;
    const int qi = q0 + fr;
    int pq = 0; if constexpr (SWA) pq = p.pos[qrow];
    const float* bt = (const float*)(p.ws + WS_BT) + h;
    const bf16* Kb; int ldk; const bf16* Vt;
    if constexpr (SWA) { Kb = P + C_KA + (h >> 2) * 64; ldk = PN; Vt = (const bf16*)(p.ws + WS_VTA) + (size_t)((h >> 2) * 64) * T; }
    else { Kb = (const bf16*)(p.ws + WS_KM) + h * 64; ldk = 512; Vt = (const bf16*)(p.ws + WS_VTM) + (size_t)(h * 64) * T; }
    for (int kt = kt_lo; kt <= kt_hi; ++kt) {
        const int k0 = kt * 32;
        f32x4 s0 = (f32x4){0.f, 0.f, 0.f, 0.f}, s1 = (f32x4){0.f, 0.f, 0.f, 0.f};
        const size_t kra = tok0 + k0 + fr, krb = kra + 16;
#pragma unroll
        for (int kk = 0; kk < NKK; ++kk) {
            bf16x8 ka, kb;
            if (SWA || kk < 2) { ka = *(const bf16x8*)(Kb + kra * ldk + kk * 32 + fq * 8); kb = *(const bf16x8*)(Kb + krb * ldk + kk * 32 + fq * 8); }
            else { ka = *(const bf16x8*)(P + kra * PN + C_KPE + fq * 8); kb = *(const bf16x8*)(P + krb * PN + C_KPE + fq * 8); }
            s0 = __builtin_amdgcn_mfma_f32_16x16x32_bf16(ka, qf[kk], s0, 0, 0, 0);
            s1 = __builtin_amdgcn_mfma_f32_16x16x32_bf16(kb, qf[kk], s1, 0, 0, 0);
        }
        float v[8];
        int pka[4] = {0, 0, 0, 0}, pkb[4] = {0, 0, 0, 0};
        if constexpr (SWA) { const int4 t0 = *(const int4*)(p.pos + tok0 + k0 + fq * 4), t1 = *(const int4*)(p.pos + tok0 + k0 + 16 + fq * 4);
            pka[0] = t0.x; pka[1] = t0.y; pka[2] = t0.z; pka[3] = t0.w; pkb[0] = t1.x; pkb[1] = t1.y; pkb[2] = t1.z; pkb[3] = t1.w; }
#pragma unroll
        for (int j = 0; j < 4; ++j) {
            const int keya = k0 + fq * 4 + j, keyb = keya + 16;
            float sa = s0[j] * scale, sb = s1[j] * scale;
            bool oka = keya <= qi, okb = keyb <= qi;
            if constexpr (SWA) {
                int da = pq - pka[j]; da = da < 0 ? 0 : (da > 128 ? 128 : da);
                int db = pq - pkb[j]; db = db < 0 ? 0 : (db > 128 ? 128 : db);
#ifndef DBG_NOBIAS
                sa += bt[da * 8]; sb += bt[db * 8];
#endif
                oka = oka && (qi - keya < 128); okb = okb && (qi - keyb < 128);
            }
            v[j] = oka ? sa * LOG2E : -1e30f; v[4 + j] = okb ? sb * LOG2E : -1e30f;
        }
        float mx = fmaxf(fmaxf(fmaxf(v[0], v[1]), fmaxf(v[2], v[3])), fmaxf(fmaxf(v[4], v[5]), fmaxf(v[6], v[7])));
        mx = fmaxf(mx, __shfl_xor(mx, 16)); mx = fmaxf(mx, __shfl_xor(mx, 32));
        const float mn = fmaxf(m, mx), alpha = __builtin_amdgcn_exp2f(m - mn); m = mn;
        float ps = 0.f;
#pragma unroll
        for (int e = 0; e < 8; ++e) { v[e] = __builtin_amdgcn_exp2f(v[e] - mn); ps += v[e]; }
        lsum = lsum * alpha + ps;
#pragma unroll
        for (int d = 0; d < 4; ++d) o[d] = o[d] * alpha;
        v4u pw; pw.x = pk2(v[0], v[1]); pw.y = pk2(v[2], v[3]); pw.z = pk2(v[4], v[5]); pw.w = pk2(v[6], v[7]);
        const bf16x8 pf = __builtin_bit_cast(bf16x8, pw);
#pragma unroll
        for (int d = 0; d < 4; ++d) {
            const bf16* vp = Vt + (size_t)(d * 16 + fr) * T + tok0 + k0 + fq * 4;
            const v2u lo = *(const v2u*)vp, hi = *(const v2u*)(vp + 16);
            const v4u vw = (v4u){lo.x, lo.y, hi.x, hi.y};
            o[d] = __builtin_amdgcn_mfma_f32_16x16x32_bf16(__builtin_bit_cast(bf16x8, vw), pf, o[d], 0, 0, 0);
        }
    }
    lsum += __shfl_xor(lsum, 16); lsum += __shfl_xor(lsum, 32);
    if constexpr (SWA) lsum += __builtin_amdgcn_exp2f(sink2 - m);
    const float inv = 1.0f / lsum;
    bf16* Y = (bf16*)(p.ws + WS_Y) + (SWA ? (size_t)0 : (size_t)2 * T * 512) + qrow * 512 + h * 64 + fq * 4;
#pragma unroll
    for (int d = 0; d < 4; ++d) { v2u w; w.x = pk2(o[d][0] * inv, o[d][1] * inv); w.y = pk2(o[d][2] * inv, o[d][3] * inv); *(v2u*)(Y + d * 16) = w; }
}

__device__ __forceinline__ void conv_unit(const Ctx& C0, const Params& p, int l, int unit) {
    const Ctx C = relaunder(C0);
    LAS float* U = (LAS float*)C.lds;
    const int c = C.tid, t0 = unit * 32, s0 = t0 & (SEQ - 1);
    const bf16* P = (const bf16*)(p.ws + WS_P);
    { const int cg8 = (c & 63) * 8, rsub = c >> 6;
#pragma unroll
      for (int pass = 0; pass < 8; ++pass) {
        const int r = pass * 8 + rsub;
        if (r < 62) {
            const int s = s0 - 30 + r; f32x4 u0 = (f32x4){0.f, 0.f, 0.f, 0.f}, u1 = u0;
            if (s >= 0) { const bf16* row = P + (size_t)(t0 - 30 + r) * PN + C_UB + cg8; const v4u a = *(const v4u*)row, g = *(const v4u*)(row + 512);
                u0[0] = bflo(a.x) * sigmoidf_(bflo(g.x)); u0[1] = bfhi(a.x) * sigmoidf_(bfhi(g.x)); u0[2] = bflo(a.y) * sigmoidf_(bflo(g.y)); u0[3] = bfhi(a.y) * sigmoidf_(bfhi(g.y));
                u1[0] = bflo(a.z) * sigmoidf_(bflo(g.z)); u1[1] = bfhi(a.z) * sigmoidf_(bfhi(g.z)); u1[2] = bflo(a.w) * sigmoidf_(bflo(g.w)); u1[3] = bfhi(a.w) * sigmoidf_(bfhi(g.w)); }
            *(LAS f32x4*)(U + r * 512 + cg8) = u0; *(LAS f32x4*)(U + r * 512 + cg8 + 4) = u1;
        }
      }
    }
    __syncthreads();
    float w[31];
#pragma unroll
    for (int j = 0; j < 31; ++j) w[j] = p.w_dw[(size_t)l * 31 * 512 + j * 512 + c];
    const float bias = p.b_dw[l * 512 + c];
    for (int tb = 0; tb < 32; tb += 8) {
        float acc[8];
#pragma unroll
        for (int k = 0; k < 8; ++k) acc[k] = bias;
#pragma unroll
        for (int jj = 0; jj < 38; ++jj) {
            const float u = U[(tb + jj) * 512 + c];
#pragma unroll
            for (int k = 0; k < 8; ++k) { const int j = jj - k; if (j >= 0 && j < 31) acc[k] += w[j] * u; }
        }
#pragma unroll
        for (int k = 0; k < 8; ++k) U[(tb + k) * 512 + c] = acc[k];
    }
    __syncthreads();
    const float* gl = p.g_cln + l * 512; const float* bl = p.b_cln + l * 512;
    bf16* Y = (bf16*)(p.ws + WS_Y) + (size_t)1 * T * 512;
    for (int q = 0; q < 4; ++q) {
        const int tl = C.wave * 4 + q; float xv[8]; float s = 0.f;
#pragma unroll
        for (int i = 0; i < 8; ++i) { xv[i] = U[tl * 512 + C.lane + 64 * i]; s += xv[i]; }
        const float mean = wave_sum(s) * (1.f / 512.f); float s2 = 0.f;
#pragma unroll
        for (int i = 0; i < 8; ++i) { xv[i] -= mean; s2 += xv[i] * xv[i]; }
        const float rstd = 1.0f / sqrtf(wave_sum(s2) * (1.f / 512.f) + EPS);
#pragma unroll
        for (int i = 0; i < 8; ++i) { const int ch = C.lane + 64 * i; const float y = xv[i] * rstd * gl[ch] + bl[ch]; Y[(size_t)(t0 + tl) * 512 + ch] = (bf16)f2bf(y * sigmoidf_(y)); }
    }
    __syncthreads();
}

constexpr int AK_ROW = 208, AV_ROW = 144, AK_BYTES = 64 * AK_ROW, AV_BYTES = 64 * AV_ROW, ABUF = AK_BYTES + AV_BYTES;
__device__ __forceinline__ void mla_unit(const Ctx& C, const Params& p, int unit) {
    int tid_ = C.tid; asm volatile("" : "+v"(tid_));
    const int tid = tid_, lane = tid & 63, fr = lane & 15, fq = lane >> 4;
    int b, h, qb;
    { const int k = unit >> 8, i = unit & 255, g = i >> 6, bh = i & 63; qb = 15 - 4 * k - ((k & 1) ? (3 - g) : g); b = bh >> 3; h = bh & 7; }
    const int q0w = qb * 256 + C.wave * 32;
    const size_t tok0 = (size_t)b * SEQ;
    const bf16* P = (const bf16*)(p.ws + WS_P); const bf16* QM = (const bf16*)(p.ws + WS_QM); const bf16* KM = (const bf16*)(p.ws + WS_KM); const bf16* VTM = (const bf16*)(p.ws + WS_VTM);
    bf16x8 qf[2][3];
#pragma unroll
    for (int g = 0; g < 2; ++g) {
        const size_t qrow = tok0 + q0w + 16 * g + fr;
        const bf16* qp = QM + qrow * 768 + h * 96 + fq * 8;
        qf[g][0] = *(const bf16x8*)qp; qf[g][1] = *(const bf16x8*)(qp + 32);
        const v4u raw = *(const v4u*)(qp + 64);
        const f32x2* cs = (const f32x2*)(p.ws + WS_ROPE) + qrow * 16 + (fq & 1) * 8;
        const float own[8] = {bflo(raw.x), bfhi(raw.x), bflo(raw.y), bfhi(raw.y), bflo(raw.z), bfhi(raw.z), bflo(raw.w), bfhi(raw.w)};
        float res[8];
#pragma unroll
        for (int e = 0; e < 8; ++e) { const float oth = __shfl_xor(own[e], 32); const f32x2 c = cs[e]; res[e] = (fq < 2) ? (own[e] * c.x - oth * c.y) : (own[e] * c.x + oth * c.y); }
        v4u rw; rw.x = pkhw(res[0], res[1]); rw.y = pkhw(res[2], res[3]); rw.z = pkhw(res[4], res[5]); rw.w = pkhw(res[6], res[7]);
        qf[g][2] = __builtin_bit_cast(bf16x8, rw);
    }
    float m[2] = {-1e30f, -1e30f}, lsum[2] = {0.f, 0.f};
    f32x4 o[2][4];
#pragma unroll
    for (int g = 0; g < 2; ++g)
#pragma unroll
        for (int d = 0; d < 4; ++d) o[g][d] = (f32x4){0.f, 0.f, 0.f, 0.f};
    const int nt = 4 * (qb + 1), my_last = (q0w + 31) >> 6;
    const int kc0 = tid, kc1 = tid + 512;
    const int key0 = kc0 / 12, part0 = kc0 % 12, key1 = kc1 / 12, part1 = kc1 % 12; const bool has1 = kc1 < 768;
    const bf16* ksrc0 = (part0 < 8) ? (KM + (tok0 + key0) * 512 + h * 64 + part0 * 8) : (P + (tok0 + key0) * PN + C_KPE + (part0 - 8) * 8);
    const bf16* ksrc1 = (part1 < 8) ? (KM + (tok0 + key1) * 512 + h * 64 + part1 * 8) : (P + (tok0 + key1) * PN + C_KPE + (part1 - 8) * 8);
    const size_t kstep0 = (part0 < 8) ? (size_t)64 * 512 : (size_t)64 * PN, kstep1 = (part1 < 8) ? (size_t)64 * 512 : (size_t)64 * PN;
    const int kdst0 = key0 * AK_ROW + part0 * 16, kdst1 = key1 * AK_ROW + part1 * 16;
    const bf16* vsrc = VTM + (size_t)(h * 64 + (tid >> 3)) * T + tok0 + (tid & 7) * 8;
    const int vdst = AK_BYTES + (tid >> 3) * AV_ROW + (tid & 7) * 16;
    LAS unsigned char* lds = C.lds;
    v4u r0[2], r1[2], r2[2];
#pragma unroll
    for (int sb = 0; sb < 2; ++sb) { r1[sb] = (v4u){0u, 0u, 0u, 0u}; r0[sb] = *(const v4u*)(ksrc0 + (size_t)sb * kstep0); if (has1) r1[sb] = *(const v4u*)(ksrc1 + (size_t)sb * kstep1); r2[sb] = *(const v4u*)(vsrc + (size_t)sb * 64); }
#pragma unroll
    for (int sb = 0; sb < 2; ++sb) { LAS unsigned char* nb = lds + sb * ABUF; *(LAS v4u*)(nb + kdst0) = r0[sb]; if (has1) *(LAS v4u*)(nb + kdst1) = r1[sb]; *(LAS v4u*)(nb + vdst) = r2[sb]; }
    __syncthreads();
    const float c2 = 0.10206207261596577f * LOG2E;
    for (int kp = 0; kp < nt / 2; ++kp) {
        const bool more = 2 * kp + 2 < nt;
        if (more) {
#pragma unroll
            for (int sb = 0; sb < 2; ++sb) { const int tn = 2 * kp + 2 + sb; r0[sb] = *(const v4u*)(ksrc0 + (size_t)tn * kstep0); if (has1) r1[sb] = *(const v4u*)(ksrc1 + (size_t)tn * kstep1); r2[sb] = *(const v4u*)(vsrc + (size_t)tn * 64); } }
#pragma unroll 1
        for (int sub = 0; sub < 2; ++sub) {
        const int kt = 2 * kp + sub;
        if (kt <= my_last) {
            const LAS unsigned char* Kb = lds + ((kp & 1) * 2 + sub) * ABUF; const LAS unsigned char* Vb = Kb + AK_BYTES;
            const int k0 = kt * 64;
            f32x4 s[2][4];
#pragma unroll
            for (int g = 0; g < 2; ++g)
#pragma unroll
                for (int blk = 0; blk < 4; ++blk) s[g][blk] = (f32x4){0.f, 0.f, 0.f, 0.f};
#pragma unroll
            for (int kk = 0; kk < 3; ++kk)
#pragma unroll
                for (int blk = 0; blk < 4; ++blk) {
                    const bf16x8 kf = *(const LAS bf16x8*)(Kb + (blk * 16 + fr) * AK_ROW + (kk * 32 + fq * 8) * 2);
#pragma unroll
                    for (int g = 0; g < 2; ++g) s[g][blk] = __builtin_amdgcn_mfma_f32_16x16x32_bf16(kf, qf[g][kk], s[g][blk], 0, 0, 0);
                }
            const bool need_mask = (k0 + 63 > q0w);
            bf16x8 pf[2][2];
#pragma unroll
            for (int g = 0; g < 2; ++g) {
                const int qi = q0w + 16 * g + fr;
                if (need_mask) {
                    asm volatile("" ::: "memory");
#pragma unroll
                    for (int blk = 0; blk < 4; ++blk)
#pragma unroll
                        for (int j = 0; j < 4; ++j) { const int key = k0 + blk * 16 + fq * 4 + j; if (key > qi) s[g][blk][j] = -1e30f; }
                    asm volatile("" ::: "memory");
                }
                float mx = fmaxf(s[g][0][0], s[g][0][1]);
                mx = fmaxf(fmaxf(mx, s[g][0][2]), s[g][0][3]);
#pragma unroll
                for (int blk = 1; blk < 4; ++blk) { mx = fmaxf(fmaxf(mx, s[g][blk][0]), s[g][blk][1]); mx = fmaxf(fmaxf(mx, s[g][blk][2]), s[g][blk][3]); }
                mx = rowmax4(mx);
                const float mn = fmaxf(m[g], mx * c2), alpha = __builtin_amdgcn_exp2f(m[g] - mn); m[g] = mn;
                f32x2 ps2 = (f32x2){0.f, 0.f};
                const f32x2 c2v = (f32x2){c2, c2}, mnv = (f32x2){mn, mn};
#pragma unroll
                for (int blk = 0; blk < 4; ++blk)
#pragma unroll
                    for (int jp = 0; jp < 2; ++jp) { f32x2 x = (f32x2){s[g][blk][2 * jp], s[g][blk][2 * jp + 1]}; x = x * c2v - mnv;
                        f32x2 pv; pv.x = __builtin_amdgcn_exp2f(x.x); pv.y = __builtin_amdgcn_exp2f(x.y); ps2 = ps2 + pv; s[g][blk][2 * jp] = pv.x; s[g][blk][2 * jp + 1] = pv.y; }
                const float ps = ps2.x + ps2.y;
                lsum[g] = lsum[g] * alpha + ps;
                if (__builtin_amdgcn_ballot_w64(alpha != 1.0f) != 0ull) {
#pragma unroll
                    for (int d = 0; d < 4; ++d) o[g][d] = o[g][d] * alpha;
                }
#pragma unroll
                for (int hf = 0; hf < 2; ++hf) { v4u pw; pw.x = pkhw(s[g][2 * hf][0], s[g][2 * hf][1]); pw.y = pkhw(s[g][2 * hf][2], s[g][2 * hf][3]); pw.z = pkhw(s[g][2 * hf + 1][0], s[g][2 * hf + 1][1]); pw.w = pkhw(s[g][2 * hf + 1][2], s[g][2 * hf + 1][3]);
                    pf[g][hf] = __builtin_bit_cast(bf16x8, pw); }
            }
#pragma unroll
            for (int hf = 0; hf < 2; ++hf)
#pragma unroll
                for (int d = 0; d < 4; ++d) {
                    const LAS unsigned char* vp = Vb + (d * 16 + fr) * AV_ROW + (hf * 32 + fq * 4) * 2;
                    const v2u lo = *(const LAS v2u*)vp, hi = *(const LAS v2u*)(vp + 32);
                    const v4u vw = (v4u){lo.x, lo.y, hi.x, hi.y}; const bf16x8 vf = __builtin_bit_cast(bf16x8, vw);
#pragma unroll
                    for (int g = 0; g < 2; ++g) o[g][d] = __builtin_amdgcn_mfma_f32_16x16x32_bf16(vf, pf[g][hf], o[g][d], 0, 0, 0);
                }
        }
        }
        if (more) {
#pragma unroll
            for (int sb = 0; sb < 2; ++sb) { LAS unsigned char* nb = lds + (((kp + 1) & 1) * 2 + sb) * ABUF; *(LAS v4u*)(nb + kdst0) = r0[sb]; if (has1) *(LAS v4u*)(nb + kdst1) = r1[sb]; *(LAS v4u*)(nb + vdst) = r2[sb]; } }
        __syncthreads();
    }
    bf16* Y = (bf16*)(p.ws + WS_Y) + (size_t)2 * T * 512;
#pragma unroll
    for (int g = 0; g < 2; ++g) {
        float lt = lsum[g]; lt += __shfl_xor(lt, 16); lt += __shfl_xor(lt, 32);
        const float inv = 1.0f / lt;
        bf16* yp = Y + (tok0 + q0w + 16 * g + fr) * 512 + h * 64 + fq * 4;
#pragma unroll
        for (int d = 0; d < 4; ++d) { v2u w; w.x = pkhw(o[g][d][0] * inv, o[g][d][1] * inv); w.y = pkhw(o[g][d][2] * inv, o[g][d][3] * inv); *(v2u*)(yp + d * 16) = w; }
    }
}

__device__ __forceinline__ void swa_unit(const Ctx& C, const Params& p, int l, int unit) {
    int tid_ = threadIdx.x; asm volatile("" : "+v"(tid_));
    const int tid = tid_, lane = tid & 63, fr = lane & 15, fq = lane >> 4, wave_ = __builtin_amdgcn_readfirstlane(tid >> 6);
    const int b = unit >> 5, kvh = (unit >> 4) & 1, qb = unit & 15;
    const int q0w = qb * 256 + wave_ * 32;
    const size_t tok0 = (size_t)b * SEQ;
    const bf16* P = (const bf16*)(p.ws + WS_P); const bf16* VTA = (const bf16*)(p.ws + WS_VTA);
    LAS unsigned char* lds = C.lds;
    constexpr int SROW = 144, STILE = 2 * 64 * SROW;
    LAS float* btl = (LAS float*)(lds + 6 * STILE);
    const int kt_lo = (4 * qb - 2 > 0) ? 4 * qb - 2 : 0, kt_hi = 4 * qb + 3, ntile = kt_hi - kt_lo + 1;
    const int my_lo = (q0w - 127 > 0 ? q0w - 127 : 0) >> 6, my_hi = (q0w + 31) >> 6;
    {
        const bf16* ksrc = P + (tok0 + (size_t)kt_lo * 64 + (tid >> 3)) * PN + C_KA + kvh * 64 + (tid & 7) * 8;
        const bf16* vsrc = VTA + (size_t)(kvh * 64 + (tid >> 3)) * T + tok0 + (size_t)kt_lo * 64 + (tid & 7) * 8;
        const int dst = (tid >> 3) * SROW + (tid & 7) * 16;
        v4u rk[6], rv[6];
#pragma unroll
        for (int t = 0; t < 6; ++t) if (t < ntile) { rk[t] = *(const v4u*)(ksrc + (size_t)t * 64 * PN); rv[t] = *(const v4u*)(vsrc + (size_t)t * 64); }
        for (int i = tid; i < 4 * 129; i += 512) { const int hh = i / 129, n = i - hh * 129; btl[i] = ((const float*)(p.ws + WS_BT))[n * 8 + kvh * 4 + hh] * LOG2E; }
#pragma unroll
        for (int t = 0; t < 6; ++t) if (t < ntile) { *(LAS v4u*)(lds + t * STILE + dst) = rk[t]; *(LAS v4u*)(lds + t * STILE + 64 * SROW + dst) = rv[t]; }
    }
    __syncthreads();
    const float c2 = 0.125f * LOG2E;
    int pq[2];
#pragma unroll
    for (int g = 0; g < 2; ++g) pq[g] = p.pos[tok0 + q0w + 16 * g + fr];
#pragma unroll 1
    for (int hh = 0; hh < 4; ++hh) {
        const int h = kvh * 4 + hh;
        const LAS float* bth = btl + hh * 129;
        bf16x8 qf[2][2];
#pragma unroll
        for (int g = 0; g < 2; ++g) { const bf16* qp = P + (tok0 + q0w + 16 * g + fr) * PN + C_QA + h * 64 + fq * 8; qf[g][0] = *(const bf16x8*)qp; qf[g][1] = *(const bf16x8*)(qp + 32); }
        const float sink2 = p.sinks[l * 8 + h] * LOG2E;
        float m[2] = {sink2, sink2}, lsum[2] = {0.f, 0.f};
        f32x4 o[2][4];
#pragma unroll
        for (int g = 0; g < 2; ++g)
#pragma unroll
            for (int d = 0; d < 4; ++d) o[g][d] = (f32x4){0.f, 0.f, 0.f, 0.f};
#pragma unroll 1
        for (int kt = my_lo; kt <= my_hi; ++kt) {
            const LAS unsigned char* Kb = lds + (kt - kt_lo) * STILE; const LAS unsigned char* Vb = Kb + 64 * SROW;
            const int k0 = kt * 64;
            f32x4 s[2][4];
#pragma unroll
            for (int blk = 0; blk < 4; ++blk) {
                bf16x8 kf[2];
#pragma unroll
                for (int kk = 0; kk < 2; ++kk) kf[kk] = *(const LAS bf16x8*)(Kb + (blk * 16 + fr) * SROW + (kk * 32 + fq * 8) * 2);
#pragma unroll
                for (int g = 0; g < 2; ++g) { f32x4 a = (f32x4){0.f, 0.f, 0.f, 0.f};
#pragma unroll
                    for (int kk = 0; kk < 2; ++kk) a = __builtin_amdgcn_mfma_f32_16x16x32_bf16(kf[kk], qf[g][kk], a, 0, 0, 0);
                    s[g][blk] = a; }
            }
            bf16x8 pf[2][2];
#pragma unroll
            for (int g = 0; g < 2; ++g) {
                const int qi = q0w + 16 * g + fr;
#pragma unroll
                for (int blk = 0; blk < 4; ++blk) { const int4 t4 = *(const int4*)(p.pos + tok0 + k0 + blk * 16 + fq * 4); const int pkv[4] = {t4.x, t4.y, t4.z, t4.w};
#pragma unroll
                    for (int j = 0; j < 4; ++j) { const int key = k0 + blk * 16 + fq * 4 + j; int dd = pq[g] - pkv[j]; dd = dd < 0 ? 0 : (dd > 128 ? 128 : dd);
                        const float v = s[g][blk][j] * c2 + bth[dd]; const bool ok = (key <= qi) && (qi - key < 128); s[g][blk][j] = ok ? v : -1e30f; } }
                float mx = fmaxf(fmaxf(s[g][0][0], s[g][0][1]), fmaxf(s[g][0][2], s[g][0][3]));
#pragma unroll
                for (int blk = 1; blk < 4; ++blk) mx = fmaxf(mx, fmaxf(fmaxf(s[g][blk][0], s[g][blk][1]), fmaxf(s[g][blk][2], s[g][blk][3])));
                mx = rowmax4(mx);
                const float mn = fmaxf(m[g], mx), alpha = __builtin_amdgcn_exp2f(m[g] - mn); m[g] = mn;
                f32x2 ps2 = (f32x2){0.f, 0.f}; const f32x2 mnv = (f32x2){mn, mn};
#pragma unroll
                for (int blk = 0; blk < 4; ++blk)
#pragma unroll
                    for (int jp = 0; jp < 2; ++jp) { f32x2 x = (f32x2){s[g][blk][2 * jp], s[g][blk][2 * jp + 1]}; x = x - mnv;
                        f32x2 pv; pv.x = __builtin_amdgcn_exp2f(x.x); pv.y = __builtin_amdgcn_exp2f(x.y); ps2 = ps2 + pv; s[g][blk][2 * jp] = pv.x; s[g][blk][2 * jp + 1] = pv.y; }
                const float ps = ps2.x + ps2.y;
                lsum[g] = lsum[g] * alpha + ps;
#pragma unroll
                for (int d = 0; d < 4; ++d) o[g][d] = o[g][d] * alpha;
#pragma unroll
                for (int hf = 0; hf < 2; ++hf) { v4u pw; pw.x = pkhw(s[g][2 * hf][0], s[g][2 * hf][1]); pw.y = pkhw(s[g][2 * hf][2], s[g][2 * hf][3]); pw.z = pkhw(s[g][2 * hf + 1][0], s[g][2 * hf + 1][1]); pw.w = pkhw(s[g][2 * hf + 1][2], s[g][2 * hf + 1][3]);
                    pf[g][hf] = __builtin_bit_cast(bf16x8, pw); }
            }
#pragma unroll
            for (int hf = 0; hf < 2; ++hf)
#pragma unroll
                for (int d = 0; d < 4; ++d) {
                    const LAS unsigned char* vp = Vb + (d * 16 + fr) * SROW + (hf * 32 + fq * 4) * 2;
                    const v2u lo = *(const LAS v2u*)vp, hi = *(const LAS v2u*)(vp + 32);
                    const v4u vw = (v4u){lo.x, lo.y, hi.x, hi.y}; const bf16x8 vf = __builtin_bit_cast(bf16x8, vw);
#pragma unroll
                    for (int g = 0; g < 2; ++g) o[g][d] = __builtin_amdgcn_mfma_f32_16x16x32_bf16(vf, pf[g][hf], o[g][d], 0, 0, 0);
                }
        }
        bf16* Y = (bf16*)(p.ws + WS_Y);
#pragma unroll
        for (int g = 0; g < 2; ++g) {
            float lt = lsum[g]; lt += __shfl_xor(lt, 16); lt += __shfl_xor(lt, 32);
            lt += __builtin_amdgcn_exp2f(sink2 - m[g]);
            const float inv = 1.0f / lt;
            bf16* yp = Y + (tok0 + q0w + 16 * g + fr) * 512 + h * 64 + fq * 4;
#pragma unroll
            for (int d = 0; d < 4; ++d) { v2u w; w.x = pkhw(o[g][d][0] * inv, o[g][d][1] * inv); w.y = pkhw(o[g][d][2] * inv, o[g][d][3] * inv); *(v2u*)(yp + d * 16) = w; }
        }
    }
    __syncthreads();
}

#ifndef DBG_NAIVE
#define DBG_NAIVE 0
#endif
#if DBG_NAIVE
__device__ __forceinline__ int t5b_n(int rel) { int n = rel < 0 ? 0 : rel; if (n < 16) return n; float nf = (float)n; int lg = 16 + (int)(logf(nf / 16.0f) / 2.0794415416798357f * 16.0f); return lg < 31 ? lg : 31; }
__device__ __forceinline__ void naive_conv(const Ctx& C, const Params& p, int l) {
    LAS float* red = (LAS float*)C.lds; const bf16* P = (const bf16*)(p.ws + WS_P); bf16* Y = (bf16*)(p.ws + WS_Y) + (size_t)T * 512; const int c = C.tid;
    for (int t = C.bid; t < T; t += C.G) {
        const int s = t & (SEQ - 1); float acc = p.b_dw[l * 512 + c];
        for (int j = 0; j < 31; ++j) { const int ss = s - 30 + j; if (ss >= 0) { const bf16* row = P + (size_t)(t - 30 + j) * PN + C_UB; const float a = bf2f(row[c]), g = bf2f(row[512 + c]); acc += p.w_dw[(size_t)l * 31 * 512 + j * 512 + c] * (a / (1.f + expf(-g))); } }
        float sw = wave_sum(acc); if (C.lane == 0) red[C.wave] = sw; __syncthreads();
        float tot = 0.f; for (int w = 0; w < 8; ++w) tot += red[w]; const float mean = tot / 512.f; __syncthreads();
        const float dv = acc - mean; sw = wave_sum(dv * dv); if (C.lane == 0) red[C.wave] = sw; __syncthreads();
        tot = 0.f; for (int w = 0; w < 8; ++w) tot += red[w]; __syncthreads();
        float y = dv / sqrtf(tot / 512.f + EPS) * p.g_cln[l * 512 + c] + p.b_cln[l * 512 + c]; y = y / (1.f + expf(-y));
        Y[(size_t)t * 512 + c] = (bf16)f2bf(y);
    }
}
__device__ __forceinline__ void naive_swa(const Ctx& C, const Params& p, int l) {
    const bf16* P = (const bf16*)(p.ws + WS_P); bf16* Y = (bf16*)(p.ws + WS_Y);
    for (int it = C.bid * 512 + C.tid; it < T * 8; it += C.G * 512) {
        const int t = it >> 3, h = it & 7, s = t & (SEQ - 1), b0 = t - s; const bf16* q = P + (size_t)t * PN + h * 64;
        float qv[64];
#pragma unroll
        for (int d = 0; d < 64; ++d) qv[d] = bf2f(q[d]);
        float acc[64];
#pragma unroll
        for (int d = 0; d < 64; ++d) acc[d] = 0.f;
        const float sink = p.sinks[l * 8 + h]; float m = sink, lsum = 0.f;
        for (int ks = (s - 127 > 0 ? s - 127 : 0); ks <= s; ++ks) { const bf16* kr = P + (size_t)(b0 + ks) * PN + C_KA + (h >> 2) * 64; float sc = 0.f;
#pragma unroll
            for (int d = 0; d < 64; ++d) sc += qv[d] * bf2f(kr[d]);
            sc = sc * 0.125f + p.rel_bias[t5b_n(p.pos[t] - p.pos[b0 + ks]) * 8 + h];
            const float mn = fmaxf(m, sc), al = expf(m - mn), pp = expf(sc - mn); lsum = lsum * al + pp; m = mn; const bf16* vr = P + (size_t)(b0 + ks) * PN + C_VA + (h >> 2) * 64;
#pragma unroll
            for (int d = 0; d < 64; ++d) acc[d] = acc[d] * al + pp * bf2f(vr[d]); }
        lsum += expf(sink - m);
#pragma unroll
        for (int d = 0; d < 64; ++d) Y[(size_t)t * 512 + h * 64 + d] = (bf16)f2bf(acc[d] / lsum);
    }
}
__device__ __forceinline__ void naive_mla(const Ctx& C, const Params& p, int l) {
    const bf16* P = (const bf16*)(p.ws + WS_P); const bf16* QM = (const bf16*)(p.ws + WS_QM); const bf16* KM = (const bf16*)(p.ws + WS_KM); const bf16* VTM = (const bf16*)(p.ws + WS_VTM);
    bf16* Y = (bf16*)(p.ws + WS_Y) + (size_t)2 * T * 512; LAS float* qs = (LAS float*)C.lds + C.wave * 128;
    for (int it = C.bid * 8 + C.wave; it < T * 8; it += C.G * 8) {
        const int t = it >> 3, h = it & 7, s = t & (SEQ - 1), b0 = t - s; const bf16* q = QM + (size_t)t * 768 + h * 96;
        asm volatile("s_waitcnt lgkmcnt(0)" ::: "memory");
        qs[C.lane] = bf2f(q[C.lane]);
        if (C.lane < 16) { const float ang = (float)p.pos[t] * expf(-9.210340371976184f * (float)C.lane / 16.f); const float cc = __cosf(ang), sn = __sinf(ang);
            const float x1 = bf2f(q[64 + C.lane]), x2 = bf2f(q[80 + C.lane]); qs[64 + C.lane] = x1 * cc - x2 * sn; qs[80 + C.lane] = x2 * cc + x1 * sn; }
        asm volatile("s_waitcnt lgkmcnt(0)" ::: "memory");
        float acc[64];
#pragma unroll
        for (int d = 0; d < 64; ++d) acc[d] = 0.f;
        float m = -1e30f, lsum = 0.f;
        for (int ks = C.lane; ks <= s; ks += 64) { const size_t kt = (size_t)(b0 + ks); float sc = 0.f;
            for (int d = 0; d < 64; ++d) sc += qs[d] * bf2f(KM[kt * 512 + h * 64 + d]);
            for (int d = 0; d < 32; ++d) sc += qs[64 + d] * bf2f(P[kt * PN + C_KPE + d]);
            sc *= 0.10206207261596577f;
            const float mn = fmaxf(m, sc), al = expf(m - mn), pp = expf(sc - mn); lsum = lsum * al + pp; m = mn;
#pragma unroll
            for (int d = 0; d < 64; ++d) acc[d] = acc[d] * al + pp * bf2f(VTM[(size_t)(h * 64 + d) * T + kt]); }
        float mg = m;
#pragma unroll
        for (int o = 1; o < 64; o <<= 1) mg = fmaxf(mg, __shfl_xor(mg, o));
        const float f = expf(m - mg); const float lt = wave_sum(lsum * f);
#pragma unroll
        for (int d = 0; d < 64; ++d) { const float v = wave_sum(acc[d] * f); if (C.lane == (d & 63)) Y[(size_t)t * 512 + h * 64 + d] = (bf16)f2bf(v / lt); }
    }
}
#endif

#define XB_TMO      128
#define XB_XCNT(j)  (256  + 64 * (j))
#define XB_XSUB(j)  (1280 + 64 * (j))
#define XB_XGEN(j)  (2304 + 64 * (j))
#define XB_TOP      3328
#define XB_TOPGEN   3392
#define XCD_BAR_WORDS 3456
#define XB_SPIN_CAP (1u << 18)

__device__ __forceinline__ unsigned xb_ld(unsigned* p)              { return __hip_atomic_load(p, __ATOMIC_RELAXED, __HIP_MEMORY_SCOPE_AGENT); }
__device__ __forceinline__ unsigned xb_add(unsigned* p, unsigned v) { return __hip_atomic_fetch_add(p, v, __ATOMIC_RELAXED, __HIP_MEMORY_SCOPE_AGENT); }
__device__ __forceinline__ unsigned xb_xcc_id() { return (unsigned)__builtin_amdgcn_s_getreg((3 << 11) | 20) & 0xFu; }
#define XB_SPIN(cond, bar) do { unsigned _sp = 0; while (cond) { __builtin_amdgcn_s_sleep(1); \
    if ((++_sp & 255u) == 0u) { if (xb_ld(&(bar)[XB_TMO])) break; if (_sp > XB_SPIN_CAP) { atomicAdd(&(bar)[XB_TMO], 1u); break; } } } } while (0)

struct XcdBarrier {
    unsigned* bar; unsigned x;
    volatile LAS unsigned* st;
};

__device__ __forceinline__ XcdBarrier xcd_barrier_post(unsigned* bar, volatile LAS unsigned* st) {
    XcdBarrier b; b.bar = bar; b.x = xb_xcc_id(); b.st = st;
    if (threadIdx.x == 0) (void)xb_add(&bar[XB_XCNT(b.x)], 1u);
    return b;
}
__device__ __forceinline__ void xcd_barrier_complete(unsigned* bar, unsigned x, unsigned& nloc, unsigned& nx) {
    const unsigned G = gridDim.x * gridDim.y * gridDim.z;
    unsigned sum, cnt, mine, sp = 0u;
    for (;;) {
        sum = 0u; cnt = 0u; mine = 0u;
#pragma unroll
        for (unsigned j = 0; j < 16; ++j) { const unsigned c = xb_ld(&bar[XB_XCNT(j)]); sum += c; cnt += (c > 0u) ? 1u : 0u; mine = (j == x) ? c : mine; }
        if (sum == G) break;
        __builtin_amdgcn_s_sleep(1);
        if ((++sp & 255u) == 0u) { if (xb_ld(&bar[XB_TMO])) break; if (sp > XB_SPIN_CAP) { atomicAdd(&bar[XB_TMO], 1u); break; } }
    }
    nloc = mine > 0u ? mine : 1u; nx = cnt > 0u ? cnt : 1u;
}

__device__ __forceinline__ void xcd_barrier(const XcdBarrier& b) {
    asm volatile("s_waitcnt vmcnt(0)" ::: "memory");
    __syncthreads();
    if (threadIdx.x == 0) {
        unsigned* bar = b.bar;
        __builtin_amdgcn_s_waitcnt(0);
        unsigned nloc = b.st[0], nx = b.st[1];
        if (nloc == 0u) { xcd_barrier_complete(bar, b.x, nloc, nx); b.st[0] = nloc; b.st[1] = nx; }
        const unsigned old = xb_add(&bar[XB_XSUB(b.x)], 1u);
        const unsigned gen = old / nloc;
        if (old + 1u == (gen + 1u) * nloc) {
            __builtin_amdgcn_fence(__ATOMIC_RELEASE, "agent");
            asm volatile("s_waitcnt vmcnt(0)" ::: "memory");
            const unsigned og = xb_add(&bar[XB_TOP], 1u);
            const unsigned tg = og / nx;
            if (og + 1u == (tg + 1u) * nx) xb_add(&bar[XB_TOPGEN], 1u);
            else XB_SPIN(xb_ld(&bar[XB_TOPGEN]) == tg, bar);
            __builtin_amdgcn_fence(__ATOMIC_ACQUIRE, "agent");
            xb_add(&bar[XB_XGEN(b.x)], 1u);
            asm volatile("s_waitcnt vmcnt(0)" ::: "memory");
        } else {
            XB_SPIN(xb_ld(&bar[XB_XGEN(b.x)]) == gen, bar);
            __builtin_amdgcn_fence(__ATOMIC_ACQUIRE, "agent");
            asm volatile("s_waitcnt vmcnt(0)" ::: "memory");
        }
    }
    __syncthreads();
}

template <int MODE>
__device__ __forceinline__ void run_gemm(const Ctx& C, const bf16* A, int lda, const bf16* Bt, int ldb, int M, int N, int K, const pg8::Epi<MODE>& E, int crot = 0) {
    pg8::Gemm g{A, Bt, lda, ldb, M, N, K}; pg8::StaticOrder S; S.init(M, N, C.G, (C.bid + crot) % C.G);
    pg8::gemm_phase<pg8::Epi<MODE>, pg8::StaticOrder, true, true>(C.lds, g, S, E);
    __syncthreads();
}

#define GSYNC() do { xcd_barrier(xbar); } while (0)
__global__ void __launch_bounds__(512) mega_fwd(Params p) {
    extern __shared__ __attribute__((aligned(16))) unsigned char lds_raw[];
    cg::grid_group grid = cg::this_grid();
    Ctx C; C.lds = (LAS unsigned char*)lds_raw; C.tid = threadIdx.x; C.lane = C.tid & 63; C.wave = __builtin_amdgcn_readfirstlane(C.tid >> 6); C.G = gridDim.x; C.bid = blockIdx.x;
    unsigned char* ws = p.ws;
    bf16* W = (bf16*)(ws + WS_W); bf16* H = (bf16*)(ws + WS_H); bf16* P = (bf16*)(ws + WS_P); bf16* Y = (bf16*)(ws + WS_Y);
    bf16* QM = (bf16*)(ws + WS_QM); bf16* KM = (bf16*)(ws + WS_KM); bf16* VTM = (bf16*)(ws + WS_VTM); bf16* VTA = (bf16*)(ws + WS_VTA);
    bf16* MG = (bf16*)(ws + WS_MG); bf16* GS = (bf16*)(ws + WS_GS); bf16* HID = (bf16*)(ws + WS_HID);

    volatile LAS unsigned* xst = (volatile LAS unsigned*)(C.lds + RING_BYTES + 64);
    if (threadIdx.x < 2) xst[threadIdx.x] = 0u;
    __syncthreads();
    XcdBarrier xbar = xcd_barrier_post((unsigned*)(p.ws), xst);
    phase_tables(C, p);
    asm volatile("s_waitcnt vmcnt(0) lgkmcnt(0)" ::: "memory"); grid.sync();
    for (int l = 0; l < DEPTH; ++l) {
        { int t_ = threadIdx.x; asm volatile("" : "+v"(t_)); C.tid = t_; C.lane = t_ & 63; C.wave = __builtin_amdgcn_readfirstlane(t_ >> 6); }
        const float* xcur = (l == 0) ? p.x : p.out;
        for (int rep_ = 0; rep_ < DBG_REP_A; ++rep_) {
        phase_convert_weights(C, p, l);
        phase_norm(C, xcur, p.g_mix + l * DM, H);
        }
        GSYNC();
        for (int rep_ = 0; rep_ < DBG_XSYNC; ++rep_) GSYNC();
        for (int rep_ = 0; rep_ < DBG_REP_G; ++rep_) {
        { pg8::Epi<pg8::EPI_BF16> E{P, PN, nullptr, 0, nullptr, nullptr, 1.f}; run_gemm(C, H, DM, W + WO_IN, DM, T, PN, DM, E); }
        { pg8::Epi<pg8::EPI_BF16> E{VTA, T, nullptr, 0, nullptr, nullptr, 1.f}; run_gemm(C, W + WO_IN + (size_t)C_VA * DM, DM, H, DM, 256, T, DM, E, C.G / 2); }
        }
        GSYNC();
        {
            rownorm_rows(C, p, l, C.bid * 8 + C.wave, C.G * 8);
            for (int rep_ = 0; rep_ < DBG_REP_C; ++rep_) {
#if DBG_NAIVE & 1
            naive_swa(C, p, l);
#else
#ifdef SWA_V1
            for (int u = C.bid; u < 2048; u += C.G) attn_unit<true>(C, p, l, u);
#else
            for (int rs_ = 0; rs_ < DBG_REP_S; ++rs_) for (int u = C.bid; u < 256; u += C.G) swa_unit(C, p, l, u);
#endif
#endif
#if DBG_NAIVE & 2
            naive_conv(C, p, l);
#else
            for (int u = C.bid; u < T / 32; u += C.G) conv_unit(C, p, l, u);
#endif
            }
        }
        GSYNC();
        for (int rep_ = 0; rep_ < DBG_REP_G; ++rep_) {
        { pg8::Epi<pg8::EPI_BF16> E{QM, 768, nullptr, 0, nullptr, nullptr, 1.f}; run_gemm(C, P + C_CQ, PN, W + WO_Q, 256, T, 768, 256, E); }
        { pg8::Epi<pg8::EPI_BF16> E{KM, 512, nullptr, 0, nullptr, nullptr, 1.f}; run_gemm(C, P + C_CKV, PN, W + WO_K, 256, T, 512, 256, E); }
        { pg8::Epi<pg8::EPI_BF16> E{VTM, T, nullptr, 0, nullptr, nullptr, 1.f}; run_gemm(C, W + WO_V, 256, P + C_CKV, PN, 512, T, 256, E); }
        }
        GSYNC();
#if DBG_NAIVE & 4
        naive_mla(C, p, l);
#else
#ifdef MLA_V1
        for (int rep = 0; rep < DBG_REP_E; ++rep) for (int u = C.bid; u < 2048; u += C.G) attn_unit<false>(C, p, l, u);
#else
        for (int rep_ = 0; rep_ < DBG_REP_E; ++rep_) for (int u = C.bid; u < 1024; u += C.G) mla_unit(C, p, u);
#endif
#endif
        GSYNC();
#ifndef DBG_REP_E
#define DBG_REP_E 1
#endif
#ifndef DBG_REP_G
#define DBG_REP_G 1
#endif
#ifndef DBG_REP_C
#define DBG_REP_C 1
#endif
#ifndef DBG_SKIP
#define DBG_SKIP 0
#endif
#ifndef DBG_DBL
#define DBG_DBL 0
#endif
        for (int rep_ = 0; rep_ < DBG_REP_G; ++rep_) { int firstn = 1;
        for (int n = 0; n < 3; ++n) {
            if ((DBG_SKIP >> n) & 1) continue;
            { pg8::Epi<pg8::EPI_SIG> E{GS, DM, nullptr, 0, nullptr, nullptr, 1.f}; run_gemm(C, H, DM, W + WO_G + (size_t)n * DM * DM, DM, T, DM, DM, E); }
#ifdef DBG_FSYNC
            GSYNC();
#endif
            { pg8::Epi<pg8::EPI_GATEMUL> E{MG, DM, GS, firstn, nullptr, nullptr, ((DBG_DBL >> n) & 1) ? 2.f : 1.f}; run_gemm(C, Y + (size_t)n * T * 512, 512, W + WO_B + (size_t)n * DM * 512, 512, T, DM, 512, E); }
            firstn = 0;
        } }
        GSYNC();
        { pg8::Epi<pg8::EPI_RES> E{nullptr, DM, nullptr, 0, xcur, p.out, 1.f}; run_gemm(C, MG, DM, W + WO_O, DM, T, DM, DM, E); }
        GSYNC();
        for (int rep_ = 0; rep_ < DBG_REP_A; ++rep_) phase_norm(C, p.out, p.g_mlp + l * DM, H);
        GSYNC();
        for (int rep_ = 0; rep_ < DBG_REP_G; ++rep_)
        { pg8::Epi<pg8::EPI_RELU2> E{HID, DFF, nullptr, 0, nullptr, nullptr, 1.f}; run_gemm(C, H, DM, W + WO_U, DM, T, DFF, DM, E); }
        GSYNC();
        { pg8::Epi<pg8::EPI_RES> E{nullptr, DM, nullptr, 0, p.out, p.out, 1.f}; run_gemm(C, HID, DFF, W + WO_D, DFF, T, DM, DFF, E); }
        GSYNC();
    }
    phase_final_norm(C, p.g_final, p.out);
}

extern "C" void kernel_launch(void* const* d_in, const int* in_sizes, int n_in, void* d_out, int out_size, void* d_ws, size_t ws_size, hipStream_t stream) {
    static int grid = 0;
    if (grid == 0) {
        int dev = 0, cus = 0, per_cu = 0;
        hipGetDevice(&dev);
        hipDeviceGetAttribute(&cus, hipDeviceAttributeMultiprocessorCount, dev);
        hipFuncSetAttribute((const void*)mega_fwd, hipFuncAttributeMaxDynamicSharedMemorySize, LDS_BYTES);
        hipOccupancyMaxActiveBlocksPerMultiprocessor(&per_cu, (const void*)mega_fwd, 512, LDS_BYTES);
        if (per_cu < 1) per_cu = 1;
        grid = cus * per_cu;
        if (ws_size < WS_END) fprintf(stderr, "kernel_launch: workspace too small: %zu < %zu\n", ws_size, (size_t)WS_END);
    }
    Params p{};
    p.x = (const float*)d_in[0]; p.pos = (const int*)d_in[1]; p.rel_bias = (const float*)d_in[2]; p.g_final = (const float*)d_in[3]; p.g_mix = (const float*)d_in[4];
    p.w_in = (const float*)d_in[5]; p.sinks = (const float*)d_in[6]; p.g_qn = (const float*)d_in[7]; p.w_qup = (const float*)d_in[8]; p.g_kvn = (const float*)d_in[9];
    p.w_kvup = (const float*)d_in[10]; p.w_dw = (const float*)d_in[11]; p.b_dw = (const float*)d_in[12]; p.g_cln = (const float*)d_in[13]; p.b_cln = (const float*)d_in[14];
    p.w_branch = (const float*)d_in[15]; p.w_out = (const float*)d_in[16]; p.g_mlp = (const float*)d_in[17]; p.w_up = (const float*)d_in[18]; p.w_down = (const float*)d_in[19];
    p.out = (float*)d_out; p.ws = (unsigned char*)d_ws;
    hipMemsetAsync(d_ws, 0, XCD_BAR_WORDS * 4, stream);
    void* args[] = {&p};
    hipError_t e = hipLaunchCooperativeKernel((const void*)mega_fwd, dim3(grid), dim3(512), args, LDS_BYTES, stream);
    if (e != hipSuccess) fprintf(stderr, "cooperative launch failed: %s (grid %d)\n", hipGetErrorString(e), grid);
}
```

```cpp
#include <hip/hip_runtime.h>
#include <hip/hip_cooperative_groups.h>
#include <cstdio>
#include <cstdint>
namespace cg = cooperative_groups;

#ifndef DBG_REP_E
#define DBG_REP_E 1
#endif
#ifndef DBG_REP_G
#define DBG_REP_G 1
#endif
#ifndef DBG_REP_C
#define DBG_REP_C 1
#endif
#ifndef DBG_REP_A
#define DBG_REP_A 1
#endif
#ifndef DBG_XSYNC
#define DBG_XSYNC 0
#endif
#ifndef DBG_REP_S
#define DBG_REP_S 1
#endif
namespace pg8 {
#define PG8_LAS __attribute__((address_space(3)))
typedef unsigned short bf16_t;
typedef short bf16x8 __attribute__((ext_vector_type(8)));
typedef float f32x4 __attribute__((ext_vector_type(4)));
typedef unsigned u32x4 __attribute__((ext_vector_type(4)));
constexpr int BM = 256, BK = 64, HALF = 128, HTB = HALF * BK * 2  , STAGE_BYTES = 8 * HTB, NXCD = 8, WGM = 8;

__host__ __device__ __forceinline__ int lds_byte(int r, int c) { const int st = (r >> 4) * 2 + (c >> 5), rr = r & 15, cc = c & 31, ob = rr * 64 + cc * 2; return st * 1024 + (ob ^ (((ob >> 9) & 1) << 5)); }
__host__ __device__ __forceinline__ void stage_rc(int b, int& R, int& C) { const int st = b / 1024, sb = b % 1024, swz = sb ^ (((sb >> 9) & 1) << 5); R = (st >> 1) * 16 + swz / 64; C = (st & 1) * 32 + (swz % 64) / 2; }
__host__ __device__ __forceinline__ int perm32(int rho) { const int n = rho >> 4, i = rho & 15; return 8 * (i >> 2) + 4 * n + (i & 3); }

struct Unit { int pm, pn; };
struct Gemm { const bf16_t* A; const bf16_t* Bt; int lda, ldb, M, N, K; };

struct StaticOrder {
    int nM, nN, nwg, G, c;
    __host__ __device__ void init(int M, int N, int G_, int c_) { nM = M / BM; nN = N / BM; nwg = nM * nN; G = G_; c = c_; }
    __host__ __device__ bool next(int i, Unit& u) const {
        const long L = (long)i * G + c; if (L >= nwg) return false;
        int wgid = (int)L; { const int q = nwg / NXCD, r = nwg % NXCD, xcd = wgid % NXCD, off = wgid / NXCD; wgid = (xcd < r ? xcd * (q + 1) : r * (q + 1) + (xcd - r) * q) + off; }
        const int nig = WGM * nN, gid = wgid / nig, fm = gid * WGM, gsz = (nM - fm) < WGM ? (nM - fm) : WGM;
        u.pm = fm + ((wgid % nig) % gsz); u.pn = (wgid % nig) / gsz; return true;
    }
    __device__ __forceinline__ void a_ready(const Unit&) const {}
    __device__ __forceinline__ void done(const Unit&) const {}
};

__device__ __forceinline__ unsigned cvt_pk_bf16(float lo, float hi) { unsigned r; asm volatile("v_cvt_pk_bf16_f32 %0, %1, %2" : "=v"(r) : "v"(lo), "v"(hi)); return r; }

template <class Epi, class Sched, bool ALIGN_EPI = false, bool SP2 = false>
__device__ __forceinline__ void gemm_phase(PG8_LAS unsigned char* lds, const Gemm g, const Sched& S, const Epi& E) {
    int tid_ = threadIdx.x; asm volatile("" : "+v"(tid_));
    const int tid = tid_, wid = __builtin_amdgcn_readfirstlane(tid >> 6), lane = tid & 63, wr = wid >> 2, wc = wid & 3, fr = lane & 15, fq = lane >> 4;
    const int K = g.K, nt = K / BK;
    unsigned voffA[2], voffB[2];
#pragma unroll
    for (int i = 0; i < 2; ++i) { int R, C; stage_rc(tid * 16 + i * 8192, R, C); const int Rb = Epi::PERM ? ((R & ~31) + perm32(R & 31)) : R;
        voffA[i] = (unsigned)(R * g.lda + C) * 2u; voffB[i] = (unsigned)(Rb * g.ldb + C) * 2u; }
    const size_t kstep = (size_t)(BK * 2);
    const size_t hstepA = (size_t)HALF * g.lda * 2, hstepB = (size_t)HALF * g.ldb * 2;
    const size_t tstepA = 2 * hstepA, tstepB = 2 * hstepB;
    const unsigned ldsw = (unsigned)wid * 1024u;
    const int aoff = lds_byte(wr * 64 + fr, fq * 8), boff = lds_byte(wc * 32 + fr, fq * 8);
#define PG8_SA(b, h) (((b) * 2 + (h)) * HTB)
#define PG8_SB(b, h) ((4 + (b) * 2 + (h)) * HTB)
#define PG8_STAGE(bufoff, gbase, voff) do { _Pragma("unroll") for (int _i = 0; _i < 2; ++_i) \
        __builtin_amdgcn_global_load_lds((const unsigned*)((const char*)(gbase) + (voff)[_i]), (PG8_LAS unsigned*)(lds + (bufoff) + ldsw + _i * 8192), 16, 0, 0); } while (0)
#define PG8_LDA(dst, b, h) do { _Pragma("unroll") for (int m = 0; m < 4; ++m) _Pragma("unroll") for (int k = 0; k < 2; ++k) dst[m][k] = *(const PG8_LAS bf16x8*)(lds + PG8_SA(b, h) + aoff + m * 2048 + k * 1024); } while (0)
#define PG8_LDB(dst, b, h) do { _Pragma("unroll") for (int n = 0; n < 2; ++n) _Pragma("unroll") for (int k = 0; k < 2; ++k) dst[n][k] = *(const PG8_LAS bf16x8*)(lds + PG8_SB(b, h) + boff + n * 2048 + k * 1024); } while (0)
#define PG8_MMA(ai, bj, At, Bt) do { __builtin_amdgcn_s_setprio(1); _Pragma("unroll") for (int m = 0; m < 4; ++m) _Pragma("unroll") for (int n = 0; n < 2; ++n) _Pragma("unroll") for (int k = 0; k < 2; ++k) \
        acc[ai][bj][m][n] = __builtin_amdgcn_mfma_f32_16x16x32_bf16(Bt[n][k], At[m][k], acc[ai][bj][m][n], 0, 0, 0); __builtin_amdgcn_s_setprio(0); } while (0)
#define PG8_WAIT_V(n) asm volatile("s_waitcnt vmcnt(" #n ")" ::: "memory")
#define PG8_WAIT_L(n) asm volatile("s_waitcnt lgkmcnt(" #n ")" ::: "memory")
#define PG8_BAR __builtin_amdgcn_s_barrier()
#define PG8_SCHED __builtin_amdgcn_sched_barrier(0)
    Unit cur, nxt; int ui = 0;
    if (!S.next(0, cur)) return;
    f32x4 acc[2][2][4][2];
#pragma unroll
    for (int a = 0; a < 2; ++a)
#pragma unroll
        for (int b = 0; b < 2; ++b)
#pragma unroll
            for (int m = 0; m < 4; ++m)
#pragma unroll
                for (int n = 0; n < 2; ++n) acc[a][b][m][n] = (f32x4){0.f, 0.f, 0.f, 0.f};
    bf16x8 At[4][2], B0[2][2], B1[2][2];
    const char* cA = (const char*)g.A + (size_t)cur.pm * tstepA; const char* cB = (const char*)g.Bt + (size_t)cur.pn * tstepB;
    S.a_ready(cur);
    if constexpr (SP2) {
        PG8_STAGE(PG8_SB(0, 0), cB, voffB); PG8_STAGE(PG8_SB(0, 1), cB + hstepB, voffB); PG8_STAGE(PG8_SA(0, 0), cA, voffA); PG8_STAGE(PG8_SA(0, 1), cA + hstepA, voffA);
        if (wr == 1) PG8_BAR;
        PG8_WAIT_V(2); PG8_BAR;
        PG8_STAGE(PG8_SB(1, 0), cB + kstep, voffB); PG8_STAGE(PG8_SA(1, 0), cA + kstep, voffA); PG8_STAGE(PG8_SB(1, 1), cB + hstepB + kstep, voffB);
        PG8_WAIT_V(6); PG8_BAR;
    } else {
        PG8_STAGE(PG8_SB(0, 0), cB, voffB); PG8_STAGE(PG8_SA(0, 0), cA, voffA); PG8_STAGE(PG8_SB(0, 1), cB + hstepB, voffB); PG8_STAGE(PG8_SA(0, 1), cA + hstepA, voffA);
        if (wr == 1) PG8_BAR;
        PG8_WAIT_V(4); PG8_BAR;
        PG8_STAGE(PG8_SB(1, 0), cB + kstep, voffB); PG8_STAGE(PG8_SA(1, 0), cA + kstep, voffA); PG8_STAGE(PG8_SB(1, 1), cB + hstepB + kstep, voffB);
        PG8_WAIT_V(6); PG8_BAR;
    }
    for (;;) {
        const bool has_next = S.next(ui + 1, nxt);
        const char* nA = has_next ? (const char*)g.A + (size_t)nxt.pm * tstepA : cA; const char* nB = has_next ? (const char*)g.Bt + (size_t)nxt.pn * tstepB : cB;
        for (int t = 0; t < nt; t += 2) {
            const bool last = (t == nt - 2);
            const char* a1 = cA + (size_t)(t + 1) * kstep;
            const char* a2 = last ? nA : cA + (size_t)(t + 2) * kstep; const char* b2 = last ? nB : cB + (size_t)(t + 2) * kstep;
            const char* a3 = a2 + kstep; const char* b3 = b2 + kstep;
            if (last && has_next) S.a_ready(nxt);
            if constexpr (SP2) {
            PG8_LDB(B0, 0, 0); PG8_LDB(B1, 0, 1); PG8_SCHED; PG8_LDA(At, 0, 0); PG8_STAGE(PG8_SA(1, 1), a1 + hstepA, voffA);
            PG8_WAIT_V(8); PG8_WAIT_L(0); PG8_BAR; PG8_MMA(0, 0, At, B0); PG8_MMA(0, 1, At, B1); PG8_BAR; PG8_SCHED;
            PG8_LDA(At, 0, 1); PG8_STAGE(PG8_SB(0, 0), b2, voffB); PG8_STAGE(PG8_SB(0, 1), b2 + hstepB, voffB); PG8_STAGE(PG8_SA(0, 0), a2, voffA);
            PG8_WAIT_V(8); PG8_WAIT_L(0); PG8_BAR; PG8_MMA(1, 0, At, B0); PG8_MMA(1, 1, At, B1); PG8_BAR; PG8_SCHED;
            PG8_LDB(B0, 1, 0); PG8_LDB(B1, 1, 1); PG8_SCHED; PG8_LDA(At, 1, 0); PG8_STAGE(PG8_SA(0, 1), a2 + hstepA, voffA);
            PG8_WAIT_V(8); PG8_WAIT_L(0); PG8_BAR; PG8_MMA(0, 0, At, B0); PG8_MMA(0, 1, At, B1); PG8_BAR; PG8_SCHED;
            PG8_LDA(At, 1, 1); PG8_STAGE(PG8_SB(1, 0), b3, voffB); PG8_STAGE(PG8_SB(1, 1), b3 + hstepB, voffB); PG8_STAGE(PG8_SA(1, 0), a3, voffA);
            PG8_WAIT_V(8); PG8_WAIT_L(0); PG8_BAR; PG8_MMA(1, 0, At, B0); PG8_MMA(1, 1, At, B1); PG8_BAR; PG8_SCHED;
            } else {
            PG8_LDB(B0, 0, 0); PG8_SCHED; PG8_LDA(At, 0, 0); PG8_STAGE(PG8_SA(1, 1), a1 + hstepA, voffA);
            PG8_WAIT_L(8); PG8_BAR; PG8_WAIT_L(0); PG8_MMA(0, 0, At, B0); PG8_BAR; PG8_SCHED;
            PG8_LDB(B1, 0, 1); PG8_STAGE(PG8_SB(0, 0), b2, voffB);
            PG8_BAR; PG8_WAIT_L(0); PG8_MMA(0, 1, At, B1); PG8_BAR;
            PG8_LDA(At, 0, 1); PG8_STAGE(PG8_SA(0, 0), a2, voffA);
            PG8_BAR; PG8_WAIT_L(0); PG8_MMA(1, 0, At, B0); PG8_BAR; PG8_SCHED;
            PG8_STAGE(PG8_SB(0, 1), b2 + hstepB, voffB);
            PG8_WAIT_V(6); PG8_BAR; PG8_MMA(1, 1, At, B1); PG8_BAR;
            PG8_LDB(B0, 1, 0); PG8_SCHED; PG8_LDA(At, 1, 0); PG8_STAGE(PG8_SA(0, 1), a2 + hstepA, voffA);
            PG8_WAIT_L(8); PG8_BAR; PG8_WAIT_L(0); PG8_MMA(0, 0, At, B0); PG8_BAR; PG8_SCHED;
            PG8_LDB(B1, 1, 1); PG8_STAGE(PG8_SB(1, 0), b3, voffB);
            PG8_BAR; PG8_WAIT_L(0); PG8_MMA(0, 1, At, B1); PG8_BAR;
            PG8_LDA(At, 1, 1); PG8_STAGE(PG8_SA(1, 0), a3, voffA);
            PG8_BAR; PG8_WAIT_L(0); PG8_MMA(1, 0, At, B0); PG8_BAR; PG8_SCHED;
            PG8_STAGE(PG8_SB(1, 1), b3 + hstepB, voffB);
            PG8_WAIT_V(6); PG8_BAR; PG8_MMA(1, 1, At, B1); PG8_BAR;
            }
        }
        if constexpr (ALIGN_EPI) { if (wr == 0) PG8_BAR; }
        if constexpr (!Epi::AFTER_DRAIN) { E(acc, cur, wr, wc, fr, fq); S.done(cur); }
        if (!has_next) break;
#pragma unroll
        for (int a = 0; a < 2; ++a)
#pragma unroll
            for (int b = 0; b < 2; ++b)
#pragma unroll
                for (int m = 0; m < 4; ++m)
#pragma unroll
                    for (int n = 0; n < 2; ++n) acc[a][b][m][n] = (f32x4){0.f, 0.f, 0.f, 0.f};
        cur = nxt; cA = nA; cB = nB; ++ui;
        if constexpr (ALIGN_EPI) { if (wr == 1) PG8_BAR; }
    }
    PG8_WAIT_V(0);
    if constexpr (!ALIGN_EPI) { if (wr == 0) PG8_BAR; }
    PG8_BAR;
    if constexpr (Epi::AFTER_DRAIN) { E.fused(acc, cur, wr, wc, fr, fq, lds, wid, lane); S.done(cur); }
#undef PG8_SA
#undef PG8_SB
#undef PG8_STAGE
#undef PG8_LDA
#undef PG8_LDB
#undef PG8_MMA
#undef PG8_WAIT_V
#undef PG8_WAIT_L
#undef PG8_BAR
#undef PG8_SCHED
}
}

constexpr int BATCH = 8, SEQ = 4096, DM = 1024, DEPTH = 4, T = BATCH * SEQ;
constexpr int INC = 5280, PN = 2304, DFF = 4096;
constexpr int C_QA = 0, C_KA = 512, C_VA = 640, C_UB = 768, C_CQ = 1792, C_CKV = 2048, C_KPE = 2176, C_GATE = 2208;
constexpr float EPS = 1e-6f, LOG2E = 1.4426950408889634f;
constexpr size_t MiB = 1u << 20;
constexpr size_t WS_ROPE = 1 * MiB;
constexpr size_t WS_BT = 5 * MiB;
constexpr size_t WS_W = 8 * MiB;
constexpr size_t WS_H = 41 * MiB;
constexpr size_t WS_P = 105 * MiB;
constexpr size_t WS_Y = 249 * MiB;
constexpr size_t WS_QM = 345 * MiB;
constexpr size_t WS_KM = 393 * MiB;
constexpr size_t WS_VTM = 425 * MiB;
constexpr size_t WS_VTA = 457 * MiB;
constexpr size_t WS_END = 473 * MiB;
constexpr size_t WS_MG = WS_QM;
constexpr size_t WS_GS = WS_P;
constexpr size_t WS_HID = WS_P;
constexpr size_t WO_IN = 0;
constexpr size_t WO_G = WO_IN + (size_t)2304 * 1024;
constexpr size_t WO_Q = WO_G + (size_t)3072 * 1024;
constexpr size_t WO_K = WO_Q + (size_t)768 * 256;
constexpr size_t WO_V = WO_K + (size_t)512 * 256;
constexpr size_t WO_B = WO_V + (size_t)512 * 256;
constexpr size_t WO_O = WO_B + (size_t)3 * 1024 * 512;
constexpr size_t WO_U = WO_O + (size_t)1024 * 1024;
constexpr size_t WO_D = WO_U + (size_t)4096 * 1024;
constexpr size_t WO_END = WO_D + (size_t)1024 * 4096;
static_assert(WO_END * 2 <= 33 * MiB, "weights fit");

constexpr int RING_BYTES = 131072, LDS_BYTES = 135168;
#define LAS __attribute__((address_space(3)))
typedef unsigned short bf16;
typedef unsigned v4u __attribute__((ext_vector_type(4)));
typedef unsigned v2u __attribute__((ext_vector_type(2)));
typedef float f32x4 __attribute__((ext_vector_type(4)));
typedef float f32x2 __attribute__((ext_vector_type(2)));
typedef short bf16x8 __attribute__((ext_vector_type(8)));

__device__ __forceinline__ unsigned f2bf(float f) { unsigned u = __builtin_bit_cast(unsigned, f); return (u + 0x7fffu + ((u >> 16) & 1u)) >> 16; }
__device__ __forceinline__ unsigned pk2(float lo, float hi) { return f2bf(lo) | (f2bf(hi) << 16); }
typedef float f32x2q __attribute__((ext_vector_type(2))); typedef __bf16 bf16x2q __attribute__((ext_vector_type(2)));
__device__ __forceinline__ unsigned pkhw(float lo, float hi) { f32x2q v = {lo, hi}; bf16x2q b = __builtin_convertvector(v, bf16x2q); return __builtin_bit_cast(unsigned, b); }
__device__ __forceinline__ float rowmax4(float v) {
    auto r16 = __builtin_amdgcn_permlane16_swap(__float_as_uint(v), __float_as_uint(v), false, false);
    v = fmaxf(__uint_as_float(r16[0]), __uint_as_float(r16[1]));
    auto r32 = __builtin_amdgcn_permlane32_swap(__float_as_uint(v), __float_as_uint(v), false, false);
    return fmaxf(__uint_as_float(r32[0]), __uint_as_float(r32[1]));
}
__device__ __forceinline__ float bf2f(unsigned short h) { return __builtin_bit_cast(float, (unsigned)h << 16); }
__device__ __forceinline__ float bflo(unsigned w) { return __builtin_bit_cast(float, w << 16); }
__device__ __forceinline__ float bfhi(unsigned w) { return __builtin_bit_cast(float, w & 0xffff0000u); }
__device__ __forceinline__ float wave_sum(float v) {
#pragma unroll
    for (int o = 1; o < 64; o <<= 1) v += __shfl_xor(v, o);
    return v;
}
__device__ __forceinline__ float sigmoidf_(float x) { return __builtin_amdgcn_rcpf(1.0f + __builtin_amdgcn_exp2f(-x * LOG2E)); }

struct Params {
    const float* x; const int* pos; const float* rel_bias; const float* g_final; const float* g_mix; const float* w_in; const float* sinks;
    const float* g_qn; const float* w_qup; const float* g_kvn; const float* w_kvup; const float* w_dw; const float* b_dw; const float* g_cln; const float* b_cln;
    const float* w_branch; const float* w_out; const float* g_mlp; const float* w_up; const float* w_down;
    float* out; unsigned char* ws;
};

namespace pg8 {
enum { EPI_BF16 = 0, EPI_SIG = 1, EPI_GATEMUL = 2, EPI_RES = 3, EPI_RELU2 = 4 };
typedef float f32x2p __attribute__((ext_vector_type(2))); typedef __bf16 bf16x2p __attribute__((ext_vector_type(2)));
__device__ __forceinline__ unsigned pkbf(float lo, float hi) { f32x2p v = {lo, hi}; bf16x2p b = __builtin_convertvector(v, bf16x2p); return __builtin_bit_cast(unsigned, b); }
template <int MODE> struct Epi {
    static constexpr bool PERM = true, AFTER_DRAIN = false;
    bf16_t* O; int ldc; const bf16_t* G; int first; const float* base; float* outf; float bscale;
    __device__ __forceinline__ void operator()(const f32x4 (&acc)[2][2][4][2], const Unit& u, int wr, int wc, int fr, int fq) const {
        const int row0 = u.pm * BM + wr * 64 + fr; const int col0 = u.pn * BM + wc * 32 + 8 * fq;
#pragma unroll
        for (int ai = 0; ai < 2; ++ai)
#pragma unroll
            for (int m = 0; m < 4; ++m) {
                const size_t roff = (size_t)(row0 + ai * HALF + m * 16) * (size_t)ldc + col0;
#pragma unroll
                for (int bj = 0; bj < 2; ++bj) {
                    f32x4 v0 = acc[ai][bj][m][0], v1 = acc[ai][bj][m][1];
                    const size_t off = roff + bj * HALF;
                    if constexpr (MODE == EPI_RES) {
                        const f32x4 b0 = *(const f32x4*)(base + off), b1 = *(const f32x4*)(base + off + 4);
                        *(f32x4*)(outf + off) = b0 + v0; *(f32x4*)(outf + off + 4) = b1 + v1;
                    } else {
                        if constexpr (MODE == EPI_SIG) {
#pragma unroll
                            for (int e = 0; e < 4; ++e) { v0[e] = sigmoidf_(v0[e]); v1[e] = sigmoidf_(v1[e]); }
                        }
                        if constexpr (MODE == EPI_RELU2) {
#pragma unroll
                            for (int e = 0; e < 4; ++e) { float a = fmaxf(v0[e], 0.f), b = fmaxf(v1[e], 0.f); v0[e] = a * a; v1[e] = b * b; }
                        }
                        if constexpr (MODE == EPI_GATEMUL) {
                            const u32x4 gw = *(const u32x4*)(G + off); v0 = v0 * bscale; v1 = v1 * bscale;
                            v0[0] *= bflo(gw.x); v0[1] *= bfhi(gw.x); v0[2] *= bflo(gw.y); v0[3] *= bfhi(gw.y);
                            v1[0] *= bflo(gw.z); v1[1] *= bfhi(gw.z); v1[2] *= bflo(gw.w); v1[3] *= bfhi(gw.w);
                            if (!first) {
                                const u32x4 ow = *(const u32x4*)(O + off);
                                v0[0] += bflo(ow.x); v0[1] += bfhi(ow.x); v0[2] += bflo(ow.y); v0[3] += bfhi(ow.y);
                                v1[0] += bflo(ow.z); v1[1] += bfhi(ow.z); v1[2] += bflo(ow.w); v1[3] += bfhi(ow.w);
                            }
                        }
                        u32x4 w; w.x = pkbf(v0[0], v0[1]); w.y = pkbf(v0[2], v0[3]); w.z = pkbf(v1[0], v1[1]); w.w = pkbf(v1[2], v1[3]);
                        *(u32x4*)(O + off) = w;
                    }
                }
            }
    }
};
}

struct Ctx { LAS unsigned char* lds; int tid, lane, wave, G, bid; };

__device__ __forceinline__ Ctx relaunder(const Ctx& C0) {
    Ctx C = C0; int t_ = C0.tid; asm volatile("" : "+v"(t_)); C.tid = t_; C.lane = t_ & 63; C.wave = __builtin_amdgcn_readfirstlane(t_ >> 6); return C;
}

__device__ __forceinline__ void tr_item(const float* W, int ldw, int c0, bf16* WT, int ldk, int r0, int nblk, int item, LAS float* scr, int lane) {
    const int kb = item / nblk, nb = item % nblk, k0 = 64 * kb, n0 = 32 * nb;
#pragma unroll 8
    for (int i = 0; i < 32; ++i) { const int kk = 2 * i + (lane >> 5); scr[kk * 33 + (lane & 31)] = W[(size_t)(k0 + kk) * ldw + c0 + n0 + (lane & 31)]; }
    asm volatile("s_waitcnt lgkmcnt(0)" ::: "memory");
    const int c = lane & 7;
#pragma unroll
    for (int j = 0; j < 4; ++j) { const int n = (lane >> 3) + 8 * j; const LAS float* s = scr + (8 * c) * 33 + n;
        v4u o; o.x = pk2(s[0 * 33], s[1 * 33]); o.y = pk2(s[2 * 33], s[3 * 33]); o.z = pk2(s[4 * 33], s[5 * 33]); o.w = pk2(s[6 * 33], s[7 * 33]);
        *(v4u*)(WT + (size_t)(r0 + n0 + n) * ldk + k0 + 8 * c) = o; }
    asm volatile("s_waitcnt lgkmcnt(0)" ::: "memory");
}

__device__ __forceinline__ void phase_convert_weights(const Ctx& C0, const Params& p, int l) {
    const Ctx C = relaunder(C0);
    LAS float* scr = (LAS float*)(C.lds + C.wave * 16384);
    bf16* W = (bf16*)(p.ws + WS_W);
    const int gw = C.bid * 8 + C.wave, NGW = C.G * 8;
    const float* w_in = p.w_in + (size_t)l * 1024 * INC;
    const float* w_qup = p.w_qup + (size_t)l * 256 * 768;
    const float* w_kvup = p.w_kvup + (size_t)l * 128 * 1024;
    const float* w_br = p.w_branch + (size_t)l * 3 * 512 * 1024;
    const float* w_out = p.w_out + (size_t)l * 1024 * 1024;
    const float* w_up = p.w_up + (size_t)l * 1024 * 4096;
    const float* w_down = p.w_down + (size_t)l * 4096 * 1024;
    constexpr int I_IN = 16 * 69, I_G = 16 * 96, I_Q = 4 * 24, I_KV = 16 * 4, I_B = 3 * 8 * 32, I_O = 16 * 32, I_U = 16 * 128, I_D = 64 * 32;
    constexpr int NITEMS = I_IN + I_G + I_Q + I_KV + I_B + I_O + I_U + I_D;
    for (int it = gw; it < NITEMS; it += NGW) {
        int r = it;
        if (r < I_IN) { tr_item(w_in, INC, 0, W + WO_IN, 1024, 0, 69, r, scr, C.lane); continue; } r -= I_IN;
        if (r < I_G) { tr_item(w_in, INC, C_GATE, W + WO_G, 1024, 0, 96, r, scr, C.lane); continue; } r -= I_G;
        if (r < I_Q) { tr_item(w_qup, 768, 0, W + WO_Q, 256, 0, 24, r, scr, C.lane); continue; } r -= I_Q;
        if (r < I_KV) { const int job = r >> 2, sub = r & 3, h = job >> 1, part = job & 1;
            tr_item(w_kvup, 1024, h * 128 + part * 64, W + (part ? WO_V : WO_K), 256, h * 64, 2, sub, scr, C.lane); continue; } r -= I_KV;
        if (r < I_B) { const int n = r / 256, s = r % 256; tr_item(w_br + (size_t)n * 512 * 1024, 1024, 0, W + WO_B + (size_t)n * 1024 * 512, 512, 0, 32, s, scr, C.lane); continue; } r -= I_B;
        if (r < I_O) { tr_item(w_out, 1024, 0, W + WO_O, 1024, 0, 32, r, scr, C.lane); continue; } r -= I_O;
        if (r < I_U) { tr_item(w_up, 4096, 0, W + WO_U, 1024, 0, 128, r, scr, C.lane); continue; } r -= I_U;
        tr_item(w_down, 1024, 0, W + WO_D, 4096, 0, 32, r, scr, C.lane);
    }
    const int gt = C.bid * 512 + C.tid, NGT = C.G * 512;
    for (int i = gt; i < 96 * 1024 / 8; i += NGT) *(v4u*)(W + WO_IN + (size_t)2208 * 1024 + (size_t)i * 8) = (v4u){0u, 0u, 0u, 0u};
    for (int i = gt; i < 1024 * 16; i += NGT) { const int row = i >> 4, c = i & 15; *(v4u*)(W + WO_K + (size_t)row * 256 + 128 + c * 8) = (v4u){0u, 0u, 0u, 0u}; }
}

__device__ __forceinline__ void phase_tables(const Ctx& C, const Params& p) {
    const int gt = C.bid * 512 + C.tid, NGT = C.G * 512;
    f32x2* cs = (f32x2*)(p.ws + WS_ROPE);
    for (int idx = gt; idx < T * 16; idx += NGT) {
        const int t = idx >> 4, i = idx & 15;
        const float freq = (float)exp(-9.210340371976184 * (double)i / 16.0);
        const float ang = (float)p.pos[t] * freq;
        double r = (double)ang * 0.15915494309189535; r -= rint(r);
        const double xx = r * 6.283185307179586, x2 = xx * xx;
        double s = 1.0 / 51090942171709440000.0, c = 1.0 / 1124000727777607680000.0;
        s = s * x2 - 1.0 / 121645100408832000.0;  c = c * -x2 + 1.0 / 2432902008176640000.0;
        s = s * x2 + 1.0 / 355687428096000.0;
        s = s * x2 - 1.0 / 1307674368000.0;
        s = s * x2 + 1.0 / 6227020800.0;
        s = s * x2 - 1.0 / 39916800.0;
        s = s * x2 + 1.0 / 362880.0;
        s = s * x2 - 1.0 / 5040.0;
        s = s * x2 + 1.0 / 120.0;
        s = s * x2 - 1.0 / 6.0;
        s = s * x2 + 1.0;
        s = s * xx;
        c = c * x2 - 1.0 / 6402373705728000.0;
        c = c * x2 + 1.0 / 20922789888000.0;
        c = c * x2 - 1.0 / 87178291200.0;
        c = c * x2 + 1.0 / 479001600.0;
        c = c * x2 - 1.0 / 3628800.0;
        c = c * x2 + 1.0 / 40320.0;
        c = c * x2 - 1.0 / 720.0;
        c = c * x2 + 1.0 / 24.0;
        c = c * x2 - 0.5;
        c = c * x2 + 1.0;
        cs[idx] = (f32x2){(float)c, (float)s};
    }
    float* bt = (float*)(p.ws + WS_BT);
    for (int idx = gt; idx < 129 * 8; idx += NGT) {
        const int n = idx >> 3, h = idx & 7; int bucket;
        if (n < 16) bucket = n;
        else { const float nf = (float)n; int large = 16 + (int)(logf(nf / 16.0f) / 2.0794415416798357f * 16.0f); bucket = large < 31 ? large : 31; }
        bt[idx] = p.rel_bias[bucket * 8 + h];
    }
}

__device__ __forceinline__ void phase_norm(const Ctx& C0, const float* xin, const float* g, bf16* hout) {
    const Ctx C = relaunder(C0);
    const int gw = C.bid * 8 + C.wave, NGW = C.G * 8;
    f32x4 gv[4];
#pragma unroll
    for (int j = 0; j < 4; ++j) gv[j] = *((const f32x4*)g + C.lane + 64 * j);
    for (int m = gw; m < T; m += 2 * NGW) {
        const int m2 = m + NGW; const bool has2 = m2 < T;
        const f32x4* xr = (const f32x4*)(xin + (size_t)m * DM) + C.lane; const f32x4* xr2 = (const f32x4*)(xin + (size_t)(has2 ? m2 : m) * DM) + C.lane;
        f32x4 v[4], u[4]; float s = 0.f, s2 = 0.f;
#pragma unroll
        for (int j = 0; j < 4; ++j) { v[j] = xr[64 * j]; u[j] = xr2[64 * j]; }
#pragma unroll
        for (int j = 0; j < 4; ++j) { s += (v[j].x * v[j].x + v[j].y * v[j].y) + (v[j].z * v[j].z + v[j].w * v[j].w); s2 += (u[j].x * u[j].x + u[j].y * u[j].y) + (u[j].z * u[j].z + u[j].w * u[j].w); }
        const float rstd = 1.0f / sqrtf(wave_sum(s) * (1.f / DM) + EPS), rstd2 = 1.0f / sqrtf(wave_sum(s2) * (1.f / DM) + EPS);
        v2u* o8 = (v2u*)(hout + (size_t)m * DM) + C.lane;
#pragma unroll
        for (int j = 0; j < 4; ++j) { v2u w; w.x = pk2(v[j].x * rstd * gv[j].x, v[j].y * rstd * gv[j].y); w.y = pk2(v[j].z * rstd * gv[j].z, v[j].w * rstd * gv[j].w); o8[64 * j] = w; }
        if (has2) { v2u* p8 = (v2u*)(hout + (size_t)m2 * DM) + C.lane;
#pragma unroll
            for (int j = 0; j < 4; ++j) { v2u w; w.x = pk2(u[j].x * rstd2 * gv[j].x, u[j].y * rstd2 * gv[j].y); w.y = pk2(u[j].z * rstd2 * gv[j].z, u[j].w * rstd2 * gv[j].w); p8[64 * j] = w; } }
    }
}
__device__ __forceinline__ void phase_final_norm(const Ctx& C, const float* g, float* x, float dbg_add = 0.f) {
    const int gw = C.bid * 8 + C.wave, NGW = C.G * 8;
    f32x4 gv[4];
#pragma unroll
    for (int j = 0; j < 4; ++j) gv[j] = *((const f32x4*)g + C.lane + 64 * j);
    for (int m = gw; m < T; m += NGW) {
        f32x4* xr = (f32x4*)(x + (size_t)m * DM) + C.lane;
        f32x4 v[4]; float s = 0.f;
#pragma unroll
        for (int j = 0; j < 4; ++j) { v[j] = xr[64 * j]; s += (v[j].x * v[j].x + v[j].y * v[j].y) + (v[j].z * v[j].z + v[j].w * v[j].w); }
        const float rstd = 1.0f / sqrtf(wave_sum(s) * (1.f / DM) + EPS);
#pragma unroll
        for (int j = 0; j < 4; ++j) xr[64 * j] = v[j] * rstd * gv[j] + dbg_add;
#ifdef DBG_ZERO
        { const int s_ = m & (SEQ - 1); if (DBG_ZERO) {
#pragma unroll
            for (int j = 0; j < 4; ++j) xr[64 * j] = (f32x4){0.f, 0.f, 0.f, 0.f}; } }
#endif
    }
}

__device__ __forceinline__ void rownorm_rows(const Ctx& C0, const Params& p, int l, int gw, int NGW) {
    const Ctx C = relaunder(C0);
    bf16* P = (bf16*)(p.ws + WS_P);
    const f32x2* cs = (const f32x2*)(p.ws + WS_ROPE);
    const float* gq = p.g_qn + l * 256; const float* gkv = p.g_kvn + l * 128;
    const f32x4 gqv = *((const f32x4*)gq + C.lane); const f32x2 gkvv = *((const f32x2*)gkv + C.lane);
    for (int m = gw; m < T; m += 2 * NGW) {
        const int mm[2] = {m, (m + NGW < T) ? m + NGW : m}; const int nrow = (m + NGW < T) ? 2 : 1;
        v2u cw[2]; unsigned kw[2]; float x1[2], x2[2]; f32x2 cc[2];
#pragma unroll
        for (int r = 0; r < 2; ++r) { const bf16* row = P + (size_t)mm[r] * PN; cw[r] = *((const v2u*)(row + C_CQ) + C.lane); kw[r] = *((const unsigned*)(row + C_CKV) + C.lane);
            x1[r] = bf2f(row[C_KPE + (C.lane & 15)]); x2[r] = bf2f(row[C_KPE + 16 + (C.lane & 15)]); cc[r] = cs[(size_t)mm[r] * 16 + (C.lane & 15)]; }
#pragma unroll
        for (int r = 0; r < 2; ++r) {
            if (r < nrow) {
            bf16* row = P + (size_t)mm[r] * PN;
            const float a0 = bflo(cw[r].x), a1 = bfhi(cw[r].x), a2 = bflo(cw[r].y), a3 = bfhi(cw[r].y);
            const float rq = 1.0f / sqrtf(wave_sum((a0 * a0 + a1 * a1) + (a2 * a2 + a3 * a3)) * (1.f / 256.f) + EPS);
            const float b0 = bflo(kw[r]), b1 = bfhi(kw[r]);
            const float rk = 1.0f / sqrtf(wave_sum(b0 * b0 + b1 * b1) * (1.f / 128.f) + EPS);
            v2u ow; ow.x = pk2(a0 * rq * gqv.x, a1 * rq * gqv.y); ow.y = pk2(a2 * rq * gqv.z, a3 * rq * gqv.w); *((v2u*)(row + C_CQ) + C.lane) = ow;
            *((unsigned*)(row + C_CKV) + C.lane) = pk2(b0 * rk * gkvv.x, b1 * rk * gkvv.y);
            if (C.lane < 16) {
                f32x2 c = cc[r];
#ifdef DBG_NOROPE
                c = (f32x2){1.f, 0.f};
#endif
                row[C_KPE + C.lane] = (bf16)f2bf(x1[r] * c.x - x2[r] * c.y);
                row[C_KPE + 16 + C.lane] = (bf16)f2bf(x2[r] * c.x + x1[r] * c.y);
            }
            }
        }
    }
}

template <bool SWA>
__device__ __forceinline__ void attn_unit(const Ctx& C, const Params& p, int l, int unit) {
    constexpr int NKK = SWA ? 2 : 3;
    const int lane = C.lane, fr = lane & 15, fq = lane >> 4;
    int b, h, qb;
    if constexpr (SWA) { b = unit >> 8; h = (unit >> 5) & 7; qb = unit & 31; }
    else {
        const int k = unit >> 8, i = unit & 255, g = i >> 6, bh = i & 63;
        qb = 31 - 4 * k - ((k & 1) ? (3 - g) : g); b = bh >> 3; h = bh & 7;
    }
    const int q0 = qb * 128 + C.wave * 16;
    const size_t tok0 = (size_t)b * SEQ;
    const size_t qrow = tok0 + q0 + fr;
    const bf16* P = (const bf16*)(p.ws + WS_P);
    bf16x8 qf[NKK];
    if constexpr (SWA) {
        const bf16* qp = P + qrow * PN + C_QA + h * 64 + fq * 8;
        qf[0] = *(const bf16x8*)qp; qf[1] = *(const bf16x8*)(qp + 32);
    } else {
        const bf16* qp = (const bf16*)(p.ws + WS_QM) + qrow * 768 + h * 96 + fq * 8;
        qf[0] = *(const bf16x8*)qp; qf[1] = *(const bf16x8*)(qp + 32);
        const v4u raw = *(const v4u*)(qp + 64);
        const f32x2* cs = (const f32x2*)(p.ws + WS_ROPE) + qrow * 16 + (fq & 1) * 8;
        float own[8] = {bflo(raw.x), bfhi(raw.x), bflo(raw.y), bfhi(raw.y), bflo(raw.z), bfhi(raw.z), bflo(raw.w), bfhi(raw.w)};
        float res[8];
#pragma unroll
        for (int e = 0; e < 8; ++e) { const float oth = __shfl_xor(own[e], 32); f32x2 c = cs[e];
#ifdef DBG_NOROPE
            c = (f32x2){1.f, 0.f};
#endif

            res[e] = (fq < 2) ? (own[e] * c.x - oth * c.y) : (own[e] * c.x + oth * c.y); }
        v4u rw; rw.x = pk2(res[0], res[1]); rw.y = pk2(res[2], res[3]); rw.z = pk2(res[4], res[5]); rw.w = pk2(res[6], res[7]);
        qf[2] = __builtin_bit_cast(bf16x8, rw);
    }
    const float scale = SWA ? 0.125f : 0.10206207261596577f;
    float sink2 = 0.f, m = -1e30f, lsum = 0.f;
    if constexpr (SWA) { sink2 = p.sinks[l * 8 + h] * LOG2E; m = sink2; }
    f32x4 o[4];
#pragma unroll
    for (int d = 0; d < 4; ++d) o[d] = (f32x4){0.f, 0.f, 0.f, 0.f};
    const int kt_lo = SWA ? ((q0 - 127 > 0 ? q0 - 127 : 0) >> 5) : 0, kt_hi = (q0 + 15) >> 5;
    const int qi = q0 + fr;
    int pq = 0; if constexpr (SWA) pq = p.pos[qrow];
    const float* bt = (const float*)(p.ws + WS_BT) + h;
    const bf16* Kb; int ldk; const bf16* Vt;
    if constexpr (SWA) { Kb = P + C_KA + (h >> 2) * 64; ldk = PN; Vt = (const bf16*)(p.ws + WS_VTA) + (size_t)((h >> 2) * 64) * T; }
    else { Kb = (const bf16*)(p.ws + WS_KM) + h * 64; ldk = 512; Vt = (const bf16*)(p.ws + WS_VTM) + (size_t)(h * 64) * T; }
    for (int kt = kt_lo; kt <= kt_hi; ++kt) {
        const int k0 = kt * 32;
        f32x4 s0 = (f32x4){0.f, 0.f, 0.f, 0.f}, s1 = (f32x4){0.f, 0.f, 0.f, 0.f};
        const size_t kra = tok0 + k0 + fr, krb = kra + 16;
#pragma unroll
        for (int kk = 0; kk < NKK; ++kk) {
            bf16x8 ka, kb;
            if (SWA || kk < 2) { ka = *(const bf16x8*)(Kb + kra * ldk + kk * 32 + fq * 8); kb = *(const bf16x8*)(Kb + krb * ldk + kk * 32 + fq * 8); }
            else { ka = *(const bf16x8*)(P + kra * PN + C_KPE + fq * 8); kb = *(const bf16x8*)(P + krb * PN + C_KPE + fq * 8); }
            s0 = __builtin_amdgcn_mfma_f32_16x16x32_bf16(ka, qf[kk], s0, 0, 0, 0);
            s1 = __builtin_amdgcn_mfma_f32_16x16x32_bf16(kb, qf[kk], s1, 0, 0, 0);
        }
        float v[8];
        int pka[4] = {0, 0, 0, 0}, pkb[4] = {0, 0, 0, 0};
        if constexpr (SWA) { const int4 t0 = *(const int4*)(p.pos + tok0 + k0 + fq * 4), t1 = *(const int4*)(p.pos + tok0 + k0 + 16 + fq * 4);
            pka[0] = t0.x; pka[1] = t0.y; pka[2] = t0.z; pka[3] = t0.w; pkb[0] = t1.x; pkb[1] = t1.y; pkb[2] = t1.z; pkb[3] = t1.w; }
#pragma unroll
        for (int j = 0; j < 4; ++j) {
            const int keya = k0 + fq * 4 + j, keyb = keya + 16;
            float sa = s0[j] * scale, sb = s1[j] * scale;
            bool oka = keya <= qi, okb = keyb <= qi;
            if constexpr (SWA) {
                int da = pq - pka[j]; da = da < 0 ? 0 : (da > 128 ? 128 : da);
                int db = pq - pkb[j]; db = db < 0 ? 0 : (db > 128 ? 128 : db);
#ifndef DBG_NOBIAS
                sa += bt[da * 8]; sb += bt[db * 8];
#endif
                oka = oka && (qi - keya < 128); okb = okb && (qi - keyb < 128);
            }
            v[j] = oka ? sa * LOG2E : -1e30f; v[4 + j] = okb ? sb * LOG2E : -1e30f;
        }
        float mx = fmaxf(fmaxf(fmaxf(v[0], v[1]), fmaxf(v[2], v[3])), fmaxf(fmaxf(v[4], v[5]), fmaxf(v[6], v[7])));
        mx = fmaxf(mx, __shfl_xor(mx, 16)); mx = fmaxf(mx, __shfl_xor(mx, 32));
        const float mn = fmaxf(m, mx), alpha = __builtin_amdgcn_exp2f(m - mn); m = mn;
        float ps = 0.f;
#pragma unroll
        for (int e = 0; e < 8; ++e) { v[e] = __builtin_amdgcn_exp2f(v[e] - mn); ps += v[e]; }
        lsum = lsum * alpha + ps;
#pragma unroll
        for (int d = 0; d < 4; ++d) o[d] = o[d] * alpha;
        v4u pw; pw.x = pk2(v[0], v[1]); pw.y = pk2(v[2], v[3]); pw.z = pk2(v[4], v[5]); pw.w = pk2(v[6], v[7]);
        const bf16x8 pf = __builtin_bit_cast(bf16x8, pw);
#pragma unroll
        for (int d = 0; d < 4; ++d) {
            const bf16* vp = Vt + (size_t)(d * 16 + fr) * T + tok0 + k0 + fq * 4;
            const v2u lo = *(const v2u*)vp, hi = *(const v2u*)(vp + 16);
            const v4u vw = (v4u){lo.x, lo.y, hi.x, hi.y};
            o[d] = __builtin_amdgcn_mfma_f32_16x16x32_bf16(__builtin_bit_cast(bf16x8, vw), pf, o[d], 0, 0, 0);
        }
    }
    lsum += __shfl_xor(lsum, 16); lsum += __shfl_xor(lsum, 32);
    if constexpr (SWA) lsum += __builtin_amdgcn_exp2f(sink2 - m);
    const float inv = 1.0f / lsum;
    bf16* Y = (bf16*)(p.ws + WS_Y) + (SWA ? (size_t)0 : (size_t)2 * T * 512) + qrow * 512 + h * 64 + fq * 4;
#pragma unroll
    for (int d = 0; d < 4; ++d) { v2u w; w.x = pk2(o[d][0] * inv, o[d][1] * inv); w.y = pk2(o[d][2] * inv, o[d][3] * inv); *(v2u*)(Y + d * 16) = w; }
}

__device__ __forceinline__ void conv_unit(const Ctx& C0, const Params& p, int l, int unit) {
    const Ctx C = relaunder(C0);
    LAS float* U = (LAS float*)C.lds;
    const int c = C.tid, t0 = unit * 32, s0 = t0 & (SEQ - 1);
    const bf16* P = (const bf16*)(p.ws + WS_P);
    { const int cg8 = (c & 63) * 8, rsub = c >> 6;
#pragma unroll
      for (int pass = 0; pass < 8; ++pass) {
        const int r = pass * 8 + rsub;
        if (r < 62) {
            const int s = s0 - 30 + r; f32x4 u0 = (f32x4){0.f, 0.f, 0.f, 0.f}, u1 = u0;
            if (s >= 0) { const bf16* row = P + (size_t)(t0 - 30 + r) * PN + C_UB + cg8; const v4u a = *(const v4u*)row, g = *(const v4u*)(row + 512);
                u0[0] = bflo(a.x) * sigmoidf_(bflo(g.x)); u0[1] = bfhi(a.x) * sigmoidf_(bfhi(g.x)); u0[2] = bflo(a.y) * sigmoidf_(bflo(g.y)); u0[3] = bfhi(a.y) * sigmoidf_(bfhi(g.y));
                u1[0] = bflo(a.z) * sigmoidf_(bflo(g.z)); u1[1] = bfhi(a.z) * sigmoidf_(bfhi(g.z)); u1[2] = bflo(a.w) * sigmoidf_(bflo(g.w)); u1[3] = bfhi(a.w) * sigmoidf_(bfhi(g.w)); }
            *(LAS f32x4*)(U + r * 512 + cg8) = u0; *(LAS f32x4*)(U + r * 512 + cg8 + 4) = u1;
        }
      }
    }
    __syncthreads();
    float w[31];
#pragma unroll
    for (int j = 0; j < 31; ++j) w[j] = p.w_dw[(size_t)l * 31 * 512 + j * 512 + c];
    const float bias = p.b_dw[l * 512 + c];
    for (int tb = 0; tb < 32; tb += 8) {
        float acc[8];
#pragma unroll
        for (int k = 0; k < 8; ++k) acc[k] = bias;
#pragma unroll
        for (int jj = 0; jj < 38; ++jj) {
            const float u = U[(tb + jj) * 512 + c];
#pragma unroll
            for (int k = 0; k < 8; ++k) { const int j = jj - k; if (j >= 0 && j < 31) acc[k] += w[j] * u; }
        }
#pragma unroll
        for (int k = 0; k < 8; ++k) U[(tb + k) * 512 + c] = acc[k];
    }
    __syncthreads();
    const float* gl = p.g_cln + l * 512; const float* bl = p.b_cln + l * 512;
    bf16* Y = (bf16*)(p.ws + WS_Y) + (size_t)1 * T * 512;
    for (int q = 0; q < 4; ++q) {
        const int tl = C.wave * 4 + q; float xv[8]; float s = 0.f;
#pragma unroll
        for (int i = 0; i < 8; ++i) { xv[i] = U[tl * 512 + C.lane + 64 * i]; s += xv[i]; }
        const float mean = wave_sum(s) * (1.f / 512.f); float s2 = 0.f;
#pragma unroll
        for (int i = 0; i < 8; ++i) { xv[i] -= mean; s2 += xv[i] * xv[i]; }
        const float rstd = 1.0f / sqrtf(wave_sum(s2) * (1.f / 512.f) + EPS);
#pragma unroll
        for (int i = 0; i < 8; ++i) { const int ch = C.lane + 64 * i; const float y = xv[i] * rstd * gl[ch] + bl[ch]; Y[(size_t)(t0 + tl) * 512 + ch] = (bf16)f2bf(y * sigmoidf_(y)); }
    }
    __syncthreads();
}

constexpr int AK_ROW = 208, AV_ROW = 144, AK_BYTES = 64 * AK_ROW, AV_BYTES = 64 * AV_ROW, ABUF = AK_BYTES + AV_BYTES;
__device__ __forceinline__ void mla_unit(const Ctx& C, const Params& p, int unit) {
    int tid_ = C.tid; asm volatile("" : "+v"(tid_));
    const int tid = tid_, lane = tid & 63, fr = lane & 15, fq = lane >> 4;
    int b, h, qb;
    { const int k = unit >> 8, i = unit & 255, g = i >> 6, bh = i & 63; qb = 15 - 4 * k - ((k & 1) ? (3 - g) : g); b = bh >> 3; h = bh & 7; }
    const int q0w = qb * 256 + C.wave * 32;
    const size_t tok0 = (size_t)b * SEQ;
    const bf16* P = (const bf16*)(p.ws + WS_P); const bf16* QM = (const bf16*)(p.ws + WS_QM); const bf16* KM = (const bf16*)(p.ws + WS_KM); const bf16* VTM = (const bf16*)(p.ws + WS_VTM);
    bf16x8 qf[2][3];
#pragma unroll
    for (int g = 0; g < 2; ++g) {
        const size_t qrow = tok0 + q0w + 16 * g + fr;
        const bf16* qp = QM + qrow * 768 + h * 96 + fq * 8;
        qf[g][0] = *(const bf16x8*)qp; qf[g][1] = *(const bf16x8*)(qp + 32);
        const v4u raw = *(const v4u*)(qp + 64);
        const f32x2* cs = (const f32x2*)(p.ws + WS_ROPE) + qrow * 16 + (fq & 1) * 8;
        const float own[8] = {bflo(raw.x), bfhi(raw.x), bflo(raw.y), bfhi(raw.y), bflo(raw.z), bfhi(raw.z), bflo(raw.w), bfhi(raw.w)};
        float res[8];
#pragma unroll
        for (int e = 0; e < 8; ++e) { const float oth = __shfl_xor(own[e], 32); const f32x2 c = cs[e]; res[e] = (fq < 2) ? (own[e] * c.x - oth * c.y) : (own[e] * c.x + oth * c.y); }
        v4u rw; rw.x = pkhw(res[0], res[1]); rw.y = pkhw(res[2], res[3]); rw.z = pkhw(res[4], res[5]); rw.w = pkhw(res[6], res[7]);
        qf[g][2] = __builtin_bit_cast(bf16x8, rw);
    }
    float m[2] = {-1e30f, -1e30f}, lsum[2] = {0.f, 0.f};
    f32x4 o[2][4];
#pragma unroll
    for (int g = 0; g < 2; ++g)
#pragma unroll
        for (int d = 0; d < 4; ++d) o[g][d] = (f32x4){0.f, 0.f, 0.f, 0.f};
    const int nt = 4 * (qb + 1), my_last = (q0w + 31) >> 6;
    const int kc0 = tid, kc1 = tid + 512;
    const int key0 = kc0 / 12, part0 = kc0 % 12, key1 = kc1 / 12, part1 = kc1 % 12; const bool has1 = kc1 < 768;
    const bf16* ksrc0 = (part0 < 8) ? (KM + (tok0 + key0) * 512 + h * 64 + part0 * 8) : (P + (tok0 + key0) * PN + C_KPE + (part0 - 8) * 8);
    const bf16* ksrc1 = (part1 < 8) ? (KM + (tok0 + key1) * 512 + h * 64 + part1 * 8) : (P + (tok0 + key1) * PN + C_KPE + (part1 - 8) * 8);
    const size_t kstep0 = (part0 < 8) ? (size_t)64 * 512 : (size_t)64 * PN, kstep1 = (part1 < 8) ? (size_t)64 * 512 : (size_t)64 * PN;
    const int kdst0 = key0 * AK_ROW + part0 * 16, kdst1 = key1 * AK_ROW + part1 * 16;
    const bf16* vsrc = VTM + (size_t)(h * 64 + (tid >> 3)) * T + tok0 + (tid & 7) * 8;
    const int vdst = AK_BYTES + (tid >> 3) * AV_ROW + ((((tid & 7) >> 2) * 32 + (2 * (tid & 1)) * 8 + (((tid & 7) >> 1) & 1) * 4) * 2);
    LAS unsigned char* lds = C.lds;
    v4u r0[2], r1[2], r2[2];
#pragma unroll
    for (int sb = 0; sb < 2; ++sb) { r1[sb] = (v4u){0u, 0u, 0u, 0u}; r0[sb] = *(const v4u*)(ksrc0 + (size_t)sb * kstep0); if (has1) r1[sb] = *(const v4u*)(ksrc1 + (size_t)sb * kstep1); r2[sb] = *(const v4u*)(vsrc + (size_t)sb * 64); }
#pragma unroll
    for (int sb = 0; sb < 2; ++sb) { LAS unsigned char* nb = lds + sb * ABUF; *(LAS v4u*)(nb + kdst0) = r0[sb]; if (has1) *(LAS v4u*)(nb + kdst1) = r1[sb]; { const v4u vv_ = r2[sb]; *(LAS v2u*)(nb + vdst) = (v2u){vv_.x, vv_.y}; *(LAS v2u*)(nb + vdst + 16) = (v2u){vv_.z, vv_.w}; } }
    __syncthreads();
    const float c2 = 0.10206207261596577f * LOG2E;
    for (int kp = 0; kp < nt / 2; ++kp) {
        const bool more = 2 * kp + 2 < nt;
        if (more) {
#pragma unroll
            for (int sb = 0; sb < 2; ++sb) { const int tn = 2 * kp + 2 + sb; r0[sb] = *(const v4u*)(ksrc0 + (size_t)tn * kstep0); if (has1) r1[sb] = *(const v4u*)(ksrc1 + (size_t)tn * kstep1); r2[sb] = *(const v4u*)(vsrc + (size_t)tn * 64); } }
#pragma unroll 1
        for (int sub = 0; sub < 2; ++sub) {
        const int kt = 2 * kp + sub;
        if (kt <= my_last) {
            const LAS unsigned char* Kb = lds + ((kp & 1) * 2 + sub) * ABUF; const LAS unsigned char* Vb = Kb + AK_BYTES;
            const int k0 = kt * 64;
            f32x4 s[2][4];
#pragma unroll
            for (int g = 0; g < 2; ++g)
#pragma unroll
                for (int blk = 0; blk < 4; ++blk) s[g][blk] = (f32x4){0.f, 0.f, 0.f, 0.f};
#pragma unroll
            for (int kk = 0; kk < 3; ++kk)
#pragma unroll
                for (int blk = 0; blk < 4; ++blk) {
                    const bf16x8 kf = *(const LAS bf16x8*)(Kb + (blk * 16 + fr) * AK_ROW + (kk * 32 + fq * 8) * 2);
#pragma unroll
                    for (int g = 0; g < 2; ++g) s[g][blk] = __builtin_amdgcn_mfma_f32_16x16x32_bf16(kf, qf[g][kk], s[g][blk], 0, 0, 0);
                }
            const bool need_mask = (k0 + 63 > q0w);
            bf16x8 pf[2][2];
#pragma unroll
            for (int g = 0; g < 2; ++g) {
                const int qi = q0w + 16 * g + fr;
                if (need_mask) {
                    asm volatile("" ::: "memory");
#pragma unroll
                    for (int blk = 0; blk < 4; ++blk)
#pragma unroll
                        for (int j = 0; j < 4; ++j) { const int key = k0 + blk * 16 + fq * 4 + j; if (key > qi) s[g][blk][j] = -1e30f; }
                    asm volatile("" ::: "memory");
                }
                float mx = fmaxf(s[g][0][0], s[g][0][1]);
                mx = fmaxf(fmaxf(mx, s[g][0][2]), s[g][0][3]);
#pragma unroll
                for (int blk = 1; blk < 4; ++blk) { mx = fmaxf(fmaxf(mx, s[g][blk][0]), s[g][blk][1]); mx = fmaxf(fmaxf(mx, s[g][blk][2]), s[g][blk][3]); }
                mx = rowmax4(mx);
                const float mn = fmaxf(m[g], mx * c2), alpha = __builtin_amdgcn_exp2f(m[g] - mn); m[g] = mn;
                f32x2 ps2 = (f32x2){0.f, 0.f};
                const f32x2 c2v = (f32x2){c2, c2}, mnv = (f32x2){mn, mn};
#pragma unroll
                for (int blk = 0; blk < 4; ++blk)
#pragma unroll
                    for (int jp = 0; jp < 2; ++jp) { f32x2 x = (f32x2){s[g][blk][2 * jp], s[g][blk][2 * jp + 1]}; x = x * c2v - mnv;
                        f32x2 pv; pv.x = __builtin_amdgcn_exp2f(x.x); pv.y = __builtin_amdgcn_exp2f(x.y); ps2 = ps2 + pv; s[g][blk][2 * jp] = pv.x; s[g][blk][2 * jp + 1] = pv.y; }
                const float ps = ps2.x + ps2.y;
                lsum[g] = lsum[g] * alpha + ps;
                if (__builtin_amdgcn_ballot_w64(alpha != 1.0f) != 0ull) {
#pragma unroll
                    for (int d = 0; d < 4; ++d) o[g][d] = o[g][d] * alpha;
                }
#pragma unroll
                for (int hf = 0; hf < 2; ++hf) { v4u pw; pw.x = pkhw(s[g][2 * hf][0], s[g][2 * hf][1]); pw.y = pkhw(s[g][2 * hf][2], s[g][2 * hf][3]); pw.z = pkhw(s[g][2 * hf + 1][0], s[g][2 * hf + 1][1]); pw.w = pkhw(s[g][2 * hf + 1][2], s[g][2 * hf + 1][3]);
                    pf[g][hf] = __builtin_bit_cast(bf16x8, pw); }
            }
#pragma unroll
            for (int hf = 0; hf < 2; ++hf)
#pragma unroll
                for (int d = 0; d < 4; ++d) {
                    const bf16x8 vf = *(const LAS bf16x8*)(Vb + (d * 16 + fr) * AV_ROW + (hf * 32 + fq * 8) * 2);
#pragma unroll
                    for (int g = 0; g < 2; ++g) o[g][d] = __builtin_amdgcn_mfma_f32_16x16x32_bf16(vf, pf[g][hf], o[g][d], 0, 0, 0);
                }
        }
        }
        if (more) {
#pragma unroll
            for (int sb = 0; sb < 2; ++sb) { LAS unsigned char* nb = lds + (((kp + 1) & 1) * 2 + sb) * ABUF; *(LAS v4u*)(nb + kdst0) = r0[sb]; if (has1) *(LAS v4u*)(nb + kdst1) = r1[sb]; { const v4u vv_ = r2[sb]; *(LAS v2u*)(nb + vdst) = (v2u){vv_.x, vv_.y}; *(LAS v2u*)(nb + vdst + 16) = (v2u){vv_.z, vv_.w}; } } }
        __syncthreads();
    }
    bf16* Y = (bf16*)(p.ws + WS_Y) + (size_t)2 * T * 512;
#pragma unroll
    for (int g = 0; g < 2; ++g) {
        float lt = lsum[g]; lt += __shfl_xor(lt, 16); lt += __shfl_xor(lt, 32);
        const float inv = 1.0f / lt;
        bf16* yp = Y + (tok0 + q0w + 16 * g + fr) * 512 + h * 64 + fq * 4;
#pragma unroll
        for (int d = 0; d < 4; ++d) { v2u w; w.x = pkhw(o[g][d][0] * inv, o[g][d][1] * inv); w.y = pkhw(o[g][d][2] * inv, o[g][d][3] * inv); *(v2u*)(yp + d * 16) = w; }
    }
}

__device__ __forceinline__ void swa_unit(const Ctx& C, const Params& p, int l, int unit) {
    int tid_ = threadIdx.x; asm volatile("" : "+v"(tid_));
    const int tid = tid_, lane = tid & 63, fr = lane & 15, fq = lane >> 4, wave_ = __builtin_amdgcn_readfirstlane(tid >> 6);
    const int b = unit >> 5, kvh = (unit >> 4) & 1, qb = unit & 15;
    const int q0w = qb * 256 + wave_ * 32;
    const size_t tok0 = (size_t)b * SEQ;
    const bf16* P = (const bf16*)(p.ws + WS_P); const bf16* VTA = (const bf16*)(p.ws + WS_VTA);
    LAS unsigned char* lds = C.lds;
    constexpr int SROW = 144, STILE = 2 * 64 * SROW;
    LAS float* btl = (LAS float*)(lds + 6 * STILE);
    const int kt_lo = (4 * qb - 2 > 0) ? 4 * qb - 2 : 0, kt_hi = 4 * qb + 3, ntile = kt_hi - kt_lo + 1;
    const int my_lo = (q0w - 127 > 0 ? q0w - 127 : 0) >> 6, my_hi = (q0w + 31) >> 6;
    {
        const bf16* ksrc = P + (tok0 + (size_t)kt_lo * 64 + (tid >> 3)) * PN + C_KA + kvh * 64 + (tid & 7) * 8;
        const bf16* vsrc = VTA + (size_t)(kvh * 64 + (tid >> 3)) * T + tok0 + (size_t)kt_lo * 64 + (tid & 7) * 8;
        const int dst = (tid >> 3) * SROW + (tid & 7) * 16;
        v4u rk[6], rv[6];
#pragma unroll
        for (int t = 0; t < 6; ++t) if (t < ntile) { rk[t] = *(const v4u*)(ksrc + (size_t)t * 64 * PN); rv[t] = *(const v4u*)(vsrc + (size_t)t * 64); }
        for (int i = tid; i < 4 * 129; i += 512) { const int hh = i / 129, n = i - hh * 129; btl[i] = ((const float*)(p.ws + WS_BT))[n * 8 + kvh * 4 + hh] * LOG2E; }
#pragma unroll
        for (int t = 0; t < 6; ++t) if (t < ntile) { *(LAS v4u*)(lds + t * STILE + dst) = rk[t]; *(LAS v4u*)(lds + t * STILE + 64 * SROW + dst) = rv[t]; }
    }
    __syncthreads();
    const float c2 = 0.125f * LOG2E;
    int pq[2];
#pragma unroll
    for (int g = 0; g < 2; ++g) pq[g] = p.pos[tok0 + q0w + 16 * g + fr];
#pragma unroll 1
    for (int hh = 0; hh < 4; ++hh) {
        const int h = kvh * 4 + hh;
        const LAS float* bth = btl + hh * 129;
        bf16x8 qf[2][2];
#pragma unroll
        for (int g = 0; g < 2; ++g) { const bf16* qp = P + (tok0 + q0w + 16 * g + fr) * PN + C_QA + h * 64 + fq * 8; qf[g][0] = *(const bf16x8*)qp; qf[g][1] = *(const bf16x8*)(qp + 32); }
        const float sink2 = p.sinks[l * 8 + h] * LOG2E;
        float m[2] = {sink2, sink2}, lsum[2] = {0.f, 0.f};
        f32x4 o[2][4];
#pragma unroll
        for (int g = 0; g < 2; ++g)
#pragma unroll
            for (int d = 0; d < 4; ++d) o[g][d] = (f32x4){0.f, 0.f, 0.f, 0.f};
#pragma unroll 1
        for (int kt = my_lo; kt <= my_hi; ++kt) {
            const LAS unsigned char* Kb = lds + (kt - kt_lo) * STILE; const LAS unsigned char* Vb = Kb + 64 * SROW;
            const int k0 = kt * 64;
            f32x4 s[2][4];
#pragma unroll
            for (int blk = 0; blk < 4; ++blk) {
                bf16x8 kf[2];
#pragma unroll
                for (int kk = 0; kk < 2; ++kk) kf[kk] = *(const LAS bf16x8*)(Kb + (blk * 16 + fr) * SROW + (kk * 32 + fq * 8) * 2);
#pragma unroll
                for (int g = 0; g < 2; ++g) { f32x4 a = (f32x4){0.f, 0.f, 0.f, 0.f};
#pragma unroll
                    for (int kk = 0; kk < 2; ++kk) a = __builtin_amdgcn_mfma_f32_16x16x32_bf16(kf[kk], qf[g][kk], a, 0, 0, 0);
                    s[g][blk] = a; }
            }
            bf16x8 pf[2][2];
#pragma unroll
            for (int g = 0; g < 2; ++g) {
                const int qi = q0w + 16 * g + fr;
#pragma unroll
                for (int blk = 0; blk < 4; ++blk) { const int4 t4 = *(const int4*)(p.pos + tok0 + k0 + blk * 16 + fq * 4); const int pkv[4] = {t4.x, t4.y, t4.z, t4.w};
#pragma unroll
                    for (int j = 0; j < 4; ++j) { const int key = k0 + blk * 16 + fq * 4 + j; int dd = pq[g] - pkv[j]; dd = dd < 0 ? 0 : (dd > 128 ? 128 : dd);
                        const float v = s[g][blk][j] * c2 + bth[dd]; const bool ok = (key <= qi) && (qi - key < 128); s[g][blk][j] = ok ? v : -1e30f; } }
                float mx = fmaxf(fmaxf(s[g][0][0], s[g][0][1]), fmaxf(s[g][0][2], s[g][0][3]));
#pragma unroll
                for (int blk = 1; blk < 4; ++blk) mx = fmaxf(mx, fmaxf(fmaxf(s[g][blk][0], s[g][blk][1]), fmaxf(s[g][blk][2], s[g][blk][3])));
                mx = rowmax4(mx);
                const float mn = fmaxf(m[g], mx), alpha = __builtin_amdgcn_exp2f(m[g] - mn); m[g] = mn;
                f32x2 ps2 = (f32x2){0.f, 0.f}; const f32x2 mnv = (f32x2){mn, mn};
#pragma unroll
                for (int blk = 0; blk < 4; ++blk)
#pragma unroll
                    for (int jp = 0; jp < 2; ++jp) { f32x2 x = (f32x2){s[g][blk][2 * jp], s[g][blk][2 * jp + 1]}; x = x - mnv;
                        f32x2 pv; pv.x = __builtin_amdgcn_exp2f(x.x); pv.y = __builtin_amdgcn_exp2f(x.y); ps2 = ps2 + pv; s[g][blk][2 * jp] = pv.x; s[g][blk][2 * jp + 1] = pv.y; }
                const float ps = ps2.x + ps2.y;
                lsum[g] = lsum[g] * alpha + ps;
#pragma unroll
                for (int d = 0; d < 4; ++d) o[g][d] = o[g][d] * alpha;
#pragma unroll
                for (int hf = 0; hf < 2; ++hf) { v4u pw; pw.x = pkhw(s[g][2 * hf][0], s[g][2 * hf][1]); pw.y = pkhw(s[g][2 * hf][2], s[g][2 * hf][3]); pw.z = pkhw(s[g][2 * hf + 1][0], s[g][2 * hf + 1][1]); pw.w = pkhw(s[g][2 * hf + 1][2], s[g][2 * hf + 1][3]);
                    pf[g][hf] = __builtin_bit_cast(bf16x8, pw); }
            }
#pragma unroll
            for (int hf = 0; hf < 2; ++hf)
#pragma unroll
                for (int d = 0; d < 4; ++d) {
                    const LAS unsigned char* vp = Vb + (d * 16 + fr) * SROW + (hf * 32 + fq * 4) * 2;
                    const v2u lo = *(const LAS v2u*)vp, hi = *(const LAS v2u*)(vp + 32);
                    const v4u vw = (v4u){lo.x, lo.y, hi.x, hi.y}; const bf16x8 vf = __builtin_bit_cast(bf16x8, vw);
#pragma unroll
                    for (int g = 0; g < 2; ++g) o[g][d] = __builtin_amdgcn_mfma_f32_16x16x32_bf16(vf, pf[g][hf], o[g][d], 0, 0, 0);
                }
        }
        bf16* Y = (bf16*)(p.ws + WS_Y);
#pragma unroll
        for (int g = 0; g < 2; ++g) {
            float lt = lsum[g]; lt += __shfl_xor(lt, 16); lt += __shfl_xor(lt, 32);
            lt += __builtin_amdgcn_exp2f(sink2 - m[g]);
            const float inv = 1.0f / lt;
            bf16* yp = Y + (tok0 + q0w + 16 * g + fr) * 512 + h * 64 + fq * 4;
#pragma unroll
            for (int d = 0; d < 4; ++d) { v2u w; w.x = pkhw(o[g][d][0] * inv, o[g][d][1] * inv); w.y = pkhw(o[g][d][2] * inv, o[g][d][3] * inv); *(v2u*)(yp + d * 16) = w; }
        }
    }
    __syncthreads();
}

#ifndef DBG_NAIVE
#define DBG_NAIVE 0
#endif
#if DBG_NAIVE
__device__ __forceinline__ int t5b_n(int rel) { int n = rel < 0 ? 0 : rel; if (n < 16) return n; float nf = (float)n; int lg = 16 + (int)(logf(nf / 16.0f) / 2.0794415416798357f * 16.0f); return lg < 31 ? lg : 31; }
__device__ __forceinline__ void naive_conv(const Ctx& C, const Params& p, int l) {
    LAS float* red = (LAS float*)C.lds; const bf16* P = (const bf16*)(p.ws + WS_P); bf16* Y = (bf16*)(p.ws + WS_Y) + (size_t)T * 512; const int c = C.tid;
    for (int t = C.bid; t < T; t += C.G) {
        const int s = t & (SEQ - 1); float acc = p.b_dw[l * 512 + c];
        for (int j = 0; j < 31; ++j) { const int ss = s - 30 + j; if (ss >= 0) { const bf16* row = P + (size_t)(t - 30 + j) * PN + C_UB; const float a = bf2f(row[c]), g = bf2f(row[512 + c]); acc += p.w_dw[(size_t)l * 31 * 512 + j * 512 + c] * (a / (1.f + expf(-g))); } }
        float sw = wave_sum(acc); if (C.lane == 0) red[C.wave] = sw; __syncthreads();
        float tot = 0.f; for (int w = 0; w < 8; ++w) tot += red[w]; const float mean = tot / 512.f; __syncthreads();
        const float dv = acc - mean; sw = wave_sum(dv * dv); if (C.lane == 0) red[C.wave] = sw; __syncthreads();
        tot = 0.f; for (int w = 0; w < 8; ++w) tot += red[w]; __syncthreads();
        float y = dv / sqrtf(tot / 512.f + EPS) * p.g_cln[l * 512 + c] + p.b_cln[l * 512 + c]; y = y / (1.f + expf(-y));
        Y[(size_t)t * 512 + c] = (bf16)f2bf(y);
    }
}
__device__ __forceinline__ void naive_swa(const Ctx& C, const Params& p, int l) {
    const bf16* P = (const bf16*)(p.ws + WS_P); bf16* Y = (bf16*)(p.ws + WS_Y);
    for (int it = C.bid * 512 + C.tid; it < T * 8; it += C.G * 512) {
        const int t = it >> 3, h = it & 7, s = t & (SEQ - 1), b0 = t - s; const bf16* q = P + (size_t)t * PN + h * 64;
        float qv[64];
#pragma unroll
        for (int d = 0; d < 64; ++d) qv[d] = bf2f(q[d]);
        float acc[64];
#pragma unroll
        for (int d = 0; d < 64; ++d) acc[d] = 0.f;
        const float sink = p.sinks[l * 8 + h]; float m = sink, lsum = 0.f;
        for (int ks = (s - 127 > 0 ? s - 127 : 0); ks <= s; ++ks) { const bf16* kr = P + (size_t)(b0 + ks) * PN + C_KA + (h >> 2) * 64; float sc = 0.f;
#pragma unroll
            for (int d = 0; d < 64; ++d) sc += qv[d] * bf2f(kr[d]);
            sc = sc * 0.125f + p.rel_bias[t5b_n(p.pos[t] - p.pos[b0 + ks]) * 8 + h];
            const float mn = fmaxf(m, sc), al = expf(m - mn), pp = expf(sc - mn); lsum = lsum * al + pp; m = mn; const bf16* vr = P + (size_t)(b0 + ks) * PN + C_VA + (h >> 2) * 64;
#pragma unroll
            for (int d = 0; d < 64; ++d) acc[d] = acc[d] * al + pp * bf2f(vr[d]); }
        lsum += expf(sink - m);
#pragma unroll
        for (int d = 0; d < 64; ++d) Y[(size_t)t * 512 + h * 64 + d] = (bf16)f2bf(acc[d] / lsum);
    }
}
__device__ __forceinline__ void naive_mla(const Ctx& C, const Params& p, int l) {
    const bf16* P = (const bf16*)(p.ws + WS_P); const bf16* QM = (const bf16*)(p.ws + WS_QM); const bf16* KM = (const bf16*)(p.ws + WS_KM); const bf16* VTM = (const bf16*)(p.ws + WS_VTM);
    bf16* Y = (bf16*)(p.ws + WS_Y) + (size_t)2 * T * 512; LAS float* qs = (LAS float*)C.lds + C.wave * 128;
    for (int it = C.bid * 8 + C.wave; it < T * 8; it += C.G * 8) {
        const int t = it >> 3, h = it & 7, s = t & (SEQ - 1), b0 = t - s; const bf16* q = QM + (size_t)t * 768 + h * 96;
        asm volatile("s_waitcnt lgkmcnt(0)" ::: "memory");
        qs[C.lane] = bf2f(q[C.lane]);
        if (C.lane < 16) { const float ang = (float)p.pos[t] * expf(-9.210340371976184f * (float)C.lane / 16.f); const float cc = __cosf(ang), sn = __sinf(ang);
            const float x1 = bf2f(q[64 + C.lane]), x2 = bf2f(q[80 + C.lane]); qs[64 + C.lane] = x1 * cc - x2 * sn; qs[80 + C.lane] = x2 * cc + x1 * sn; }
        asm volatile("s_waitcnt lgkmcnt(0)" ::: "memory");
        float acc[64];
#pragma unroll
        for (int d = 0; d < 64; ++d) acc[d] = 0.f;
        float m = -1e30f, lsum = 0.f;
        for (int ks = C.lane; ks <= s; ks += 64) { const size_t kt = (size_t)(b0 + ks); float sc = 0.f;
            for (int d = 0; d < 64; ++d) sc += qs[d] * bf2f(KM[kt * 512 + h * 64 + d]);
            for (int d = 0; d < 32; ++d) sc += qs[64 + d] * bf2f(P[kt * PN + C_KPE + d]);
            sc *= 0.10206207261596577f;
            const float mn = fmaxf(m, sc), al = expf(m - mn), pp = expf(sc - mn); lsum = lsum * al + pp; m = mn;
#pragma unroll
            for (int d = 0; d < 64; ++d) acc[d] = acc[d] * al + pp * bf2f(VTM[(size_t)(h * 64 + d) * T + kt]); }
        float mg = m;
#pragma unroll
        for (int o = 1; o < 64; o <<= 1) mg = fmaxf(mg, __shfl_xor(mg, o));
        const float f = expf(m - mg); const float lt = wave_sum(lsum * f);
#pragma unroll
        for (int d = 0; d < 64; ++d) { const float v = wave_sum(acc[d] * f); if (C.lane == (d & 63)) Y[(size_t)t * 512 + h * 64 + d] = (bf16)f2bf(v / lt); }
    }
}
#endif

#define XB_TMO      128
#define XB_XCNT(j)  (256  + 64 * (j))
#define XB_XSUB(j)  (1280 + 64 * (j))
#define XB_XGEN(j)  (2304 + 64 * (j))
#define XB_TOP      3328
#define XB_TOPGEN   3392
#define XCD_BAR_WORDS 3456
#define XB_SPIN_CAP (1u << 18)

__device__ __forceinline__ unsigned xb_ld(unsigned* p)              { return __hip_atomic_load(p, __ATOMIC_RELAXED, __HIP_MEMORY_SCOPE_AGENT); }
__device__ __forceinline__ unsigned xb_add(unsigned* p, unsigned v) { return __hip_atomic_fetch_add(p, v, __ATOMIC_RELAXED, __HIP_MEMORY_SCOPE_AGENT); }
__device__ __forceinline__ unsigned xb_xcc_id() { return (unsigned)__builtin_amdgcn_s_getreg((3 << 11) | 20) & 0xFu; }
#define XB_SPIN(cond, bar) do { unsigned _sp = 0; while (cond) { __builtin_amdgcn_s_sleep(1); \
    if ((++_sp & 255u) == 0u) { if (xb_ld(&(bar)[XB_TMO])) break; if (_sp > XB_SPIN_CAP) { atomicAdd(&(bar)[XB_TMO], 1u); break; } } } } while (0)

struct XcdBarrier {
    unsigned* bar; unsigned x;
    volatile LAS unsigned* st;
};

__device__ __forceinline__ XcdBarrier xcd_barrier_post(unsigned* bar, volatile LAS unsigned* st) {
    XcdBarrier b; b.bar = bar; b.x = xb_xcc_id(); b.st = st;
    if (threadIdx.x == 0) (void)xb_add(&bar[XB_XCNT(b.x)], 1u);
    return b;
}
__device__ __forceinline__ void xcd_barrier_complete(unsigned* bar, unsigned x, unsigned& nloc, unsigned& nx) {
    const unsigned G = gridDim.x * gridDim.y * gridDim.z;
    unsigned sum, cnt, mine, sp = 0u;
    for (;;) {
        sum = 0u; cnt = 0u; mine = 0u;
#pragma unroll
        for (unsigned j = 0; j < 16; ++j) { const unsigned c = xb_ld(&bar[XB_XCNT(j)]); sum += c; cnt += (c > 0u) ? 1u : 0u; mine = (j == x) ? c : mine; }
        if (sum == G) break;
        __builtin_amdgcn_s_sleep(1);
        if ((++sp & 255u) == 0u) { if (xb_ld(&bar[XB_TMO])) break; if (sp > XB_SPIN_CAP) { atomicAdd(&bar[XB_TMO], 1u); break; } }
    }
    nloc = mine > 0u ? mine : 1u; nx = cnt > 0u ? cnt : 1u;
}

__device__ __forceinline__ void xcd_barrier(const XcdBarrier& b) {
    asm volatile("s_waitcnt vmcnt(0)" ::: "memory");
    __syncthreads();
    if (threadIdx.x == 0) {
        unsigned* bar = b.bar;
        __builtin_amdgcn_s_waitcnt(0);
        unsigned nloc = b.st[0], nx = b.st[1];
        if (nloc == 0u) { xcd_barrier_complete(bar, b.x, nloc, nx); b.st[0] = nloc; b.st[1] = nx; }
        const unsigned old = xb_add(&bar[XB_XSUB(b.x)], 1u);
        const unsigned gen = old / nloc;
        if (old + 1u == (gen + 1u) * nloc) {
            __builtin_amdgcn_fence(__ATOMIC_RELEASE, "agent");
            asm volatile("s_waitcnt vmcnt(0)" ::: "memory");
            const unsigned og = xb_add(&bar[XB_TOP], 1u);
            const unsigned tg = og / nx;
            if (og + 1u == (tg + 1u) * nx) xb_add(&bar[XB_TOPGEN], 1u);
            else XB_SPIN(xb_ld(&bar[XB_TOPGEN]) == tg, bar);
            __builtin_amdgcn_fence(__ATOMIC_ACQUIRE, "agent");
            xb_add(&bar[XB_XGEN(b.x)], 1u);
            asm volatile("s_waitcnt vmcnt(0)" ::: "memory");
        } else {
            XB_SPIN(xb_ld(&bar[XB_XGEN(b.x)]) == gen, bar);
            __builtin_amdgcn_fence(__ATOMIC_ACQUIRE, "agent");
            asm volatile("s_waitcnt vmcnt(0)" ::: "memory");
        }
    }
    __syncthreads();
}

template <int MODE>
__device__ __forceinline__ void run_gemm(const Ctx& C, const bf16* A, int lda, const bf16* Bt, int ldb, int M, int N, int K, const pg8::Epi<MODE>& E, int crot = 0) {
    pg8::Gemm g{A, Bt, lda, ldb, M, N, K}; pg8::StaticOrder S; S.init(M, N, C.G, (C.bid + crot) % C.G);
    pg8::gemm_phase<pg8::Epi<MODE>, pg8::StaticOrder, true, true>(C.lds, g, S, E);
    __syncthreads();
}

#define GSYNC() do { xcd_barrier(xbar); } while (0)
__global__ void __launch_bounds__(512) mega_fwd(Params p) {
    extern __shared__ __attribute__((aligned(16))) unsigned char lds_raw[];
    cg::grid_group grid = cg::this_grid();
    Ctx C; C.lds = (LAS unsigned char*)lds_raw; C.tid = threadIdx.x; C.lane = C.tid & 63; C.wave = __builtin_amdgcn_readfirstlane(C.tid >> 6); C.G = gridDim.x; C.bid = blockIdx.x;
    unsigned char* ws = p.ws;
    bf16* W = (bf16*)(ws + WS_W); bf16* H = (bf16*)(ws + WS_H); bf16* P = (bf16*)(ws + WS_P); bf16* Y = (bf16*)(ws + WS_Y);
    bf16* QM = (bf16*)(ws + WS_QM); bf16* KM = (bf16*)(ws + WS_KM); bf16* VTM = (bf16*)(ws + WS_VTM); bf16* VTA = (bf16*)(ws + WS_VTA);
    bf16* MG = (bf16*)(ws + WS_MG); bf16* GS = (bf16*)(ws + WS_GS); bf16* HID = (bf16*)(ws + WS_HID);

    volatile LAS unsigned* xst = (volatile LAS unsigned*)(C.lds + RING_BYTES + 64);
    if (threadIdx.x < 2) xst[threadIdx.x] = 0u;
    __syncthreads();
    XcdBarrier xbar = xcd_barrier_post((unsigned*)(p.ws), xst);
    phase_tables(C, p);
    asm volatile("s_waitcnt vmcnt(0) lgkmcnt(0)" ::: "memory"); grid.sync();
    for (int l = 0; l < DEPTH; ++l) {
        { int t_ = threadIdx.x; asm volatile("" : "+v"(t_)); C.tid = t_; C.lane = t_ & 63; C.wave = __builtin_amdgcn_readfirstlane(t_ >> 6); }
        const float* xcur = (l == 0) ? p.x : p.out;
        for (int rep_ = 0; rep_ < DBG_REP_A; ++rep_) {
        phase_convert_weights(C, p, l);
        phase_norm(C, xcur, p.g_mix + l * DM, H);
        }
        GSYNC();
        for (int rep_ = 0; rep_ < DBG_XSYNC; ++rep_) GSYNC();
        for (int rep_ = 0; rep_ < DBG_REP_G; ++rep_) {
        { pg8::Epi<pg8::EPI_BF16> E{P, PN, nullptr, 0, nullptr, nullptr, 1.f}; run_gemm(C, H, DM, W + WO_IN, DM, T, PN, DM, E); }
        { pg8::Epi<pg8::EPI_BF16> E{VTA, T, nullptr, 0, nullptr, nullptr, 1.f}; run_gemm(C, W + WO_IN + (size_t)C_VA * DM, DM, H, DM, 256, T, DM, E, C.G / 2); }
        }
        GSYNC();
        {
            rownorm_rows(C, p, l, C.bid * 8 + C.wave, C.G * 8);
            for (int rep_ = 0; rep_ < DBG_REP_C; ++rep_) {
#if DBG_NAIVE & 1
            naive_swa(C, p, l);
#else
#ifdef SWA_V1
            for (int u = C.bid; u < 2048; u += C.G) attn_unit<true>(C, p, l, u);
#else
            for (int rs_ = 0; rs_ < DBG_REP_S; ++rs_) for (int u = C.bid; u < 256; u += C.G) swa_unit(C, p, l, u);
#endif
#endif
#if DBG_NAIVE & 2
            naive_conv(C, p, l);
#else
            for (int u = C.bid; u < T / 32; u += C.G) conv_unit(C, p, l, u);
#endif
            }
        }
        GSYNC();
        for (int rep_ = 0; rep_ < DBG_REP_G; ++rep_) {
        { pg8::Epi<pg8::EPI_BF16> E{QM, 768, nullptr, 0, nullptr, nullptr, 1.f}; run_gemm(C, P + C_CQ, PN, W + WO_Q, 256, T, 768, 256, E); }
        { pg8::Epi<pg8::EPI_BF16> E{KM, 512, nullptr, 0, nullptr, nullptr, 1.f}; run_gemm(C, P + C_CKV, PN, W + WO_K, 256, T, 512, 256, E); }
        { pg8::Epi<pg8::EPI_BF16> E{VTM, T, nullptr, 0, nullptr, nullptr, 1.f}; run_gemm(C, W + WO_V, 256, P + C_CKV, PN, 512, T, 256, E); }
        }
        GSYNC();
#if DBG_NAIVE & 4
        naive_mla(C, p, l);
#else
#ifdef MLA_V1
        for (int rep = 0; rep < DBG_REP_E; ++rep) for (int u = C.bid; u < 2048; u += C.G) attn_unit<false>(C, p, l, u);
#else
        for (int rep_ = 0; rep_ < DBG_REP_E; ++rep_) for (int u = C.bid; u < 1024; u += C.G) mla_unit(C, p, u);
#endif
#endif
        GSYNC();
#ifndef DBG_REP_E
#define DBG_REP_E 1
#endif
#ifndef DBG_REP_G
#define DBG_REP_G 1
#endif
#ifndef DBG_REP_C
#define DBG_REP_C 1
#endif
#ifndef DBG_SKIP
#define DBG_SKIP 0
#endif
#ifndef DBG_DBL
#define DBG_DBL 0
#endif
        for (int rep_ = 0; rep_ < DBG_REP_G; ++rep_) { int firstn = 1;
        for (int n = 0; n < 3; ++n) {
            if ((DBG_SKIP >> n) & 1) continue;
            { pg8::Epi<pg8::EPI_SIG> E{GS, DM, nullptr, 0, nullptr, nullptr, 1.f}; run_gemm(C, H, DM, W + WO_G + (size_t)n * DM * DM, DM, T, DM, DM, E); }
#ifdef DBG_FSYNC
            GSYNC();
#endif
            { pg8::Epi<pg8::EPI_GATEMUL> E{MG, DM, GS, firstn, nullptr, nullptr, ((DBG_DBL >> n) & 1) ? 2.f : 1.f}; run_gemm(C, Y + (size_t)n * T * 512, 512, W + WO_B + (size_t)n * DM * 512, 512, T, DM, 512, E); }
            firstn = 0;
        } }
        GSYNC();
        { pg8::Epi<pg8::EPI_RES> E{nullptr, DM, nullptr, 0, xcur, p.out, 1.f}; run_gemm(C, MG, DM, W + WO_O, DM, T, DM, DM, E); }
        GSYNC();
        for (int rep_ = 0; rep_ < DBG_REP_A; ++rep_) phase_norm(C, p.out, p.g_mlp + l * DM, H);
        GSYNC();
        for (int rep_ = 0; rep_ < DBG_REP_G; ++rep_)
        { pg8::Epi<pg8::EPI_RELU2> E{HID, DFF, nullptr, 0, nullptr, nullptr, 1.f}; run_gemm(C, H, DM, W + WO_U, DM, T, DFF, DM, E); }
        GSYNC();
        { pg8::Epi<pg8::EPI_RES> E{nullptr, DM, nullptr, 0, p.out, p.out, 1.f}; run_gemm(C, HID, DFF, W + WO_D, DFF, T, DM, DFF, E); }
        GSYNC();
    }
    phase_final_norm(C, p.g_final, p.out);
}

extern "C" void kernel_launch(void* const* d_in, const int* in_sizes, int n_in, void* d_out, int out_size, void* d_ws, size_t ws_size, hipStream_t stream) {
    static int grid = 0;
    if (grid == 0) {
        int dev = 0, cus = 0, per_cu = 0;
        hipGetDevice(&dev);
        hipDeviceGetAttribute(&cus, hipDeviceAttributeMultiprocessorCount, dev);
        hipFuncSetAttribute((const void*)mega_fwd, hipFuncAttributeMaxDynamicSharedMemorySize, LDS_BYTES);
        hipOccupancyMaxActiveBlocksPerMultiprocessor(&per_cu, (const void*)mega_fwd, 512, LDS_BYTES);
        if (per_cu < 1) per_cu = 1;
        grid = cus * per_cu;
        if (ws_size < WS_END) fprintf(stderr, "kernel_launch: workspace too small: %zu < %zu\n", ws_size, (size_t)WS_END);
    }
    Params p{};
    p.x = (const float*)d_in[0]; p.pos = (const int*)d_in[1]; p.rel_bias = (const float*)d_in[2]; p.g_final = (const float*)d_in[3]; p.g_mix = (const float*)d_in[4];
    p.w_in = (const float*)d_in[5]; p.sinks = (const float*)d_in[6]; p.g_qn = (const float*)d_in[7]; p.w_qup = (const float*)d_in[8]; p.g_kvn = (const float*)d_in[9];
    p.w_kvup = (const float*)d_in[10]; p.w_dw = (const float*)d_in[11]; p.b_dw = (const float*)d_in[12]; p.g_cln = (const float*)d_in[13]; p.b_cln = (const float*)d_in[14];
    p.w_branch = (const float*)d_in[15]; p.w_out = (const float*)d_in[16]; p.g_mlp = (const float*)d_in[17]; p.w_up = (const float*)d_in[18]; p.w_down = (const float*)d_in[19];
    p.out = (float*)d_out; p.ws = (unsigned char*)d_ws;
    hipMemsetAsync(d_ws, 0, XCD_BAR_WORDS * 4, stream);
    void* args[] = {&p};
    hipError_t e = hipLaunchCooperativeKernel((const void*)mega_fwd, dim3(grid), dim3(512), args, LDS_BYTES, stream);
    if (e != hipSuccess) fprintf(stderr, "cooperative launch failed: %s (grid %d)\n", hipGetErrorString(e), grid);
}
```
